# Optimizing an MI355X kernel written in HIP

```python
import math
import jax, jax.numpy as jnp
from jax import lax
import numpy as np

D_MODEL = 1024
BATCH = 4
SEQ = 8192
DEPTH = 2

GRID_W = 64
CTX_LEN = 256
MIX_W = D_MODEL
FOURIER_GROUPS = 4
FOURIER_W = MIX_W // 4
POOL_WINDOWS = (2, 4, 8, 16)
POOL_W = MIX_W // 4
POOL_GROUP = POOL_W // len(POOL_WINDOWS)
HEAD_DIM = 64
ATT_HEADS = (MIX_W // 4) // HEAD_DIM
ATT_KV_HEADS = 2
WINDOW = 128
ATT_BLOCK = 128
ROPE_BASE = 10000.0
RET_HEADS = 4
RET_DK = (MIX_W // 4) // RET_HEADS
RET_DV = RET_DK
RET_CHUNK = 128
N_EXPERTS = 32
TOP_K = 4
D_EXPERT = D_MODEL
SWIGLU_LIMIT = 7.0
SWIGLU_ALPHA = 1.702
MOE_BLOCK = 128
DEEPNORM_ALPHA = (2 * DEPTH) ** 0.25
DEEPNORM_BETA = (8 * DEPTH) ** -0.25
LN_EPS = 1e-6
NEG_INF = -1e30
IN_SIZES = (FOURIER_W, POOL_W, ATT_HEADS * HEAD_DIM, ATT_KV_HEADS * HEAD_DIM, ATT_KV_HEADS * HEAD_DIM,
            RET_HEADS * RET_DK, RET_HEADS * RET_DK, RET_HEADS * RET_DV, RET_HEADS * RET_DV)
IN_W = sum(IN_SIZES)

kernel_name = 'hybrid_parallel_groups_moe_dit'


def layer_norm(x, g=None, b=None):
    xf = x.astype(jnp.float32)
    mu = jnp.mean(xf, axis=-1, keepdims=True)
    var = jnp.mean(jnp.square(xf - mu), axis=-1, keepdims=True)
    y = (xf - mu) * lax.rsqrt(var + LN_EPS)
    if g is not None:
        y = y * g.astype(jnp.float32) + b.astype(jnp.float32)
    return y.astype(x.dtype)


def axial_rope(x, row, col):
    half = x.shape[-1] // 2
    inv = 1.0 / (ROPE_BASE ** (jnp.arange(0, half, 2, dtype=jnp.float32) / half))

    def rot(xp, pos):
        ang = pos.astype(jnp.float32)[:, None] * inv[None, :]
        cos = jnp.cos(ang)[None, :, None, :].astype(xp.dtype)
        sin = jnp.sin(ang)[None, :, None, :].astype(xp.dtype)
        x1, x2 = jnp.split(xp, 2, axis=-1)
        return jnp.concatenate([x1 * cos - x2 * sin, x2 * cos + x1 * sin], axis=-1)

    return jnp.concatenate([rot(x[..., :half], row), rot(x[..., half:], col)], axis=-1)


def fourier_mix(a):
    B, N, _ = a.shape
    af = a.reshape(B, N, FOURIER_GROUPS, FOURIER_W // FOURIER_GROUPS).astype(jnp.float32)
    y = jnp.fft.fftn(af, axes=(1, 3), norm='ortho').real
    return y.astype(a.dtype).reshape(B, N, FOURIER_W)


def centred_window_mean(x, w):
    N = x.shape[1]
    cs = jnp.concatenate([jnp.zeros_like(x[:, :1]), jnp.cumsum(x, axis=1)], axis=1)
    t = jnp.arange(N)
    lo = jnp.clip(t - w // 2, 0, N)
    hi = jnp.clip(t + w // 2, 0, N)
    cnt = (hi - lo).astype(x.dtype)
    return (cs[:, hi] - cs[:, lo]) / cnt[None, :, None]


def pool_mix(b, pool_w, pool_scale):
    B, N, _ = b.shape
    bg = b.reshape(B, N, len(POOL_WINDOWS), POOL_GROUP).astype(jnp.float32)
    pooled = jnp.stack([centred_window_mean(bg[:, :, i], w) - bg[:, :, i] for i, w in enumerate(POOL_WINDOWS)], axis=2)
    y = jnp.einsum('bngc,gcd->bngd', pooled.astype(b.dtype), pool_w)
    return y.reshape(B, N, POOL_W) * pool_scale


def banded_attention(q, k, v, k_ctx, v_ctx, sinks):
    B, N, _, _ = q.shape
    L = k_ctx.shape[1]
    nb = N // ATT_BLOCK
    G = ATT_HEADS // ATT_KV_HEADS
    scale = HEAD_DIM ** -0.5
    qb = q.reshape(B, nb, ATT_BLOCK, ATT_KV_HEADS, G, HEAD_DIM)

    def band(t):
        tp = jnp.pad(t, ((0, 0), (ATT_BLOCK, ATT_BLOCK), (0, 0), (0, 0)))
        tp = tp.reshape(B, nb + 2, ATT_BLOCK, ATT_KV_HEADS, HEAD_DIM)
        return jnp.concatenate([tp[:, :-2], tp[:, 1:-1], tp[:, 2:]], axis=2)

    kb, vb = band(k), band(v)
    s_loc = jnp.einsum('bnqkgd,bnskd->bnkgqs', qb, kb).astype(jnp.float32) * scale
    s_ctx = jnp.einsum('bnqkgd,blkd->bnkgql', qb, k_ctx).astype(jnp.float32) * scale
    blk = jnp.arange(nb)[:, None]
    qpos = blk * ATT_BLOCK + jnp.arange(ATT_BLOCK)[None]
    kpos = (blk - 1) * ATT_BLOCK + jnp.arange(3 * ATT_BLOCK)[None]
    valid = ((jnp.abs(qpos[:, :, None] - kpos[:, None, :]) <= WINDOW)
             & (kpos >= 0)[:, None, :] & (kpos < N)[:, None, :])
    s_loc = jnp.where(valid[None, :, None, None], s_loc, NEG_INF)
    sink = jnp.broadcast_to(sinks.astype(jnp.float32).reshape(ATT_KV_HEADS, G)[None, None, :, :, None, None],
                            s_loc.shape[:-1] + (1,))
    p = jax.nn.softmax(jnp.concatenate([s_loc, s_ctx, sink], axis=-1), axis=-1).astype(v.dtype)
    nloc = 3 * ATT_BLOCK
    o = (jnp.einsum('bnkgqs,bnskd->bnqkgd', p[..., :nloc], vb)
         + jnp.einsum('bnkgql,blkd->bnqkgd', p[..., nloc:nloc + L], v_ctx))
    return o.reshape(B, N, ATT_HEADS * HEAD_DIM)


def context_attention(q, k, v, sinks):
    B, L, _, _ = q.shape
    G = ATT_HEADS // ATT_KV_HEADS
    qg = q.reshape(B, L, ATT_KV_HEADS, G, HEAD_DIM)
    s = jnp.einsum('blkgd,bmkd->bkglm', qg, k).astype(jnp.float32) * (HEAD_DIM ** -0.5)
    sink = jnp.broadcast_to(sinks.astype(jnp.float32).reshape(ATT_KV_HEADS, G)[None, :, :, None, None],
                            s.shape[:-1] + (1,))
    p = jax.nn.softmax(jnp.concatenate([s, sink], axis=-1), axis=-1).astype(v.dtype)
    o = jnp.einsum('bkglm,bmkd->blkgd', p[..., :L], v)
    return o.reshape(B, L, ATT_HEADS * HEAD_DIM)


def retention_chunkwise(q, k, v, log_g, state0):
    B, N, H, dk = q.shape
    dv = v.shape[-1]
    nc = N // RET_CHUNK
    qc = q.reshape(B, nc, RET_CHUNK, H, dk)
    kc = k.reshape(B, nc, RET_CHUNK, H, dk)
    vc = v.reshape(B, nc, RET_CHUNK, H, dv)
    i = jnp.arange(RET_CHUNK, dtype=jnp.float32)
    diff = i[:, None] - i[None, :]
    dmask = jnp.where(diff >= 0, jnp.exp(jnp.maximum(diff, 0.0)[None] * log_g[:, None, None]), 0.0)
    scores = jnp.einsum('bnqhd,bnshd->bnhqs', qc, kc) * dmask[None, None]
    o_inner = jnp.einsum('bnhqs,bnshv->bnqhv', scores, vc)
    zeta = jnp.exp((RET_CHUNK - 1.0 - i)[:, None] * log_g[None, :])
    kv = jnp.einsum('bnshd,sh,bnshv->bnhdv', kc, zeta, vc)
    chunk_decay = jnp.exp(RET_CHUNK * log_g)[None, :, None, None]

    def step(R, kv_n):
        return chunk_decay * R + kv_n, R

    R_final, R_prev = lax.scan(step, state0, jnp.moveaxis(kv, 1, 0))
    R_prev = jnp.moveaxis(R_prev, 0, 1)
    xi = jnp.exp((i + 1.0)[:, None] * log_g[None, :])
    o_cross = jnp.einsum('bnqhd,bnhdv->bnqhv', qc, R_prev) * xi[None, None, :, :, None]
    return (o_inner + o_cross).reshape(B, N, H, dv), R_final


def bidirectional_retention(q_l, k_l, v_l, q_c, k_c, v_c, ret_decay):
    def heads(t):
        return t.reshape(t.shape[0], t.shape[1], RET_HEADS, -1).astype(jnp.float32)

    q_l, k_l, v_l, q_c, k_c, v_c = [heads(t) for t in (q_l, k_l, v_l, q_c, k_c, v_c)]
    k_l = k_l * (RET_DK ** -0.5)
    k_c = k_c * (RET_DK ** -0.5)
    log_g = -jnp.exp(ret_decay.astype(jnp.float32))
    B = q_l.shape[0]
    state0 = jnp.zeros((B, RET_HEADS, RET_DK, RET_DV), jnp.float32)

    def flip(t):
        return jnp.flip(t, axis=1)

    o_cf, s_f = retention_chunkwise(q_c, k_c, v_c, log_g[0], state0)
    o_lf, _ = retention_chunkwise(q_l, k_l, v_l, log_g[0], s_f)
    o_cb, s_b = retention_chunkwise(flip(q_c), flip(k_c), flip(v_c), log_g[1], state0)
    o_lb, _ = retention_chunkwise(flip(q_l), flip(k_l), flip(v_l), log_g[1], s_b)
    return o_lf + flip(o_lb), o_cf + flip(o_cb)


def retention_out(o, g):
    B, N = o.shape[:2]
    gn = layer_norm(o).reshape(B, N, RET_HEADS * RET_DV).astype(g.dtype)
    return jax.nn.silu(g) * gn


def token_mixers(h_lat, h_ctx, w_in, pool_w, pool_scale, sinks, ret_decay, w_out, row, col, need_ctx):
    B, N, _ = h_lat.shape
    L = h_ctx.shape[1]
    split_pts = np.cumsum(IN_SIZES)[:-1].tolist()
    a_l, b_l, q_l, k_l, v_l, rq_l, rk_l, rv_l, rg_l = jnp.split(h_lat @ w_in, split_pts, axis=-1)
    a_c, b_c, q_c, k_c, v_c, rq_c, rk_c, rv_c, rg_c = jnp.split(h_ctx @ w_in, split_pts, axis=-1)
    q_l = axial_rope(q_l.reshape(B, N, ATT_HEADS, HEAD_DIM), row, col)
    k_l = axial_rope(k_l.reshape(B, N, ATT_KV_HEADS, HEAD_DIM), row, col)
    v_l = v_l.reshape(B, N, ATT_KV_HEADS, HEAD_DIM)
    k_c = k_c.reshape(B, L, ATT_KV_HEADS, HEAD_DIM)
    v_c = v_c.reshape(B, L, ATT_KV_HEADS, HEAD_DIM)
    att_l = banded_attention(q_l, k_l, v_l, k_c, v_c, sinks)
    ret_l, ret_c = bidirectional_retention(rq_l, rk_l, rv_l, rq_c, rk_c, rv_c, ret_decay)
    y_lat = jnp.concatenate([fourier_mix(a_l), pool_mix(b_l, pool_w, pool_scale), att_l,
                             retention_out(ret_l, rg_l)], axis=-1) @ w_out
    if not need_ctx:
        return y_lat, None
    att_c = context_attention(q_c.reshape(B, L, ATT_HEADS, HEAD_DIM), k_c, v_c, sinks)
    y_ctx = jnp.concatenate([fourier_mix(a_c), pool_mix(b_c, pool_w, pool_scale), att_c,
                             retention_out(ret_c, rg_c)], axis=-1) @ w_out
    return y_lat, y_ctx


def clamped_swiglu(u):
    glu = jnp.minimum(u[..., ::2], SWIGLU_LIMIT)
    lin = jnp.clip(u[..., 1::2], -SWIGLU_LIMIT, SWIGLU_LIMIT)
    return glu * jax.nn.sigmoid(SWIGLU_ALPHA * glu) * (lin + 1.0)


def moe_ffn(h, router_w, router_b, w1, b1, w2, b2):
    T, D = h.shape
    logits = (h @ router_w + router_b).astype(jnp.float32)
    top_v, top_i = lax.top_k(logits, TOP_K)
    gates = jax.nn.softmax(top_v, axis=-1)
    A = T * TOP_K
    flat_e = top_i.reshape(-1)
    flat_g = gates.reshape(-1).astype(h.dtype)
    order = jnp.argsort(flat_e)
    sorted_e = flat_e[order]
    counts = jnp.bincount(flat_e, length=N_EXPERTS)
    padded = (counts + MOE_BLOCK - 1) // MOE_BLOCK * MOE_BLOCK
    pad_end = jnp.cumsum(padded)
    pad_start = pad_end - padded
    grp_start = jnp.cumsum(counts) - counts
    dest = pad_start[sorted_e] + jnp.arange(A) - grp_start[sorted_e]
    nblk = -(-A // MOE_BLOCK) + N_EXPERTS
    P = nblk * MOE_BLOCK
    row_tok = jnp.full((P,), T, jnp.int32).at[dest].set((order // TOP_K).astype(jnp.int32))
    row_gate = jnp.zeros((P,), h.dtype).at[dest].set(flat_g[order])
    blk_e = jnp.minimum(jnp.searchsorted(pad_end, jnp.arange(nblk) * MOE_BLOCK, side='right'), N_EXPERTS - 1)
    h_pad = jnp.concatenate([h, jnp.zeros((1, D), h.dtype)], axis=0)

    def expert_block(args):
        rows, e = args
        u = h_pad[rows] @ w1[e] + b1[e]
        return clamped_swiglu(u) @ w2[e] + b2[e]

    y = lax.map(expert_block, (row_tok.reshape(nblk, MOE_BLOCK), blk_e))
    y = y.reshape(P, D) * row_gate[:, None]
    return jnp.zeros((T + 1, D), y.dtype).at[row_tok].add(y)[:T]


def setup_inputs(seed: int = 0) -> dict:
    key = jax.random.key(seed)
    ks = jax.random.split(key, 20)
    nrm = jax.random.normal
    f32 = jnp.float32
    base_decay = -(5.0 + jnp.arange(RET_HEADS, dtype=f32)) * math.log(2.0)
    return {
        'x': nrm(ks[0], (BATCH, SEQ, D_MODEL), f32),
        'c': nrm(ks[1], (BATCH, D_MODEL), f32),
        'ctx': nrm(ks[2], (BATCH, CTX_LEN, D_MODEL), f32),
        'c_ctx': nrm(ks[3], (D_MODEL,), f32),
        'w_mod': nrm(ks[4], (DEPTH, D_MODEL, 6 * D_MODEL), f32) * D_MODEL ** -0.5,
        'b_mod': 0.02 * nrm(ks[5], (DEPTH, 6 * D_MODEL), f32),
        'w_in': nrm(ks[6], (DEPTH, D_MODEL, IN_W), f32) * D_MODEL ** -0.5,
        'pool_w': nrm(ks[7], (DEPTH, len(POOL_WINDOWS), POOL_GROUP, POOL_GROUP), f32) * POOL_GROUP ** -0.5,
        'pool_scale': 1.0 + 0.1 * nrm(ks[8], (DEPTH, POOL_W), f32),
        'attn_sink': 0.5 * nrm(ks[9], (DEPTH, ATT_HEADS), f32),
        'ret_decay': jnp.log(-base_decay)[None, None, :] * 0.0 + jnp.log(jnp.exp(base_decay))[None, None, :] + 0.1 * nrm(ks[10], (DEPTH, 2, RET_HEADS), f32),
        'w_out': nrm(ks[11], (DEPTH, MIX_W, D_MODEL), f32) * MIX_W ** -0.5 * DEEPNORM_BETA,
        'ln_g': 1.0 + 0.02 * nrm(ks[12], (DEPTH, 2, D_MODEL), f32),
        'ln_b': 0.02 * nrm(ks[13], (DEPTH, 2, D_MODEL), f32),
        'router_w': nrm(ks[14], (DEPTH, D_MODEL, N_EXPERTS), f32) * D_MODEL ** -0.5,
        'router_b': 0.01 * nrm(ks[15], (DEPTH, N_EXPERTS), f32),
        'exp_w1': nrm(ks[16], (DEPTH, N_EXPERTS, D_MODEL, 2 * D_EXPERT), f32) * D_MODEL ** -0.5,
        'exp_b1': 0.02 * nrm(ks[17], (DEPTH, N_EXPERTS, 2 * D_EXPERT), f32),
        'exp_w2': nrm(ks[18], (DEPTH, N_EXPERTS, D_EXPERT, D_MODEL), f32) * D_EXPERT ** -0.5 * DEEPNORM_BETA,
        'exp_b2': 0.02 * nrm(ks[19], (DEPTH, N_EXPERTS, D_MODEL), f32),
    }


def reference(x, c, ctx, c_ctx, w_mod, b_mod, w_in, pool_w, pool_scale, attn_sink, ret_decay, w_out,
              ln_g, ln_b, router_w, router_b, exp_w1, exp_b1, exp_w2, exp_b2):
    B, N, D = x.shape
    L = ctx.shape[1]
    ROWS = N // GRID_W
    row = jnp.broadcast_to(jnp.arange(ROWS)[:, None], (ROWS, GRID_W)).reshape(-1)
    col = jnp.broadcast_to(jnp.arange(GRID_W)[None, :], (ROWS, GRID_W)).reshape(-1)
    x_lat, x_ctx = x, ctx
    for l in range(DEPTH):
        need_ctx = l < DEPTH - 1
        sh1, sc1, g1, sh2, sc2, g2 = [m[:, None, :] for m in
                                      jnp.split(jax.nn.silu(c) @ w_mod[l] + b_mod[l], 6, axis=-1)]
        csh1, csc1, cg1, csh2, csc2, cg2 = jnp.split(jax.nn.silu(c_ctx) @ w_mod[l] + b_mod[l], 6, axis=-1)
        h_lat = layer_norm(x_lat) * (1.0 + sc1) + sh1
        h_ctx = layer_norm(x_ctx) * (1.0 + csc1) + csh1
        y_lat, y_ctx = token_mixers(h_lat, h_ctx, w_in[l], pool_w[l], pool_scale[l], attn_sink[l],
                                    ret_decay[l], w_out[l], row, col, need_ctx)
        x_lat = layer_norm(DEEPNORM_ALPHA * x_lat + g1 * y_lat, ln_g[l, 0], ln_b[l, 0])
        h2_lat = (layer_norm(x_lat) * (1.0 + sc2) + sh2).reshape(B * N, D)
        if need_ctx:
            x_ctx = layer_norm(DEEPNORM_ALPHA * x_ctx + cg1 * y_ctx, ln_g[l, 0], ln_b[l, 0])
            h2_ctx = (layer_norm(x_ctx) * (1.0 + csc2) + csh2).reshape(B * L, D)
            f = moe_ffn(jnp.concatenate([h2_ctx, h2_lat], axis=0), router_w[l], router_b[l],
                        exp_w1[l], exp_b1[l], exp_w2[l], exp_b2[l])
            f_ctx = f[:B * L].reshape(B, L, D)
            f_lat = f[B * L:].reshape(B, N, D)
            x_ctx = layer_norm(DEEPNORM_ALPHA * x_ctx + cg2 * f_ctx, ln_g[l, 1], ln_b[l, 1])
        else:
            f_lat = moe_ffn(h2_lat, router_w[l], router_b[l], exp_w1[l], exp_b1[l],
                            exp_w2[l], exp_b2[l]).reshape(B, N, D)
        x_lat = layer_norm(DEEPNORM_ALPHA * x_lat + g2 * f_lat, ln_g[l, 1], ln_b[l, 1])
    return x_lat
```

```cpp
#ifndef CPU_TEST
#include <hip/hip_runtime.h>
#include <cstdio>
#include <cstdint>
#define HD __device__ __forceinline__
#define OPAQUE_V(x) asm volatile("" : "+v"(x))
#else
#define OPAQUE_V(x)
#include <cstdio>
#include <cstdint>
#include <cstdlib>
#include <cstring>
#include <cmath>
#include <vector>
#include <string>
#include "emu.h"
#define HD static inline
static inline int atomicAdd(int* p, int v) { int o = *p; *p = o + v; return o; }
static inline float cospif(float x) { return (float)cos(M_PI * (double)x); }
static inline float sinpif(float x) { return (float)sin(M_PI * (double)x); }
struct uint4 { unsigned x, y, z, w; };
#endif

#ifndef CFG_D
#define CFG_D 1024
#define CFG_NB 4
#define CFG_SEQ 8192
#define CFG_LCTX 256
#define CFG_GW 64
#define CFG_HDIM 64
#define CFG_WIN 128
#define CFG_NE 32
#endif
constexpr int D = CFG_D, NB = CFG_NB, SEQ = CFG_SEQ, LCTX = CFG_LCTX, GW = CFG_GW, HDIM = CFG_HDIM, WIN = CFG_WIN, NE = CFG_NE;
constexpr int DEPTH = 2, TOPK = 4, DE = D;
constexpr int QW = D / 4;
constexpr int NH = QW / HDIM, NKV = 2, GQ = NH / NKV;
constexpr int RH = 4, RDK = QW / RH;
constexpr int FG = 4, FC = QW / FG;
constexpr int PGW = QW / 4;
constexpr int INW = 2 * D;
constexpr int A_OFF = 0, B_OFF = QW, Q_OFF = 2 * QW, K_OFF = 3 * QW, V_OFF = 3 * QW + QW / 2, RQ_OFF = 4 * QW, RK_OFF = 5 * QW, RV_OFF = 6 * QW, RG_OFF = 7 * QW;
constexpr int TC = NB * LCTX, TL = NB * SEQ, T = TC + TL;
constexpr int MOEB = 256;
constexpr int PMAX = T * TOPK + NE * MOEB, NBLKMAX = PMAX / MOEB;
constexpr float LN_EPS = 1e-6f, SW_LIMIT = 7.0f, SW_ALPHA = 1.702f;
constexpr float DN_ALPHA = 1.41421356237309515f;
constexpr float ROPE_BASE = 10000.0f;
static_assert(NH * HDIM == QW && RH * RDK == QW && FG * FC == QW && GQ * NKV == NH, "shape algebra");

typedef unsigned short bf16;
#ifndef CPU_TEST
typedef float cvt_f32x2_t __attribute__((ext_vector_type(2))); typedef __bf16 cvt_bf16x2_t __attribute__((ext_vector_type(2)));
HD unsigned cvt_pk_bf16(float lo, float hi) { const cvt_f32x2_t v = {lo, hi}; return __builtin_bit_cast(unsigned, __builtin_convertvector(v, cvt_bf16x2_t)); }
HD unsigned f2bf(float f) { return cvt_pk_bf16(f, f) & 0xffffu; }
#else
HD unsigned f2bf(float f) { unsigned u; __builtin_memcpy(&u, &f, 4); return (u + 0x7fffu + ((u >> 16) & 1u)) >> 16; }
HD unsigned cvt_pk_bf16(float lo, float hi) { return f2bf(lo) | (f2bf(hi) << 16); }
#endif
HD float bf2f(bf16 h) { unsigned u = (unsigned)h << 16; float f; __builtin_memcpy(&f, &u, 4); return f; }
#ifndef CPU_TEST
HD float rcp_f(float x) { return __builtin_amdgcn_rcpf(x); }
HD void sincos_rev(float rev, float& c, float& s) { c = __builtin_amdgcn_cosf(rev); s = __builtin_amdgcn_sinf(rev); }
HD float rsq_f(float x) { return __builtin_amdgcn_rsqf(x); }
HD float silu_f(float x) { return x * __builtin_amdgcn_rcpf(1.0f + __expf(-x)); }
#else
HD float rcp_f(float x) { return 1.0f / x; }
HD void sincos_rev(float rev, float& c, float& s) { c = cospif(2.0f * rev); s = sinpif(2.0f * rev); }
HD float rsq_f(float x) { return 1.0f / sqrtf(x); }
HD float silu_f(float x) { return x / (1.0f + expf(-x)); }
#endif
constexpr float W8_SCALE = 32.0f;
HD float fp8_to_f32(unsigned c) { const unsigned sg = (c >> 7) & 1u, e = (c >> 3) & 15u, m = c & 7u; float v = e == 0 ? (float)m * 0.001953125f : ldexpf(1.0f + (float)m * 0.125f, (int)e - 7); return sg ? -v : v; }
HD unsigned f32_to_fp8_sw(float f) {
    const unsigned sg = f < 0.f ? 0x80u : 0u; float a = fabsf(f); if (!(a == a)) return 0x7Fu; if (a > 448.0f) a = 448.0f;
    if (a < 0.015625f) { const int q = (int)nearbyintf(a * 512.0f); return sg | (unsigned)q; }
    int ex; const float fr = frexpf(a, &ex); int e = ex - 1; int q = (int)nearbyintf((fr * 2.0f - 1.0f) * 8.0f); if (q == 8) { q = 0; ++e; }
    if (e > 8 || (e == 8 && q == 7)) { e = 8; q = 6; }
    return sg | (unsigned)((e + 7) << 3) | (unsigned)q;
}
#ifndef CPU_TEST
typedef float f32x4_h __attribute__((ext_vector_type(4))); typedef float f32x2_h __attribute__((ext_vector_type(2)));
HD f32x4_h unpk4_fp8(unsigned w) { const f32x2_h lo = __builtin_amdgcn_cvt_pk_f32_fp8((int)w, false), hi = __builtin_amdgcn_cvt_pk_f32_fp8((int)w, true); return (f32x4_h){lo[0], lo[1], hi[0], hi[1]}; }
HD unsigned pk4_fp8(float a, float b, float c, float d) { int w = 0; w = __builtin_amdgcn_cvt_pk_fp8_f32(a, b, w, false); w = __builtin_amdgcn_cvt_pk_fp8_f32(c, d, w, true); return (unsigned)w; }
#else
typedef float f32x4_h __attribute__((ext_vector_type(4)));
HD f32x4_h unpk4_fp8(unsigned w) { return (f32x4_h){fp8_to_f32(w & 255u), fp8_to_f32((w >> 8) & 255u), fp8_to_f32((w >> 16) & 255u), fp8_to_f32(w >> 24)}; }
HD unsigned pk4_fp8(float a, float b, float c, float d) { return f32_to_fp8_sw(a) | (f32_to_fp8_sw(b) << 8) | (f32_to_fp8_sw(c) << 16) | (f32_to_fp8_sw(d) << 24); }
#endif

constexpr size_t al256(size_t x) { return (x + 255) & ~(size_t)255; }
constexpr size_t WS_CTL = 0, CTL_ZERO_BYTES = 1u << 20;
constexpr int CW_BAR = 4096;
constexpr int CW_CNT = 16384;
constexpr size_t WS_MOD = CTL_ZERO_BYTES;
constexpr size_t WS_WIN = al256(WS_MOD + (size_t)DEPTH * (NB + 1) * 6 * D * 4);
constexpr size_t WS_WOUT = al256(WS_WIN + (size_t)DEPTH * INW * D * 2);
constexpr size_t WS_W1 = al256(WS_WOUT + (size_t)DEPTH * D * D * 2);
constexpr size_t WS_W2 = al256(WS_W1 + (size_t)DEPTH * NE * 2 * DE * D * 2);
constexpr size_t WS_WDFT = al256(WS_W2 + (size_t)DEPTH * NE * D * DE * 2);
constexpr size_t WS_XS = al256(WS_WDFT + (size_t)(4u << 20));
constexpr size_t WS_HB = al256(WS_XS + (size_t)T * D * 4);
constexpr size_t WS_LOG = al256(WS_HB + (size_t)T * D * 2);
constexpr size_t WS_TOPI = al256(WS_LOG + (size_t)T * NE * 4);
constexpr size_t WS_GATE = al256(WS_TOPI + (size_t)T * TOPK * 4);
constexpr size_t WS_RANK = al256(WS_GATE + (size_t)T * TOPK * 4);
constexpr size_t WS_POS = al256(WS_RANK + (size_t)T * TOPK * 4);
constexpr size_t WS_BLKE = al256(WS_POS + (size_t)T * TOPK * 4);
constexpr size_t WS_BLKCNT = al256(WS_BLKE + (size_t)(NBLKMAX + 64) * 4);
constexpr size_t WS_HB8 = al256(WS_BLKCNT + (size_t)DEPTH * 1024 * NE * 4);
constexpr size_t WS_ARENA = al256(WS_HB8 + (size_t)T * D);
constexpr size_t WS_PJ = WS_ARENA;
constexpr size_t WS_QR = al256(WS_PJ + (size_t)T * INW * 2);
constexpr size_t WS_KR = al256(WS_QR + (size_t)T * QW * 2);
constexpr size_t WS_ZT = al256(WS_KR + (size_t)T * (QW / 2) * 2);
constexpr size_t WS_ZC = al256(WS_ZT + (size_t)NB * QW * 2 * SEQ * 2);
constexpr size_t WS_OF = al256(WS_ZC + (size_t)TC * 2 * QW * 4);
constexpr size_t WS_MIX = al256(WS_OF + (size_t)2 * T * QW * 4);
constexpr size_t WS_Y = al256(WS_MIX + (size_t)T * D * 2);
constexpr size_t WS_MIXER_END = al256(WS_Y + (size_t)T * D * 2);
constexpr size_t WS_AS = WS_ARENA;
constexpr size_t WS_ACT = al256(WS_AS + (size_t)PMAX * D * 2);
constexpr size_t WS_YM = al256(WS_ACT + (size_t)PMAX * DE * 2);
constexpr size_t WS_MOE_END = al256(WS_YM + (size_t)PMAX * D * 2);
constexpr size_t WS_TOTAL = WS_MIXER_END > WS_MOE_END ? WS_MIXER_END : WS_MOE_END;

struct P {
    const float *x, *c, *ctx, *c_ctx, *w_mod, *b_mod, *w_in, *pool_w, *pool_scale, *attn_sink, *ret_decay, *w_out, *ln_g, *ln_b, *router_w, *router_b, *exp_w1, *exp_b1, *exp_w2, *exp_b2;
    float* out;
    unsigned char* ws; int qbank;
    float* mod; bf16 *WinT, *WoutT, *W1T, *W2T, *Wdft; bf16* xs; bf16* hb; float* logits; int* topi; float* gate; int* rank; int* pos; int* blke; int* cnt; int* blkcnt; int* rowtok; unsigned char *hb8, *W1T8, *W2T8, *as8, *act8, *ym8;
    bf16 *pj, *qr, *kr, *zt; float* zc; float* of; float* rs; bf16* rs16; bf16 *ft64, *ft128, *ct, *pwt; float* rtab; float* ctab; bf16 *mix, *y; bf16 *as, *act, *ym;
};
HD void fill_views(P& p) {
    unsigned char* ws = p.ws; p.qbank = 0;
    p.mod = (float*)(ws + WS_MOD); p.WinT = (bf16*)(ws + WS_WIN); p.WoutT = (bf16*)(ws + WS_WOUT); p.W1T = (bf16*)(ws + WS_W1); p.W2T = (bf16*)(ws + WS_W2); p.Wdft = (bf16*)(ws + WS_WDFT);
    p.xs = (bf16*)(ws + WS_XS); p.hb = (bf16*)(ws + WS_HB); p.logits = (float*)(ws + WS_LOG); p.topi = (int*)(ws + WS_TOPI); p.gate = (float*)(ws + WS_GATE); p.rank = (int*)(ws + WS_RANK);
    p.pos = (int*)(ws + WS_POS); p.blke = (int*)(ws + WS_BLKE); p.cnt = (int*)(ws + WS_CTL) + CW_CNT; p.blkcnt = (int*)(ws + WS_BLKCNT); p.rowtok = (int*)(ws + WS_AS); p.hb8 = ws + WS_HB8; p.W1T8 = ws + WS_W1; p.W2T8 = ws + WS_W2; p.as8 = ws + WS_AS; p.act8 = ws + WS_ACT; p.ym8 = ws + WS_YM;
    p.pj = (bf16*)(ws + WS_PJ); p.qr = (bf16*)(ws + WS_QR); p.kr = (bf16*)(ws + WS_KR); p.zt = (bf16*)(ws + WS_ZT); p.zc = (float*)(ws + WS_ZC); p.of = (float*)(ws + WS_OF); p.rs = (float*)(ws + WS_OF); p.rs16 = (bf16*)(ws + WS_OF); p.ft64 = (bf16*)(ws + WS_WDFT); p.ft128 = (bf16*)(ws + WS_WDFT + 65536); p.ct = (bf16*)(ws + WS_ZT); p.pwt = (bf16*)(ws + WS_WDFT + 262144); p.rtab = (float*)(ws + WS_WDFT + 524288); p.ctab = (float*)(ws + WS_WDFT + 786432);
    p.mix = (bf16*)(ws + WS_MIX); p.y = (bf16*)(ws + WS_Y); p.as = (bf16*)(ws + WS_AS); p.act = (bf16*)(ws + WS_ACT); p.ym = (bf16*)(ws + WS_YM);
}
HD int row_slot(int t) { return t < TC ? NB : (t - TC) / SEQ; }
HD void row_seq(int t, int& n, int& N, int& t0) { if (t < TC) { n = t % LCTX; N = LCTX; t0 = t - n; } else { n = (t - TC) % SEQ; N = SEQ; t0 = t - n; } }
HD const float* modp(const P& p, int l, int slot, int which) { return p.mod + ((size_t)(l * (NB + 1) + slot) * 6 + which) * D; }
HD void ph_fch(const P& p, long gid) {
    const int gc = (int)(gid % QW), t = (int)(gid / QW); const int g = gc / FC, cp = gc % FC;
    const bf16* a = p.pj + (size_t)t * INW + A_OFF + g * FC;
    float br = 0.f, bs = 0.f;
    for (int c = 0; c < FC; ++c) { float cs, sn; sincos_rev((float)((c * cp) % FC) * (1.0f / (float)FC), cs, sn); const float v = bf2f(a[c]); br += v * cs; bs += v * sn; }
    { const float s = 1.0f / sqrtf((float)LCTX * FC); p.zc[(size_t)t * 2 * QW + gc] = br * s; p.zc[(size_t)t * 2 * QW + QW + gc] = -bs * s; }
}
HD void ph_ctab(const P& p, long gid) { const float a = 2.0f * (float)gid / (float)LCTX; p.ctab[2 * gid] = cospif(a); p.ctab[2 * gid + 1] = sinpif(a); }
HD void ph_fctx(const P& p, long gid) {
    const int gc = (int)(gid % QW), t = (int)(gid / QW); const int k = t % LCTX, t0 = t - k;
    float acc = 0.f;
    for (int n0 = 0; n0 < LCTX; n0 += 16) {
        float zr[16], zi[16];
#pragma unroll
        for (int u = 0; u < 16; ++u) { const float* z = p.zc + (size_t)(t0 + n0 + u) * 2 * QW; zr[u] = z[gc]; zi[u] = z[QW + gc]; }
#pragma unroll
        for (int u = 0; u < 16; ++u) { const int m = ((n0 + u) * k) % LCTX; acc += p.ctab[2 * m] * zr[u] + p.ctab[2 * m + 1] * zi[u]; }
    }
    p.mix[(size_t)t * D + gc] = (bf16)f2bf(acc);
}
HD void ph_pwt(const P& p, long gid) { const int c = (int)(gid % PGW), d = (int)(gid / PGW) % PGW; const long lg = gid / (PGW * PGW); p.pwt[gid] = (bf16)f2bf(p.pool_w[(lg * PGW + c) * PGW + d]); }
#ifndef CPU_TEST
#define LAS __attribute__((address_space(3)))
typedef short bf16x8 __attribute__((ext_vector_type(8)));
typedef float f32x4 __attribute__((ext_vector_type(4)));
typedef float f32x16 __attribute__((ext_vector_type(16)));
typedef unsigned u32x4 __attribute__((ext_vector_type(4)));
typedef unsigned u32x2 __attribute__((ext_vector_type(2)));
typedef _Float16 half8 __attribute__((ext_vector_type(8)));
#define WAVE_LDS_FENCE() asm volatile("s_waitcnt lgkmcnt(0)" ::: "memory")
#define SCHED_FENCE() __builtin_amdgcn_sched_barrier(0)
#else
#define LAS
#define WAVE_LDS_FENCE() emu::wave_sync()
#define SCHED_FENCE()
#endif
constexpr int NWV = 8;
constexpr int TS = 72;
constexpr int TILE_B = 64 * TS * 2;
constexpr int WAVE_LDS = 2 * TILE_B;
HD unsigned pk2f(float lo, float hi) { return cvt_pk_bf16(lo, hi); }
template <int CTRL, int BANK = 0xF> HD float dpp_mov(float old, float v) { return __builtin_bit_cast(float, __builtin_amdgcn_update_dpp(__builtin_bit_cast(int, old), __builtin_bit_cast(int, v), CTRL, 0xF, BANK, false)); }
template <int M> HD float xchg_xor(float v) {
    if constexpr (M == 1) return dpp_mov<0xB1>(v, v);
    else if constexpr (M == 2) return dpp_mov<0x4E>(v, v);
    else if constexpr (M == 4) { float r = dpp_mov<0x104, 0x5>(v, v); return dpp_mov<0x114, 0xA>(r, v); }
    else if constexpr (M == 8) return dpp_mov<0x128>(v, v);
    else return __shfl_xor(v, M);
}
#ifndef CPU_TEST
HD float row16_sum(float v) { v += dpp_mov<0x128>(v, v);
    asm volatile("s_nop 1\n\tv_add_f32_dpp %0, %0, %0 row_ror:4 row_mask:0xf bank_mask:0xf\n\ts_nop 1\n\tv_add_f32_dpp %0, %0, %0 quad_perm:[2,3,0,1] row_mask:0xf bank_mask:0xf\n\t"
                 "s_nop 1\n\tv_add_f32_dpp %0, %0, %0 quad_perm:[1,0,3,2] row_mask:0xf bank_mask:0xf\n\ts_nop 1" : "+v"(v));
    return v; }
HD float row16_max(float v) { v = fmaxf(v, dpp_mov<0x128>(v, v));
    asm volatile("s_nop 1\n\tv_max_f32_dpp %0, %0, %0 row_ror:4 row_mask:0xf bank_mask:0xf\n\ts_nop 1\n\tv_max_f32_dpp %0, %0, %0 quad_perm:[2,3,0,1] row_mask:0xf bank_mask:0xf\n\t"
                 "s_nop 1\n\tv_max_f32_dpp %0, %0, %0 quad_perm:[1,0,3,2] row_mask:0xf bank_mask:0xf\n\ts_nop 1" : "+v"(v));
    return v; }
#else
HD float row16_sum(float v) { v += dpp_mov<0x128>(v, v); v += dpp_mov<0x124>(v, v); v += dpp_mov<0x4E>(v, v); v += dpp_mov<0xB1>(v, v); return v; }
HD float row16_max(float v) { v = fmaxf(v, dpp_mov<0x128>(v, v)); v = fmaxf(v, dpp_mov<0x124>(v, v)); v = fmaxf(v, dpp_mov<0x4E>(v, v)); v = fmaxf(v, dpp_mov<0xB1>(v, v)); return v; }
#endif
HD float rdlane(float v, int l) { return __builtin_bit_cast(float, __builtin_amdgcn_readlane(__builtin_bit_cast(int, v), l)); }
HD bf16x8 ldfrag(const LAS bf16* tile, int row, int k) { return *(const LAS bf16x8*)(tile + row * TS + k); }
HD void stage_tile_ld(u32x4 (&v)[8], const bf16* src, size_t gs, int lane) {
#pragma unroll
    for (int it = 0; it < 8; ++it) { const int r = it * 8 + (lane >> 3), cc = lane & 7; v[it] = *(const u32x4*)(src + (size_t)r * gs + cc * 8); }
}
HD void stage_tile_st(LAS bf16* dst, const u32x4 (&v)[8], int lane) {
#pragma unroll
    for (int it = 0; it < 8; ++it) { const int r = it * 8 + (lane >> 3), cc = lane & 7; *(LAS u32x4*)(dst + r * TS + cc * 8) = v[it]; }
}
HD void stage_tile(LAS bf16* dst, const bf16* src, size_t gs, int lane) {
#pragma unroll 4
    for (int it = 0; it < 8; ++it) { const int r = it * 8 + (lane >> 3), cc = lane & 7; const u32x4 v = *(const u32x4*)(src + (size_t)r * gs + cc * 8); *(LAS u32x4*)(dst + r * TS + cc * 8) = v; }
}
HD void stage_tile_T_ld(u32x4 (&v)[8], const bf16* src, size_t gs, int lane) {
#pragma unroll
    for (int cc = 0; cc < 8; ++cc) v[cc] = *(const u32x4*)(src + (size_t)lane * gs + cc * 8);
}
HD void stage_tile_T_st(LAS bf16* dst, const u32x4 (&v)[8], int lane, float lg, int mode, float s) {
    const int r = lane; const float w = mode == 0 ? s : s * __expf(lg * (float)(mode == 1 ? 63 - r : r));
#pragma unroll
    for (int cc = 0; cc < 8; ++cc)
#pragma unroll
        for (int e = 0; e < 4; ++e) { const unsigned u = v[cc][e];
            if (mode == 0 && s == 1.0f) { dst[(cc * 8 + 2 * e) * TS + r] = (bf16)(u & 0xffffu); dst[(cc * 8 + 2 * e + 1) * TS + r] = (bf16)(u >> 16); }
            else { dst[(cc * 8 + 2 * e) * TS + r] = (bf16)f2bf(bf2f((bf16)(u & 0xffffu)) * w); dst[(cc * 8 + 2 * e + 1) * TS + r] = (bf16)f2bf(bf2f((bf16)(u >> 16)) * w); } }
}
HD void stage_tile_T(LAS bf16* dst, const bf16* src, size_t gs, int lane, float lg, int mode, float s) { u32x4 v[8]; stage_tile_T_ld(v, src, gs, lane); stage_tile_T_st(dst, v, lane, lg, mode, s); }
HD void stage_tile_f32(LAS bf16* dst, const float* src, int lane) {
#pragma unroll 8
    for (int it = 0; it < 16; ++it) { const int r = it * 4 + (lane >> 4), c4 = lane & 15; const f32x4 v = *(const f32x4*)(src + r * 64 + c4 * 4);
        u32x2 o; o.x = pk2f(v[0], v[1]); o.y = pk2f(v[2], v[3]); *(LAS u32x2*)(dst + r * TS + c4 * 4) = o; }
}

#ifndef CPU_TEST
HD int q_pop_wave(int* ctr, int lane) { int v = 0; if (lane == 0) v = __hip_atomic_fetch_add(ctr, 1, __ATOMIC_RELAXED, __HIP_MEMORY_SCOPE_AGENT); return __builtin_amdgcn_readfirstlane(v); }
#else
HD int q_pop_wave(int* ctr, int lane) { const int base = emu::g_cur & ~63; emu::wave_sync(); if (lane == 0) emu::g_xi[base] = (*ctr)++; emu::wave_sync(); const int v = emu::g_xi[base]; emu::wave_sync(); return v; }
#endif
HD int* q_ctr(const P& p, int l, int k) { return p.cnt + 1024 + ((p.qbank * DEPTH + l) * 8 + k) * 64; }
constexpr int RCH = 64, NCH = (LCTX + SEQ) / RCH, NCHC = LCTX / RCH;
HD int ret_row0(int b, int c) { return c < NCHC ? b * LCTX + c * RCH : TC + b * SEQ + (c - NCHC) * RCH; }
HD size_t rs_off(int dir, int b, int h, int c) { return ((((size_t)dir * NB + b) * RH + h) * NCH + c) * (size_t)(RDK * RDK); }
HD void ph_retA(const P& p, int l, LAS unsigned char* lds) {
    static_assert(RDK == 64 && LCTX % RCH == 0 && SEQ % RCH == 0, "retention wave kernels are written for dk = dv = 64");
    int tid = threadIdx.x; OPAQUE_V(tid); const int wave = __builtin_amdgcn_readfirstlane(tid >> 6);
    LAS bf16* buf0 = (LAS bf16*)(lds + wave * WAVE_LDS); LAS bf16* buf1 = buf0 + 64 * TS;
    const float ksc = 1.0f / sqrtf((float)RDK);
    for (;;) {
        int lane = tid & 63; OPAQUE_V(lane);
        const int task = q_pop_wave(q_ctr(p, l, 0), lane); if (task >= NB * RH * NCH) break;
        const int fr = lane & 15, fq = lane >> 4;
        const int c = task % NCH, h = (task / NCH) % RH, b = task / (NCH * RH);
        const bf16* base = p.pj + (size_t)ret_row0(b, c) * INW + h * RDK;
        WAVE_LDS_FENCE();
        u32x4 vv[8];
        { u32x4 kv[8]; stage_tile_T_ld(kv, base + RK_OFF, INW, lane); stage_tile_T_ld(vv, base + RV_OFF, INW, lane);
          stage_tile_T_st(buf1, kv, lane, 0.f, 0, 1.0f); }
        for (int dir = 0; dir < 2; ++dir) {
            const float lg = -expf(p.ret_decay[(l * 2 + dir) * RH + h]);
            WAVE_LDS_FENCE();
            stage_tile_T_st(buf0, vv, lane, lg, dir == 0 ? 1 : 2, ksc);
            WAVE_LDS_FENCE();
            f32x4 acc[4][4];
#pragma unroll
            for (int a = 0; a < 4; ++a)
#pragma unroll
                for (int bb = 0; bb < 4; ++bb) acc[a][bb] = (f32x4){0.f, 0.f, 0.f, 0.f};
#pragma unroll
            for (int ks = 0; ks < 2; ++ks) {
                bf16x8 af[4], bfr[4];
#pragma unroll
                for (int a = 0; a < 4; ++a) { af[a] = ldfrag(buf0, 16 * a + fr, 32 * ks + 8 * fq); bfr[a] = ldfrag(buf1, 16 * a + fr, 32 * ks + 8 * fq); }
#pragma unroll
                for (int a = 0; a < 4; ++a)
#pragma unroll
                    for (int bb = 0; bb < 4; ++bb) acc[a][bb] = __builtin_amdgcn_mfma_f32_16x16x32_bf16(af[a], bfr[bb], acc[a][bb], 0, 0, 0);
            }
            WAVE_LDS_FENCE();
#pragma unroll
            for (int a = 0; a < 4; ++a)
#pragma unroll
                for (int bb = 0; bb < 4; ++bb)
#pragma unroll
                    for (int j = 0; j < 4; ++j) buf0[(16 * a + 4 * fq + j) * TS + 16 * bb + fr] = (bf16)f2bf(acc[a][bb][j]);
            WAVE_LDS_FENCE();
            { bf16* out = p.rs16 + rs_off(dir, b, h, c);
#pragma unroll 4
              for (int it = 0; it < 8; ++it) { const int r = it * 8 + (lane >> 3), cc = lane & 7; *(u32x4*)(out + r * RDK + cc * 8) = *(const LAS u32x4*)(buf0 + r * TS + cc * 8); } }
        }
    }
}
HD void ph_retscan(const P& p, int l, long gid) {
    const int e2 = (int)(gid % (RDK * RDK / 2)); int r = (int)(gid / (RDK * RDK / 2)); const int h = r % RH; r /= RH; const int b = r % NB, dir = r / NB;
    const float lg = -expf(p.ret_decay[(l * 2 + dir) * RH + h]); const float dec = expf(lg * (float)RCH);
    float c0 = 0.f, c1 = 0.f;
    static_assert(NCH % 12 == 0, "scan batches 12 chunks per trip");
    for (int s0 = 0; s0 < NCH; s0 += 12) {
        unsigned* ptr[12]; unsigned tv[12];
#pragma unroll
        for (int u = 0; u < 12; ++u) { const int step = s0 + u; const int c = dir == 0 ? step : (step < NCHC ? NCHC - 1 - step : NCH - 1 - (step - NCHC)); ptr[u] = (unsigned*)(p.rs16 + rs_off(dir, b, h, c)) + e2; tv[u] = *ptr[u]; }
#pragma unroll
        for (int u = 0; u < 12; ++u) { *ptr[u] = pk2f(c0, c1); c0 = dec * c0 + bf2f((bf16)(tv[u] & 0xffffu)); c1 = dec * c1 + bf2f((bf16)(tv[u] >> 16)); }
    }
}
HD void ph_retC(const P& p, int l, LAS unsigned char* lds, bool with_ctx) {
    int tid = threadIdx.x; OPAQUE_V(tid); const int wave = __builtin_amdgcn_readfirstlane(tid >> 6);
    LAS bf16* buf0 = (LAS bf16*)(lds + wave * WAVE_LDS); LAS bf16* buf1 = buf0 + 64 * TS;
    const float ksc = 1.0f / sqrtf((float)RDK);
    const int nch = with_ctx ? NCH : NCH - NCHC;
    for (;;) {
        int lane = tid & 63; OPAQUE_V(lane);
        const int task = q_pop_wave(q_ctr(p, l, 1), lane); if (task >= NB * RH * nch) break;
        const int fr = lane & 15, fq = lane >> 4;
        const int c = task % nch + (NCH - nch), h = (task / nch) % RH, b = task / (nch * RH);
        const int row0 = ret_row0(b, c);
        const bf16* base = p.pj + (size_t)row0 * INW + h * RDK;
        const float lgf = -expf(p.ret_decay[(l * 2 + 0) * RH + h]), lgb = -expf(p.ret_decay[(l * 2 + 1) * RH + h]);
        WAVE_LDS_FENCE();
        { u32x4 qv[8], kv[8]; stage_tile_ld(qv, base + RQ_OFF, INW, lane); stage_tile_ld(kv, base + RK_OFF, INW, lane); stage_tile_st(buf0, qv, lane); stage_tile_st(buf1, kv, lane); }
        WAVE_LDS_FENCE();
        bf16x8 qa[4][2];
#pragma unroll
        for (int a = 0; a < 4; ++a)
#pragma unroll
            for (int ks = 0; ks < 2; ++ks) qa[a][ks] = ldfrag(buf0, 16 * a + fr, 32 * ks + 8 * fq);
        f32x4 O[4][4];
#pragma unroll
        for (int a = 0; a < 4; ++a)
#pragma unroll
            for (int bb = 0; bb < 4; ++bb) O[a][bb] = (f32x4){0.f, 0.f, 0.f, 0.f};
#pragma unroll 1
        for (int dir = 0; dir < 2; ++dir) {
            WAVE_LDS_FENCE();
            stage_tile(buf0, p.rs16 + rs_off(dir, b, h, c), RDK, lane);
            WAVE_LDS_FENCE();
            const float lgd = dir == 0 ? lgf : lgb;
#pragma unroll
            for (int bb = 0; bb < 4; ++bb) {
                f32x4 tmp[4];
#pragma unroll
                for (int a = 0; a < 4; ++a) tmp[a] = (f32x4){0.f, 0.f, 0.f, 0.f};
#pragma unroll
                for (int ks = 0; ks < 2; ++ks) { const bf16x8 rb = ldfrag(buf0, 16 * bb + fr, 32 * ks + 8 * fq);
#pragma unroll
                    for (int a = 0; a < 4; ++a) tmp[a] = __builtin_amdgcn_mfma_f32_16x16x32_bf16(qa[a][ks], rb, tmp[a], 0, 0, 0); }
#pragma unroll
                for (int a = 0; a < 4; ++a)
#pragma unroll
                    for (int j = 0; j < 4; ++j) { const int i = 16 * a + 4 * fq + j; const float xi = __expf(lgd * (float)(dir == 0 ? i + 1 : RCH - i)); O[a][bb][j] += xi * tmp[a][j]; }
                SCHED_FENCE();
            }
        }
        WAVE_LDS_FENCE();
#pragma unroll
        for (int bb = 0; bb < 4; ++bb) {
            f32x4 S4[4];
#pragma unroll
            for (int a = 0; a < 4; ++a) S4[a] = (f32x4){0.f, 0.f, 0.f, 0.f};
#pragma unroll
            for (int ks = 0; ks < 2; ++ks) { const bf16x8 kb = ldfrag(buf1, 16 * bb + fr, 32 * ks + 8 * fq);
#pragma unroll
                for (int a = 0; a < 4; ++a) S4[a] = __builtin_amdgcn_mfma_f32_16x16x32_bf16(qa[a][ks], kb, S4[a], 0, 0, 0); }
#pragma unroll
            for (int a = 0; a < 4; ++a)
#pragma unroll
                for (int j = 0; j < 4; ++j) { const int i = 16 * a + 4 * fq + j, jj = 16 * bb + fr;
                    const float m = (i >= jj ? __expf(lgf * (float)(i - jj)) : 0.f) + (jj >= i ? __expf(lgb * (float)(jj - i)) : 0.f);
                    buf0[i * TS + jj] = (bf16)f2bf(S4[a][j] * m * ksc); }
            SCHED_FENCE();
        }
        WAVE_LDS_FENCE();
        stage_tile_T(buf1, base + RV_OFF, INW, lane, 0.f, 0, 1.0f);
        WAVE_LDS_FENCE();
#pragma unroll
        for (int ks = 0; ks < 2; ++ks) {
            bf16x8 pa[4], vb[4];
#pragma unroll
            for (int a = 0; a < 4; ++a) { pa[a] = ldfrag(buf0, 16 * a + fr, 32 * ks + 8 * fq); vb[a] = ldfrag(buf1, 16 * a + fr, 32 * ks + 8 * fq); }
#pragma unroll
            for (int a = 0; a < 4; ++a)
#pragma unroll
                for (int bb = 0; bb < 4; ++bb) O[a][bb] = __builtin_amdgcn_mfma_f32_16x16x32_bf16(pa[a], vb[bb], O[a][bb], 0, 0, 0);
        }
        WAVE_LDS_FENCE();
        stage_tile(buf1, base + RG_OFF, INW, lane);
        WAVE_LDS_FENCE();
#pragma unroll
        for (int a = 0; a < 4; ++a)
#pragma unroll
            for (int j = 0; j < 4; ++j) {
                float s = (O[a][0][j] + O[a][1][j]) + (O[a][2][j] + O[a][3][j]);
                s = row16_sum(s);
                const float mu = s * (1.0f / RDK);
                float q = 0.f;
#pragma unroll
                for (int bb = 0; bb < 4; ++bb) { const float d = O[a][bb][j] - mu; q += d * d; }
                q = row16_sum(q);
                const float rstd = rsq_f(q * (1.0f / RDK) + LN_EPS);
                const int i = 16 * a + 4 * fq + j;
#pragma unroll
                for (int bb = 0; bb < 4; ++bb) { const int v = 16 * bb + fr; const float g = bf2f(buf1[i * TS + v]);
                    buf0[i * TS + v] = (bf16)f2bf(silu_f(g) * (O[a][bb][j] - mu) * rstd); }
                SCHED_FENCE();
            }
        WAVE_LDS_FENCE();
        { bf16* orow = p.mix + (size_t)row0 * D + 3 * QW + h * RDK;
#pragma unroll 2
          for (int it = 0; it < 8; ++it) { const int r = it * 8 + (lane >> 3), cc = lane & 7; *(u32x4*)(orow + (size_t)r * D + cc * 8) = *(const LAS u32x4*)(buf0 + r * TS + cc * 8); } }
    }
}

constexpr int NJ = D / 256;
HD float wave_sum(float v) { v = row16_sum(v); return (rdlane(v, 0) + rdlane(v, 16)) + (rdlane(v, 32) + rdlane(v, 48)); }
HD void row_stats(const f32x4 (&v)[NJ], float& mu, float& rstd) {
    float s = 0.f;
#pragma unroll
    for (int j = 0; j < NJ; ++j) s += (v[j][0] + v[j][1]) + (v[j][2] + v[j][3]);
    mu = wave_sum(s) * (1.0f / D); float q = 0.f;
#pragma unroll
    for (int j = 0; j < NJ; ++j) { const f32x4 d = v[j] - mu; q += (d[0] * d[0] + d[1] * d[1]) + (d[2] * d[2] + d[3] * d[3]); }
    rstd = rsq_f(wave_sum(q) * (1.0f / D) + LN_EPS);
}
HD f32x4 ld4(const float* p) { return *(const f32x4*)p; }
HD f32x4 ld4bf(const bf16* p) { const u32x2 u = *(const u32x2*)p; f32x4 r; r[0] = bf2f((bf16)(u.x & 0xffffu)); r[1] = bf2f((bf16)(u.x >> 16)); r[2] = bf2f((bf16)(u.y & 0xffffu)); r[3] = bf2f((bf16)(u.y >> 16)); return r; }
HD void st4bf(bf16* p, f32x4 v) { u32x2 o; o.x = pk2f(v[0], v[1]); o.y = pk2f(v[2], v[3]); *(u32x2*)p = o; }
HD void row_lnmod_store(const P& p, int l, int which, int t, const f32x4 (&v)[NJ], int lane, f32x4 (*keep)[NJ], bool as_fp8 = false) {
    float mu, rstd; row_stats(v, mu, rstd);
    const int slot = row_slot(t); const float* sh = modp(p, l, slot, which); const float* sc = modp(p, l, slot, which + 1);
#pragma unroll
    for (int j = 0; j < NJ; ++j) { const int c = 4 * lane + 256 * j; const f32x4 h = (v[j] - mu) * rstd * (ld4(sc + c) + 1.0f) + ld4(sh + c);
        if (as_fp8) *(unsigned*)(p.hb8 + (size_t)t * D + c) = pk4_fp8(h[0], h[1], h[2], h[3]); else st4bf(p.hb + (size_t)t * D + c, h);
        if (keep) (*keep)[j] = h; }
}
HD void ph_mod_block(const P& p, LAS unsigned char* lds) {
    int tid = threadIdx.x; OPAQUE_V(tid);
    LAS float* sl = (LAS float*)lds;
    LAS float* red = sl + (NB + 1) * D;
    static_assert(((NB + 1) * D + 8 * (NB + 1) * 64) * 4 <= 147456 && D % 256 == 0 && (NB + 1) * 64 <= NWV * 64, "mod GEMV LDS / shape");
    for (int i = tid; i < (NB + 1) * D; i += NWV * 64) { const int slot = i / D, k = i % D; sl[i] = silu_f(slot < NB ? p.c[(size_t)slot * D + k] : p.c_ctx[k]); }
    __syncthreads();
    constexpr int GPL = 6 * D / 64, KP = D / 8;
    for (int grp = blockIdx.x; grp < DEPTH * GPL; grp += gridDim.x) {
        const int l = grp / GPL, j0 = (grp % GPL) * 64, col = tid & 63, kp = tid >> 6;
        const float* w = p.w_mod + ((size_t)l * D + (size_t)kp * KP) * 6 * D + j0 + col;
        float acc[NB + 1];
#pragma unroll
        for (int sidx = 0; sidx <= NB; ++sidx) acc[sidx] = 0.f;
        for (int k0 = 0; k0 < KP; k0 += 32) {
            float wv[32];
#pragma unroll
            for (int u = 0; u < 32; ++u) wv[u] = w[(size_t)(k0 + u) * 6 * D];
#pragma unroll
            for (int u = 0; u < 32; ++u)
#pragma unroll
                for (int sidx = 0; sidx <= NB; ++sidx) acc[sidx] += sl[sidx * D + kp * KP + k0 + u] * wv[u];
        }
#pragma unroll
        for (int sidx = 0; sidx <= NB; ++sidx) red[(kp * (NB + 1) + sidx) * 64 + col] = acc[sidx];
        __syncthreads();
        if (tid < (NB + 1) * 64) { const int sidx = tid >> 6; float t = p.b_mod[(size_t)l * 6 * D + j0 + col];
#pragma unroll
            for (int q = 0; q < 8; ++q) t += red[(q * (NB + 1) + sidx) * 64 + col];
            p.mod[((size_t)l * (NB + 1) + sidx) * 6 * D + j0 + col] = t; }
        __syncthreads();
    }
}
HD void ln0_row(const P& p, int t, bool live, int lane) {
    const float* src = t < TC ? p.ctx + (size_t)t * D : p.x + (size_t)(t - TC) * D;
    f32x4 v[NJ];
#pragma unroll
    for (int j = 0; j < NJ; ++j) v[j] = ld4(src + 4 * lane + 256 * j);
    float mu, rstd; row_stats(v, mu, rstd);
    const int slot = row_slot(t); const float* sh = modp(p, 0, slot, 0); const float* sc = modp(p, 0, slot, 1);
    if (live) {
#pragma unroll
        for (int j = 0; j < NJ; ++j) { const int c = 4 * lane + 256 * j; st4bf(p.hb + (size_t)t * D + c, (v[j] - mu) * rstd * (ld4(sc + c) + 1.0f) + ld4(sh + c)); } }
}
HD void ph_rows_ln0(const P& p, LAS unsigned char* lds) {
    int tid = threadIdx.x; OPAQUE_V(tid); const int wave = __builtin_amdgcn_readfirstlane(tid >> 6);
    for (int t = blockIdx.x * NWV + wave; t < T; t += 2 * gridDim.x * NWV) {
        int lane = tid & 63; OPAQUE_V(lane);
        const int t2 = t + gridDim.x * NWV; const bool live2 = t2 < T;
        ln0_row(p, t, true, lane); ln0_row(p, live2 ? t2 : t, live2, lane);
    }
}
#ifndef CPU_TEST
#define LDS_ATOMIC_INC(ptr) __hip_atomic_fetch_add((ptr), 1, __ATOMIC_RELAXED, __HIP_MEMORY_SCOPE_WORKGROUP)
#else
#define LDS_ATOMIC_INC(ptr) ((*(ptr))++)
#endif
HD int rows_per_block(int tlo) { return (T - tlo + (int)gridDim.x - 1) / (int)gridDim.x; }
HD void ph_rows_res1(const P& p, int l, int tlo, LAS unsigned char* lds) {
    int tid = threadIdx.x; OPAQUE_V(tid); const int wave = __builtin_amdgcn_readfirstlane(tid >> 6);
    constexpr int WS_ = D + 8, NT = (NE + 15) / 16;
    LAS _Float16* wt = (LAS _Float16*)lds;
    LAS _Float16* ht = wt + NE * WS_ + wave * (4 * WS_);
    LAS int* hist = (LAS int*)(lds + (NE * WS_ + NWV * 4 * WS_) * 2);
    static_assert((NE * WS_ + NWV * 4 * WS_) * 2 + NE * 4 <= 147456 && NE <= 32 && D % 256 == 0, "router LDS");
    const int lane0 = tid & 63;
    { const float* rw = p.router_w + (size_t)l * D * NE;
      for (int idx = tid; idx < D * NE; idx += NWV * 64) { const int i = idx / NE, e = idx % NE; wt[e * WS_ + i] = (_Float16)rw[idx]; } }
    if (wave == 0) hist[lane0 % NE] = 0;
    __syncthreads();
    const float* lg = p.ln_g + (size_t)(l * 2 + 0) * D; const float* lb = p.ln_b + (size_t)(l * 2 + 0) * D;
    const int R = rows_per_block(tlo); const int rbeg = tlo + (int)blockIdx.x * R; const int rend = rbeg + R < T ? rbeg + R : T;
    const int nrows = rend - rbeg; const int nfull = (nrows / 32) * 8;
    const int nbatch = nfull + (nrows - nfull * 4);
    for (int bi = wave; bi < nbatch; bi += NWV) {
        int lane = tid & 63; OPAQUE_V(lane);
        const int fr = lane & 15, fq = lane >> 4;
        const int t0 = bi < nfull ? rbeg + 4 * bi : rbeg + 4 * nfull + (bi - nfull); const int nr = bi < nfull ? 4 : 1;
        WAVE_LDS_FENCE();
#pragma unroll 2
        for (int r = 0; r < nr; ++r) {
            const int t = t0 + r; const int slot = row_slot(t); const float* g1 = modp(p, l, slot, 2);
            f32x4 v[NJ];
#pragma unroll
            for (int j = 0; j < NJ; ++j) { const int c = 4 * lane + 256 * j;
                const f32x4 xr = l == 0 ? ld4((t < TC ? p.ctx + (size_t)t * D : p.x + (size_t)(t - TC) * D) + c) : ld4bf(p.xs + (size_t)t * D + c);
                v[j] = xr * DN_ALPHA + ld4(g1 + c) * ld4bf(p.y + (size_t)t * D + c); }
            float mu, rstd; row_stats(v, mu, rstd);
#pragma unroll
            for (int j = 0; j < NJ; ++j) { const int c = 4 * lane + 256 * j; v[j] = (v[j] - mu) * rstd * ld4(lg + c) + ld4(lb + c); st4bf(p.xs + (size_t)t * D + c, v[j]); }
            float mu2, rstd2; row_stats(v, mu2, rstd2);
            const float* sh = modp(p, l, slot, 3); const float* sc = modp(p, l, slot, 4);
#pragma unroll
            for (int j = 0; j < NJ; ++j) { const int c = 4 * lane + 256 * j; const f32x4 h = (v[j] - mu2) * rstd2 * (ld4(sc + c) + 1.0f) + ld4(sh + c);
                *(unsigned*)(p.hb8 + (size_t)t * D + c) = pk4_fp8(h[0], h[1], h[2], h[3]);
                typedef _Float16 half4 __attribute__((ext_vector_type(4))); const half4 o = {(_Float16)h[0], (_Float16)h[1], (_Float16)h[2], (_Float16)h[3]}; *(LAS half4*)(ht + r * WS_ + c) = o; }
        }
        WAVE_LDS_FENCE();
        f32x4 acc[NT];
#pragma unroll
        for (int nt = 0; nt < NT; ++nt) acc[nt] = (f32x4){0.f, 0.f, 0.f, 0.f};
        { const int arow = nr == 4 ? (fr & 3) : 0;
#pragma unroll 4
          for (int ks = 0; ks < D / 32; ++ks) { const half8 a = *(const LAS half8*)(ht + arow * WS_ + 32 * ks + 8 * fq);
#pragma unroll
              for (int nt = 0; nt < NT; ++nt) { const int e = 16 * nt + fr; const half8 bw = *(const LAS half8*)(wt + (e < NE ? e : NE - 1) * WS_ + 32 * ks + 8 * fq);
                  acc[nt] = __builtin_amdgcn_mfma_f32_16x16x32_f16(a, bw, acc[nt], 0, 0, 0); } } }
        float lo = fq == 0 ? acc[0][0] : fq == 1 ? acc[0][1] : fq == 2 ? acc[0][2] : acc[0][3];
        float hi = -3.0e38f;
        if constexpr (NT > 1) hi = fq == 0 ? acc[NT - 1][0] : fq == 1 ? acc[NT - 1][1] : fq == 2 ? acc[NT - 1][2] : acc[NT - 1][3];
        lo = fr < NE ? lo + p.router_b[l * NE + fr] : -3.0e38f;
        if constexpr (NT > 1) hi = 16 + fr < NE ? hi + p.router_b[l * NE + (16 + fr < NE ? 16 + fr : 0)] : -3.0e38f;
        const bool rowlive = fq < nr; const int t = t0 + (rowlive ? fq : 0);
#ifdef CPU_TEST
        if (rowlive) { if (fr < NE) p.logits[(size_t)t * NE + fr] = lo; if (16 + fr < NE) p.logits[(size_t)t * NE + 16 + fr] = hi; }
#endif
        float tv0 = 0.f, tv1 = 0.f, tv2 = 0.f, tv3 = 0.f; int te0 = 0, te1 = 0, te2 = 0, te3 = 0;
#pragma unroll
        for (int k = 0; k < TOPK; ++k) {
            const float mx = row16_max(fmaxf(lo, hi));
            const unsigned blo = (unsigned)(__ballot(lo == mx) >> (16 * fq)) & 0xffffu, bhi = (unsigned)(__ballot(hi == mx) >> (16 * fq)) & 0xffffu;
            const int we = blo ? __builtin_ctz(blo) : 16 + __builtin_ctz(bhi | 0x10000u);
            if (k == 0) { tv0 = mx; te0 = we; } else if (k == 1) { tv1 = mx; te1 = we; } else if (k == 2) { tv2 = mx; te2 = we; } else { tv3 = mx; te3 = we; }
            if (we == fr) lo = -3.0e38f; if (we == 16 + fr) hi = -3.0e38f;
        }
        if (rowlive && fr < TOPK) { const float e1 = __expf(tv1 - tv0), e2 = __expf(tv2 - tv0), e3 = __expf(tv3 - tv0); const float rs = 1.0f / (1.0f + e1 + e2 + e3);
            const int ek = fr == 0 ? te0 : fr == 1 ? te1 : fr == 2 ? te2 : te3; const float gk = (fr == 0 ? 1.0f : fr == 1 ? e1 : fr == 2 ? e2 : e3) * rs;
            p.topi[(size_t)t * TOPK + fr] = ek; p.gate[(size_t)t * TOPK + fr] = gk; LDS_ATOMIC_INC(hist + ek); }
    }
    __syncthreads();
    if (wave == 0) p.blkcnt[((size_t)l * 1024 + blockIdx.x) * NE + lane0 % NE] = hist[lane0 % NE];
    __syncthreads();
}
HD void ph_dispatch(const P& p, int l, int tlo, LAS unsigned char* lds) {
    int tid = threadIdx.x; OPAQUE_V(tid); const int wave = __builtin_amdgcn_readfirstlane(tid >> 6), lane = tid & 63;
    LAS int* part = (LAS int*)lds;
    LAS int* tot = part + 16 * 2 * NE;
    LAS int* cur = tot + NE;
    LAS int* pst = cur + NE;
    LAS int* posl = pst + NE + 8;
    const int G = (int)gridDim.x, me = (int)blockIdx.x;
    { const int e = tid % NE, pt = tid / NE;
      const int pq = pt % 16; int st = 0, sb = 0; for (int b = pq; b < G; b += 16) { const int c = p.blkcnt[((size_t)l * 1024 + b) * NE + e]; st += c; sb += b < me ? c : 0; } part[(pq * 2 + 0) * NE + e] = st; part[(pq * 2 + 1) * NE + e] = sb; }
    __syncthreads();
    if (wave == 0) { const int e = lane % NE; int st = 0, sb = 0; for (int pt = 0; pt < 16; ++pt) { st += part[(pt * 2 + 0) * NE + e]; sb += part[(pt * 2 + 1) * NE + e]; } tot[e] = st; cur[e] = sb; }
    __syncthreads();
    if (wave == 0) { const int e = lane % NE; int s = 0, all = 0;
#pragma unroll
        for (int k = 0; k < NE; ++k) { const int pk = (tot[k] + MOEB - 1) / MOEB * MOEB; s += k < e ? pk : 0; all += pk; }
        const int ce = cur[e]; WAVE_LDS_FENCE(); pst[e] = s; cur[e] = ce + s; pst[NE] = all; }
    __syncthreads();
    if (me == 0) {
        const int nblk = pst[NE] / MOEB;
        for (int rb = tid; rb < nblk; rb += NWV * 64) { int e = 0;
#pragma unroll
            for (int k = 1; k < NE; ++k) e += pst[k] <= rb * MOEB ? 1 : 0;
            p.blke[rb] = e; }
        if (tid == 0) p.blke[NBLKMAX] = nblk;
    }
    const int R = rows_per_block(tlo); const int rbeg = tlo + me * R; const int rend = rbeg + R < T ? rbeg + R : T; const int na = (rend - rbeg) * TOPK;
    for (int a = tid; a < na; a += NWV * 64) { const int e = p.topi[(size_t)rbeg * TOPK + a]; const int ps = LDS_ATOMIC_INC(cur + e); posl[a] = ps; p.pos[(size_t)rbeg * TOPK + a] = ps; }
    __syncthreads();
    static_assert(D == 1024, "a gathered fp8 row is 64 lanes x 16 bytes");
    for (int a0 = wave * 8; a0 < na; a0 += NWV * 8) {
        u32x4 v[8]; int ps[8];
#pragma unroll
        for (int q = 0; q < 8; ++q) { const int a = a0 + q < na ? a0 + q : na - 1; ps[q] = posl[a]; const int t = rbeg + a / TOPK; v[q] = *(const u32x4*)(p.hb8 + (size_t)t * D + lane * 16); }
#pragma unroll
        for (int q = 0; q < 8; ++q) *(u32x4*)(p.as8 + (size_t)ps[q] * D + lane * 16) = v[q];
    }
    for (int i = me * NWV + wave; i < NE * MOEB; i += G * NWV) { const int e = i / MOEB, r = i % MOEB; const int row = pst[e] + tot[e] + r;
        if (row < pst[e + 1]) { unsigned zz = 0u; OPAQUE_V(zz); const u32x4 z = {zz, zz, zz, zz}; *(u32x4*)(p.as8 + (size_t)row * D + lane * 16) = z; } }
    __syncthreads();
}
HD void res2_row(const P& p, int l, int t, bool live, int lane, const float* lg, const float* lb) {
    const int slot = row_slot(t); const float* g2 = modp(p, l, slot, 5);
    const int* ps = p.pos + (size_t)t * TOPK; const float* ga = p.gate + (size_t)t * TOPK;
    const unsigned char* y0 = p.ym8 + (size_t)ps[0] * D; const unsigned char* y1 = p.ym8 + (size_t)ps[1] * D; const unsigned char* y2 = p.ym8 + (size_t)ps[2] * D; const unsigned char* y3 = p.ym8 + (size_t)ps[3] * D;
    const float a0 = ga[0], a1 = ga[1], a2 = ga[2], a3 = ga[3];
    f32x4 v[NJ];
#pragma unroll
    for (int j = 0; j < NJ; ++j) { const int c = 4 * lane + 256 * j;
        const f32x4 f = unpk4_fp8(*(const unsigned*)(y0 + c)) * a0 + unpk4_fp8(*(const unsigned*)(y1 + c)) * a1 + unpk4_fp8(*(const unsigned*)(y2 + c)) * a2 + unpk4_fp8(*(const unsigned*)(y3 + c)) * a3;
        v[j] = ld4bf(p.xs + (size_t)t * D + c) * DN_ALPHA + ld4(g2 + c) * f; }
    float mu, rstd; row_stats(v, mu, rstd);
#pragma unroll
    for (int j = 0; j < NJ; ++j) { const int c = 4 * lane + 256 * j; v[j] = (v[j] - mu) * rstd * ld4(lg + c) + ld4(lb + c); }
    if (l == DEPTH - 1) {
        if (live) {
#pragma unroll
            for (int j = 0; j < NJ; ++j) *(f32x4*)(p.out + (size_t)(t - TC) * D + 4 * lane + 256 * j) = v[j]; }
    } else {
        float mu2, rstd2; row_stats(v, mu2, rstd2);
        const float* sh = modp(p, l + 1, slot, 0); const float* sc = modp(p, l + 1, slot, 1);
        if (live) {
#pragma unroll
            for (int j = 0; j < NJ; ++j) { const int c = 4 * lane + 256 * j; st4bf(p.xs + (size_t)t * D + c, v[j]); st4bf(p.hb + (size_t)t * D + c, (v[j] - mu2) * rstd2 * (ld4(sc + c) + 1.0f) + ld4(sh + c)); } }
    }
}
HD void ph_rows_res2(const P& p, int l, int tlo, LAS unsigned char* lds) {
    int tid = threadIdx.x; OPAQUE_V(tid); const int wave = __builtin_amdgcn_readfirstlane(tid >> 6);
    const float* lg = p.ln_g + (size_t)(l * 2 + 1) * D; const float* lb = p.ln_b + (size_t)(l * 2 + 1) * D;
    for (int t = tlo + blockIdx.x * NWV + wave; t < T; t += 2 * gridDim.x * NWV) {
        int lane = tid & 63; OPAQUE_V(lane);
        const int t2 = t + gridDim.x * NWV; const bool live2 = t2 < T;
        res2_row(p, l, t, true, lane, lg, lb);
        res2_row(p, l, live2 ? t2 : t, live2, lane, lg, lb);
    }
}
HD void ph_rtab(const P& p, long gid) { const int j = (int)(gid % 16), pos = (int)(gid / 16); const float inv = powf(ROPE_BASE, -(float)(2 * j) / 32.0f); const float a = (float)pos * inv; p.rtab[2 * gid] = cosf(a); p.rtab[2 * gid + 1] = sinf(a); }
HD void stage_tile_rope_ld(u32x4 (&v)[8], const bf16* src, size_t gs, int lane) {
    const int q = lane & 3, hf = q >> 1, sc = q & 1; const int c1 = 32 * hf + 8 * sc;
#pragma unroll
    for (int it = 0; it < 4; ++it) { const int r = it * 16 + (lane >> 2); v[2 * it] = *(const u32x4*)(src + (size_t)r * gs + c1); v[2 * it + 1] = *(const u32x4*)(src + (size_t)r * gs + c1 + 16); }
}
HD void stage_tile_rope_st(LAS bf16* dst, const u32x4 (&v)[8], int lane, int n0, const float* rtab) {
    static_assert(GW == 64 || GW == 32 || GW == 16, "grid width");
    const int q = lane & 3, hf = q >> 1, sc = q & 1; const int c1 = 32 * hf + 8 * sc;
#pragma unroll
    for (int it = 0; it < 4; ++it) { const int r = it * 16 + (lane >> 2); const int n = n0 + r; const int pos = hf == 0 ? n / GW : n % GW;
        const u32x4 a = v[2 * it], b = v[2 * it + 1];
        const f32x4* tp = (const f32x4*)(rtab + (size_t)(pos * 16 + 8 * sc) * 2);
        u32x4 oa, ob;
#pragma unroll
        for (int e = 0; e < 4; ++e) { const f32x4 t = tp[e];
            const float x1l = bf2f((bf16)(a[e] & 0xffffu)), x1h = bf2f((bf16)(a[e] >> 16)), x2l = bf2f((bf16)(b[e] & 0xffffu)), x2h = bf2f((bf16)(b[e] >> 16));
            oa[e] = pk2f(x1l * t[0] - x2l * t[1], x1h * t[2] - x2h * t[3]); ob[e] = pk2f(x2l * t[0] + x1l * t[1], x2h * t[2] + x1h * t[3]); }
        *(LAS u32x4*)(dst + r * TS + c1) = oa; *(LAS u32x4*)(dst + r * TS + c1 + 16) = ob; }
}
HD void stage_tile_rope(LAS bf16* dst, const bf16* src, size_t gs, int lane, int n0, const float* rtab) {
    const int q = lane & 3, hf = q >> 1, sc = q & 1; const int c1 = 32 * hf + 8 * sc;
#pragma unroll 2
    for (int it = 0; it < 4; ++it) { const int r = it * 16 + (lane >> 2); const int n = n0 + r; const int pos = hf == 0 ? n / GW : n % GW;
        const u32x4 a = *(const u32x4*)(src + (size_t)r * gs + c1), b = *(const u32x4*)(src + (size_t)r * gs + c1 + 16);
        const f32x4* tp = (const f32x4*)(rtab + (size_t)(pos * 16 + 8 * sc) * 2);
        u32x4 oa, ob;
#pragma unroll
        for (int e = 0; e < 4; ++e) { const f32x4 t = tp[e];
            const float x1l = bf2f((bf16)(a[e] & 0xffffu)), x1h = bf2f((bf16)(a[e] >> 16)), x2l = bf2f((bf16)(b[e] & 0xffffu)), x2h = bf2f((bf16)(b[e] >> 16));
            oa[e] = pk2f(x1l * t[0] - x2l * t[1], x1h * t[2] - x2h * t[3]); ob[e] = pk2f(x2l * t[0] + x1l * t[1], x2h * t[2] + x1h * t[3]); }
        *(LAS u32x4*)(dst + r * TS + c1) = oa; *(LAS u32x4*)(dst + r * TS + c1 + 16) = ob; }
}
HD void ph_attn_wave(const P& p, int l, LAS unsigned char* lds, bool with_ctx) {
    static_assert(HDIM == 64 && WIN == 128 && SEQ % 64 == 0 && LCTX % 64 == 0, "attention wave kernel is written for head dim 64, window 128");
    int tid = threadIdx.x; OPAQUE_V(tid); const int wave = __builtin_amdgcn_readfirstlane(tid >> 6);
    LAS bf16* buf0 = (LAS bf16*)(lds + wave * WAVE_LDS); LAS bf16* buf1 = buf0 + 64 * TS;
    constexpr int NQB = SEQ / 64, NCB = LCTX / 64, NLAT = NB * NH * NQB;
    const int ntask = NLAT + (with_ctx ? NB * NH * NCB : 0);
    for (;;) {
        int lane = tid & 63; OPAQUE_V(lane);
        const int task = q_pop_wave(q_ctr(p, l, 2), lane); if (task >= ntask) break;
        const int fr = lane & 15, fq = lane >> 4;
        const bool isctx = task >= NLAT; const int r = isctx ? task - NLAT : task; const int nqb = isctx ? NCB : NQB;
        const int qb = r % nqb, h = (r / nqb) % NH, b = r / (nqb * NH), kvh = h / GQ;
        const int qrow0 = isctx ? b * LCTX + qb * 64 : TC + b * SEQ + qb * 64;
        WAVE_LDS_FENCE();
        if (isctx) stage_tile(buf0, p.pj + (size_t)qrow0 * INW + Q_OFF + h * HDIM, INW, lane);
        else stage_tile_rope(buf0, p.pj + (size_t)qrow0 * INW + Q_OFF + h * HDIM, INW, lane, qb * 64, p.rtab);
        WAVE_LDS_FENCE();
        bf16x8 qa[4][2];
#pragma unroll
        for (int a = 0; a < 4; ++a)
#pragma unroll
            for (int ks = 0; ks < 2; ++ks) qa[a][ks] = ldfrag(buf0, 16 * a + fr, 32 * ks + 8 * fq);
        f32x4 O[4][4]; float m[4][4], ls[4][4];
        const float sink = p.attn_sink[l * NH + h];
#pragma unroll
        for (int a = 0; a < 4; ++a)
#pragma unroll
            for (int j = 0; j < 4; ++j) { m[a][j] = sink; ls[a][j] = 1.0f; O[a][j] = (f32x4){0.f, 0.f, 0.f, 0.f}; }
        const int nloc = isctx ? 0 : 5;
#pragma unroll 1
        for (int kt = 0; kt < nloc + NCB; ++kt) {
            int krow0, mtype = 0, kn0 = -1;
            if (kt < nloc) { const int tt = kt - 2; const int ks0 = qb * 64 + 64 * tt; if (ks0 < 0 || ks0 >= SEQ) continue; krow0 = TC + b * SEQ + ks0; kn0 = ks0; mtype = tt == -2 ? 1 : (tt == 2 ? 2 : 0); }
            else krow0 = b * LCTX + (kt - nloc) * 64;
            WAVE_LDS_FENCE();
            if (kn0 < 0) stage_tile(buf0, p.pj + (size_t)krow0 * INW + K_OFF + kvh * HDIM, INW, lane);
            else stage_tile_rope(buf0, p.pj + (size_t)krow0 * INW + K_OFF + kvh * HDIM, INW, lane, kn0, p.rtab);
            stage_tile_T(buf1, p.pj + (size_t)krow0 * INW + V_OFF + kvh * HDIM, INW, lane, 0.f, 0, 1.0f);
            WAVE_LDS_FENCE();
            f32x4 S[4][4];
#pragma unroll
            for (int a = 0; a < 4; ++a)
#pragma unroll
                for (int bb = 0; bb < 4; ++bb) S[a][bb] = (f32x4){0.f, 0.f, 0.f, 0.f};
#pragma unroll
            for (int bb = 0; bb < 4; ++bb)
#pragma unroll
                for (int ks = 0; ks < 2; ++ks) { const bf16x8 kb = ldfrag(buf0, 16 * bb + fr, 32 * ks + 8 * fq);
#pragma unroll
                    for (int a = 0; a < 4; ++a) S[a][bb] = __builtin_amdgcn_mfma_f32_16x16x32_bf16(qa[a][ks], kb, S[a][bb], 0, 0, 0); }
#pragma unroll
            for (int a = 0; a < 4; ++a)
#pragma unroll
                for (int bb = 0; bb < 4; ++bb) S[a][bb] = S[a][bb] * 0.125f;
            WAVE_LDS_FENCE();
            int frk = fr, fqk = fq; OPAQUE_V(frk); OPAQUE_V(fqk);
#pragma unroll
            for (int a = 0; a < 4; ++a)
#pragma unroll
                for (int j = 0; j < 4; ++j) {
                    const int i = 16 * a + 4 * fqk + j;
                    float mx = -3.0e38f;
                    if (mtype != 0) {
#pragma unroll
                        for (int bb = 0; bb < 4; ++bb) { const int jj = 16 * bb + frk; if ((mtype == 1 && jj < i) || (mtype == 2 && jj > i)) S[a][bb][j] = -1.0e30f; } }
#pragma unroll
                    for (int bb = 0; bb < 4; ++bb) mx = fmaxf(mx, S[a][bb][j]);
                    mx = row16_max(mx);
                    const float mn = fmaxf(m[a][j], mx); const float alpha = __expf(m[a][j] - mn); m[a][j] = mn;
                    float rs = 0.f;
#pragma unroll
                    for (int bb = 0; bb < 4; ++bb) { const float pe = __expf(S[a][bb][j] - mn); rs += pe; buf0[i * TS + 16 * bb + frk] = (bf16)f2bf(pe); }
                    rs = row16_sum(rs);
                    ls[a][j] = ls[a][j] * alpha + rs;
#pragma unroll
                    for (int vb = 0; vb < 4; ++vb) O[a][vb][j] *= alpha;
                    SCHED_FENCE();
                }
            WAVE_LDS_FENCE();
#pragma unroll
            for (int ks = 0; ks < 2; ++ks) {
                bf16x8 pa[4], vb[4];
#pragma unroll
                for (int a = 0; a < 4; ++a) { pa[a] = ldfrag(buf0, 16 * a + fr, 32 * ks + 8 * fq); vb[a] = ldfrag(buf1, 16 * a + fr, 32 * ks + 8 * fq); }
#pragma unroll
                for (int a = 0; a < 4; ++a)
#pragma unroll
                    for (int bb = 0; bb < 4; ++bb) O[a][bb] = __builtin_amdgcn_mfma_f32_16x16x32_bf16(pa[a], vb[bb], O[a][bb], 0, 0, 0);
            }
        }
        WAVE_LDS_FENCE();
#pragma unroll
        for (int a = 0; a < 4; ++a)
#pragma unroll
            for (int j = 0; j < 4; ++j) { const float rl = rcp_f(ls[a][j]); const int i = 16 * a + 4 * fq + j;
#pragma unroll
                for (int vb = 0; vb < 4; ++vb) buf0[i * TS + 16 * vb + fr] = (bf16)f2bf(O[a][vb][j] * rl); }
        WAVE_LDS_FENCE();
        { bf16* orow = p.mix + (size_t)qrow0 * D + 2 * QW + h * HDIM;
#pragma unroll 2
          for (int it = 0; it < 8; ++it) { const int rr = it * 8 + (lane >> 3), cc = lane & 7; *(u32x4*)(orow + (size_t)rr * D + cc * 8) = *(const LAS u32x4*)(buf0 + rr * TS + cc * 8); } }
    }
}

constexpr int FN1 = SEQ / 64;
HD void ph_ftab(const P& p, long gid) {
    if (gid < 2 * 64 * 64) { const int s = (int)(gid / 4096), r = (int)(gid % 4096) / 64, k = (int)(gid % 64); const float a = 2.0f * (float)((r * k) % 64) / 64.0f; p.ft64[gid] = (bf16)f2bf(s == 0 ? cospif(a) : sinpif(a)); }
    else { const long g2 = gid - 2 * 64 * 64; const int s = (int)(g2 / (FN1 * FN1)), r = (int)(g2 % (FN1 * FN1)) / FN1, k = (int)(g2 % FN1); const float a = 2.0f * (float)((r * k) % FN1) / (float)FN1; p.ft128[g2] = (bf16)f2bf(s == 0 ? cospif(a) : sinpif(a)); }
}
constexpr int XS = FN1 + 8;
HD void ph_fftA(const P& p, int l, LAS unsigned char* lds) {
    static_assert(FC == 64 && FN1 % 32 == 0 && FN1 <= 16 * NWV && SEQ == 64 * FN1, "FFT stage A is written for 64 channels per group and SEQ = 64 * 128");
    int tid = threadIdx.x; OPAQUE_V(tid); const int wave = __builtin_amdgcn_readfirstlane(tid >> 6);
    constexpr int NRT = FN1 / 16;
    LAS bf16* xt = (LAS bf16*)lds;
    LAS bf16* w64 = xt + 64 * XS;
    LAS bf16* ul = w64 + 2 * 64 * TS + wave * (2 * 16 * TS);
    static_assert((64 * XS + 2 * 64 * TS + NWV * 2 * 16 * TS) * 2 <= 147456, "FFT stage A LDS");
    __syncthreads();
    for (int i = tid; i < 2 * 64 * 8; i += NWV * 64) { const int r = i >> 3, cc = i & 7; *(LAS u32x4*)(w64 + r * TS + cc * 8) = *(const u32x4*)(p.ft64 + r * 64 + cc * 8); }
    constexpr int KST = FN1 / 32;
    bf16x8 wc[KST], wsn[KST];
    {
        const int lane0 = tid & 63, fr0 = lane0 & 15, fq0 = lane0 >> 4;
#pragma unroll
        for (int ks = 0; ks < KST; ++ks) {
            const int row = 16 * (wave % NRT) + fr0, k = 32 * ks + 8 * fq0;

            wc[ks] = *(const bf16x8*)(p.ft128 + row * FN1 + k); wsn[ks] = *(const bf16x8*)(p.ft128 + FN1 * FN1 + row * FN1 + k);
        }
    }
    const int ntask = NB * FG * 64;
    LAS int* qslot = (LAS int*)(lds + 147456 - 64);
    for (;;) {
        int lane = tid & 63; OPAQUE_V(lane);
        const int fr = lane & 15, fq = lane >> 4;
        __syncthreads();
        if (wave == 0) { const int tk = q_pop_wave(q_ctr(p, l, 5), lane); if (lane == 0) *qslot = tk; }
        __syncthreads();
        const int task = *qslot; if (task >= ntask) break;
        const int n2 = task % 64, g = (task / 64) % FG, b = task / (64 * FG);
        for (int i = tid; i < FN1 * 8; i += NWV * 64) { const int n1 = i % FN1, cc = i / FN1;
            const u32x4 v = *(const u32x4*)(p.pj + (size_t)(TC + b * SEQ + n1 * 64 + n2) * INW + A_OFF + g * FC + cc * 8);
#pragma unroll
            for (int e = 0; e < 4; ++e) { xt[(cc * 8 + 2 * e) * XS + n1] = (bf16)(v[e] & 0xffffu); xt[(cc * 8 + 2 * e + 1) * XS + n1] = (bf16)(v[e] >> 16); } }
        __syncthreads();
        if (wave < NRT) {
            f32x4 Uc[4], Us[4];
#pragma unroll
            for (int ct = 0; ct < 4; ++ct) { Uc[ct] = (f32x4){0.f, 0.f, 0.f, 0.f}; Us[ct] = (f32x4){0.f, 0.f, 0.f, 0.f}; }
#pragma unroll
            for (int ks = 0; ks < KST; ++ks)
#pragma unroll
                for (int ct = 0; ct < 4; ++ct) { const bf16x8 xb = *(const LAS bf16x8*)(xt + (16 * ct + fr) * XS + 32 * ks + 8 * fq);
                    Uc[ct] = __builtin_amdgcn_mfma_f32_16x16x32_bf16(wc[ks], xb, Uc[ct], 0, 0, 0); Us[ct] = __builtin_amdgcn_mfma_f32_16x16x32_bf16(wsn[ks], xb, Us[ct], 0, 0, 0); }
            WAVE_LDS_FENCE();
#pragma unroll
            for (int ct = 0; ct < 4; ++ct)
#pragma unroll
                for (int j = 0; j < 4; ++j) { ul[(4 * fq + j) * TS + 16 * ct + fr] = (bf16)f2bf(Uc[ct][j]); ul[(16 + 4 * fq + j) * TS + 16 * ct + fr] = (bf16)f2bf(Us[ct][j]); }
            WAVE_LDS_FENCE();
            f32x4 T1[4], T2[4], T3[4];
#pragma unroll
            for (int ct = 0; ct < 4; ++ct) { T1[ct] = (f32x4){0.f, 0.f, 0.f, 0.f}; T2[ct] = (f32x4){0.f, 0.f, 0.f, 0.f}; T3[ct] = (f32x4){0.f, 0.f, 0.f, 0.f}; }
#pragma unroll
            for (int ks = 0; ks < 2; ++ks) { const bf16x8 uc = ldfrag(ul, fr, 32 * ks + 8 * fq), us = ldfrag(ul + 16 * TS, fr, 32 * ks + 8 * fq);
#pragma unroll
                for (int ct = 0; ct < 4; ++ct) { const bf16x8 cb = ldfrag(w64, 16 * ct + fr, 32 * ks + 8 * fq), sb = ldfrag(w64 + 64 * TS, 16 * ct + fr, 32 * ks + 8 * fq);
                    T1[ct] = __builtin_amdgcn_mfma_f32_16x16x32_bf16(uc, cb, T1[ct], 0, 0, 0); T2[ct] = __builtin_amdgcn_mfma_f32_16x16x32_bf16(us, sb, T2[ct], 0, 0, 0);
                    T3[ct] = __builtin_amdgcn_mfma_f32_16x16x32_bf16(uc, sb, T3[ct], 0, 0, 0); T3[ct] = __builtin_amdgcn_mfma_f32_16x16x32_bf16(us, cb, T3[ct], 0, 0, 0); } }
            WAVE_LDS_FENCE();
            LAS bf16* ot = ul;
            static_assert(16 * 136 <= 2 * 16 * TS, "FFT stage A output tile fits the per-wave slice");
#pragma unroll
            for (int j = 0; j < 4; ++j) { const int k1 = 16 * wave + 4 * fq + j;
                float cs, sn; sincos_rev((float)((n2 * k1) % SEQ) * (1.0f / (float)SEQ), cs, sn);
#pragma unroll
                for (int ct = 0; ct < 4; ++ct) { const float cre = T1[ct][j] - T2[ct][j], cim = -T3[ct][j];
                    ot[(4 * fq + j) * 136 + 16 * ct + fr] = (bf16)f2bf(cre * cs + cim * sn); ot[(4 * fq + j) * 136 + 64 + 16 * ct + fr] = (bf16)f2bf(cim * cs - cre * sn); } }
            WAVE_LDS_FENCE();
            { bf16* obase = p.ct + ((size_t)((b * FG + g) * 64 + n2) * FN1 + 16 * wave) * 128;
#pragma unroll
              for (int it = 0; it < 4; ++it) { const int rr = it * 4 + (lane >> 4), cc = lane & 15; *(u32x4*)(obase + (size_t)rr * 128 + cc * 8) = *(const LAS u32x4*)(ot + rr * 136 + cc * 8); } }
        }
    }
    __syncthreads();
}
HD void ph_fftB(const P& p, int l, LAS unsigned char* lds) {
    int tid = threadIdx.x; OPAQUE_V(tid); const int wave = __builtin_amdgcn_readfirstlane(tid >> 6);
    LAS bf16* buf0 = (LAS bf16*)(lds + wave * WAVE_LDS); LAS bf16* buf1 = buf0 + 64 * TS;
    const float scale = 1.0f / sqrtf((float)SEQ * 64.0f);
    const int ntask = NB * FG * FN1;
    for (;;) {
        int lane = tid & 63; OPAQUE_V(lane);
        const int task = q_pop_wave(q_ctr(p, l, 3), lane); if (task >= ntask) break;
        const int fr = lane & 15, fq = lane >> 4;
        const int k1 = task % FN1, g = (task / FN1) % FG, b = task / (FN1 * FG);
        const bf16* src = p.ct + ((size_t)((b * FG + g) * 64) * FN1 + k1) * 128;
        WAVE_LDS_FENCE();
        { u32x4 rv[8], iv[8]; stage_tile_T_ld(rv, src, (size_t)FN1 * 128, lane); stage_tile_T_ld(iv, src + 64, (size_t)FN1 * 128, lane);
          stage_tile_T_st(buf0, rv, lane, 0.f, 0, 1.0f);
          stage_tile_T_st(buf1, iv, lane, 0.f, 0, 1.0f); }
        WAVE_LDS_FENCE();
        f32x4 Y[4][4];
#pragma unroll
        for (int a = 0; a < 4; ++a)
#pragma unroll
            for (int bb = 0; bb < 4; ++bb) Y[a][bb] = (f32x4){0.f, 0.f, 0.f, 0.f};
#pragma unroll
        for (int ks = 0; ks < 2; ++ks) {
            bf16x8 ca[4], sa[4];
#pragma unroll
            for (int a = 0; a < 4; ++a) { ca[a] = *(const bf16x8*)(p.ft64 + (16 * a + fr) * 64 + 32 * ks + 8 * fq); sa[a] = *(const bf16x8*)(p.ft64 + 4096 + (16 * a + fr) * 64 + 32 * ks + 8 * fq); }
#pragma unroll
            for (int bb = 0; bb < 4; ++bb) { const bf16x8 rb = ldfrag(buf0, 16 * bb + fr, 32 * ks + 8 * fq), ib = ldfrag(buf1, 16 * bb + fr, 32 * ks + 8 * fq);
#pragma unroll
                for (int a = 0; a < 4; ++a) { Y[a][bb] = __builtin_amdgcn_mfma_f32_16x16x32_bf16(ca[a], rb, Y[a][bb], 0, 0, 0); Y[a][bb] = __builtin_amdgcn_mfma_f32_16x16x32_bf16(sa[a], ib, Y[a][bb], 0, 0, 0); } }
        }
        WAVE_LDS_FENCE();
#pragma unroll
        for (int a = 0; a < 4; ++a)
#pragma unroll
            for (int bb = 0; bb < 4; ++bb)
#pragma unroll
                for (int j = 0; j < 4; ++j) buf0[(16 * a + 4 * fq + j) * TS + 16 * bb + fr] = (bf16)f2bf(Y[a][bb][j] * scale);
        WAVE_LDS_FENCE();
        { bf16* orow = p.mix + (size_t)(TC + b * SEQ + k1) * D + g * FC;
#pragma unroll 2
          for (int it = 0; it < 8; ++it) { const int k2 = it * 8 + (lane >> 3), cc = lane & 7; *(u32x4*)(orow + (size_t)k2 * FN1 * D + cc * 8) = *(const LAS u32x4*)(buf0 + k2 * TS + cc * 8); } }
    }
}

HD void ph_pool_wave(const P& p, int l, LAS unsigned char* lds, bool with_ctx) {
    static_assert(PGW == 64 && LCTX % 64 == 0 && SEQ % 64 == 0 && 80 * TS * 2 <= WAVE_LDS, "pool wave kernel is written for 64-wide groups");
    int tid = threadIdx.x; OPAQUE_V(tid); const int wave = __builtin_amdgcn_readfirstlane(tid >> 6);
    LAS bf16* hb = (LAS bf16*)(lds + wave * WAVE_LDS);
    const int rb0 = with_ctx ? 0 : TC / 64; const int ntask = (T / 64 - rb0) * 4;
    for (;;) {
        int lane = tid & 63; OPAQUE_V(lane);
        const int task = q_pop_wave(q_ctr(p, l, 4), lane); if (task >= ntask) break;
        const int fr = lane & 15, fq = lane >> 4;
        const int g = 3 - task / (T / 64 - rb0), rb = rb0 + task % (T / 64 - rb0);
        const int r0 = rb * 64; const int hw = 1 << g;
        int n0, N, t0; row_seq(r0, n0, N, t0);
        WAVE_LDS_FENCE();
        { u32x4 hv[10];
#pragma unroll
          for (int it = 0; it < 10; ++it) { const int rr = it * 8 + (lane >> 3), cc = lane & 7; const int n = n0 - 8 + rr;
              const u32x4 z = {0u, 0u, 0u, 0u}; hv[it] = z; if (n >= 0 && n < N) hv[it] = *(const u32x4*)(p.pj + (size_t)(t0 + n) * INW + B_OFF + g * PGW + cc * 8); }
#pragma unroll
          for (int it = 0; it < 10; ++it) { const int rr = it * 8 + (lane >> 3), cc = lane & 7; *(LAS u32x4*)(hb + rr * TS + cc * 8) = hv[it]; } }
        WAVE_LDS_FENCE();
        bf16x8 pa[4][2];
#pragma unroll
        for (int a = 0; a < 4; ++a) { const int i = 16 * a + fr, n = n0 + i; int lo = n - hw; if (lo < 0) lo = 0; int hi = n + hw; if (hi > N) hi = N; const float rc = rcp_f((float)(hi - lo));
#pragma unroll
            for (int ks = 0; ks < 2; ++ks) {
                float s[8];
#pragma unroll
                for (int e = 0; e < 8; ++e) s[e] = 0.f;
                for (int r = lo; r < hi; ++r) { const u32x4 v = *(const LAS u32x4*)(hb + (r - n0 + 8) * TS + 32 * ks + 8 * fq);
#pragma unroll
                    for (int e = 0; e < 4; ++e) { s[2 * e] += bf2f((bf16)(v[e] & 0xffffu)); s[2 * e + 1] += bf2f((bf16)(v[e] >> 16)); } }
                const u32x4 sv = *(const LAS u32x4*)(hb + (i + 8) * TS + 32 * ks + 8 * fq);
                u32x4 o;
#pragma unroll
                for (int e = 0; e < 4; ++e) o[e] = pk2f(s[2 * e] * rc - bf2f((bf16)(sv[e] & 0xffffu)), s[2 * e + 1] * rc - bf2f((bf16)(sv[e] >> 16)));
                pa[a][ks] = __builtin_bit_cast(bf16x8, o);
            } }
        f32x4 Y[4][4];
#pragma unroll
        for (int a = 0; a < 4; ++a)
#pragma unroll
            for (int dt = 0; dt < 4; ++dt) Y[a][dt] = (f32x4){0.f, 0.f, 0.f, 0.f};
        const bf16* wt = p.pwt + (size_t)(l * 4 + g) * PGW * PGW;
#pragma unroll
        for (int dt = 0; dt < 4; ++dt)
#pragma unroll
            for (int ks = 0; ks < 2; ++ks) { const bf16x8 wb = *(const bf16x8*)(wt + (16 * dt + fr) * PGW + 32 * ks + 8 * fq);
#pragma unroll
                for (int a = 0; a < 4; ++a) Y[a][dt] = __builtin_amdgcn_mfma_f32_16x16x32_bf16(pa[a][ks], wb, Y[a][dt], 0, 0, 0); }
        WAVE_LDS_FENCE();
#pragma unroll
        for (int dt = 0; dt < 4; ++dt) { const float sc = p.pool_scale[(size_t)l * QW + g * PGW + 16 * dt + fr];
#pragma unroll
            for (int a = 0; a < 4; ++a)
#pragma unroll
                for (int j = 0; j < 4; ++j) hb[(16 * a + 4 * fq + j) * TS + 16 * dt + fr] = (bf16)f2bf(Y[a][dt][j] * sc); }
        WAVE_LDS_FENCE();
        { bf16* orow = p.mix + (size_t)r0 * D + QW + g * PGW;
#pragma unroll 2
          for (int it = 0; it < 8; ++it) { const int rr = it * 8 + (lane >> 3), cc = lane & 7; *(u32x4*)(orow + (size_t)rr * D + cc * 8) = *(const LAS u32x4*)(hb + rr * TS + cc * 8); } }
    }
}
#ifndef CPU_TEST
namespace pg8 {
#define PG8_LAS __attribute__((address_space(3)))
typedef unsigned short bf16_t;
typedef short bf16x8 __attribute__((ext_vector_type(8)));
typedef float f32x4 __attribute__((ext_vector_type(4)));
typedef unsigned u32x4 __attribute__((ext_vector_type(4)));
constexpr int BM = 256, BK = 64, HALF = 128, HTB = HALF * BK * 2  , STAGE_BYTES = 8 * HTB, NXCD = 8, WGM = 8;

__host__ __device__ __forceinline__ int lds_byte(int r, int c) { const int st = (r >> 4) * 2 + (c >> 5), rr = r & 15, cc = c & 31, ob = rr * 64 + cc * 2; return st * 1024 + (ob ^ (((ob >> 9) & 1) << 5)); }
__host__ __device__ __forceinline__ void stage_rc(int b, int& R, int& C) { const int st = b / 1024, sb = b % 1024, swz = sb ^ (((sb >> 9) & 1) << 5); R = (st >> 1) * 16 + swz / 64; C = (st & 1) * 32 + (swz % 64) / 2; }
__host__ __device__ __forceinline__ int perm32(int rho) { const int n = rho >> 4, i = rho & 15; return 8 * (i >> 2) + 4 * n + (i & 3); }

struct Unit { int pm, pn; };
struct Gemm { const bf16_t* A; const bf16_t* Bt; int M, N, K; const int* rowtok; };

struct StaticOrder {
    int nM, nN, nwg, G, c;
    __host__ __device__ void init(int M, int N, int G_, int c_) { nM = M / BM; nN = N / BM; nwg = nM * nN; G = G_; c = c_; }
    __host__ __device__ bool next(int i, Unit& u) const {
        const long L = (long)i * G + c; if (L >= nwg) return false;
        int wgid = (int)L; { const int q = nwg / NXCD, r = nwg % NXCD, xcd = wgid % NXCD, off = wgid / NXCD; wgid = (xcd < r ? xcd * (q + 1) : r * (q + 1) + (xcd - r) * q) + off; }
        const int nig = WGM * nN, gid = wgid / nig, fm = gid * WGM, gsz = (nM - fm) < WGM ? (nM - fm) : WGM;
        u.pm = fm + ((wgid % nig) % gsz); u.pn = (wgid % nig) / gsz; return true;
    }
    __device__ __forceinline__ void a_ready(const Unit&) const {}
    __device__ __forceinline__ void done(const Unit&) const {}
};

__device__ __forceinline__ unsigned cvt_pk_bf16(float lo, float hi) { unsigned r; asm volatile("v_cvt_pk_bf16_f32 %0, %1, %2" : "=v"(r) : "v"(lo), "v"(hi)); return r; }
typedef float f32x2 __attribute__((ext_vector_type(2)));
__device__ __forceinline__ f32x2 gelu_pk(f32x2 v) {
    const f32x2 av = __builtin_elementwise_abs(v), d = av * 0.2316418882f + 1.0f;
    f32x2 t; t.x = __builtin_amdgcn_rcpf(d.x); t.y = __builtin_amdgcn_rcpf(d.y);
    f32x2 q = t * 0.5307027145f + (-0.7265760135f); q = q * t + 0.7107068705f; q = q * t + (-0.142248368f); q = q * t + 0.127414796f; q = q * t;
    const f32x2 s = (v * v) * (-0.72134752044f);
    f32x2 e; e.x = __builtin_amdgcn_exp2f(s.x); e.y = __builtin_amdgcn_exp2f(s.y);
    const f32x2 m = v * (q * e), r = v - m;
    f32x2 o; o.x = v.x < 0.f ? m.x : r.x; o.y = v.y < 0.f ? m.y : r.y; return o;
}

template <int ACT  > struct EpiBf16 {
    static constexpr bool PERM = true, AFTER_DRAIN = false; static_assert(ACT == 0 || ACT == 1, "EpiBf16: ACT is 0 (none) or 1 (gelu_pk)");
    bf16_t* O; int ldc; const float* bias; int split_cols; size_t split_stride; float scale0;
    __device__ __forceinline__ void operator()(const f32x4 (&acc)[2][2][4][2], const Unit& u, int wr, int wc, int fr, int fq) const {
        const int row0 = u.pm * BM + wr * 64 + fr; int colt = u.pn * BM; bf16_t* base = O;
        float sc = 1.f; if (split_cols) { const int t = colt / split_cols; base += (size_t)t * split_stride; colt -= t * split_cols; if (t == 0) sc = scale0; }
        const int col0 = colt + wc * 32 + 8 * fq, bcol0 = u.pn * BM + wc * 32 + 8 * fq;
        f32x4 bv[2][2];
#pragma unroll
        for (int bj = 0; bj < 2; ++bj)
#pragma unroll
            for (int n = 0; n < 2; ++n) bv[bj][n] = bias ? *(const f32x4*)(bias + bcol0 + bj * HALF + 4 * n) : (f32x4){0.f, 0.f, 0.f, 0.f};
#pragma unroll
        for (int ai = 0; ai < 2; ++ai)
#pragma unroll
            for (int m = 0; m < 4; ++m) { bf16_t* rowp = base + (size_t)(row0 + ai * HALF + m * 16) * ldc + col0;
#pragma unroll
                for (int bj = 0; bj < 2; ++bj) { f32x4 v0 = acc[ai][bj][m][0] + bv[bj][0], v1 = acc[ai][bj][m][1] + bv[bj][1];
                    if (ACT == 1) { f32x2 a = gelu_pk((f32x2){v0[0], v0[1]}), b = gelu_pk((f32x2){v0[2], v0[3]}), c = gelu_pk((f32x2){v1[0], v1[1]}), d = gelu_pk((f32x2){v1[2], v1[3]});
                        v0 = (f32x4){a.x, a.y, b.x, b.y}; v1 = (f32x4){c.x, c.y, d.x, d.y}; }
                    v0 = v0 * sc; v1 = v1 * sc; u32x4 w; w.x = cvt_pk_bf16(v0[0], v0[1]); w.y = cvt_pk_bf16(v0[2], v0[3]); w.z = cvt_pk_bf16(v1[0], v1[1]); w.w = cvt_pk_bf16(v1[2], v1[3]);
                    *(u32x4*)(rowp + bj * HALF) = w; } }
    }
};
template <bool HAS_BIAS> struct EpiOut {
    static constexpr bool PERM = true, AFTER_DRAIN = false;
    bf16_t* O; int ldc; const float* bias; int split_cols; size_t split_stride; float scale;
    __device__ __forceinline__ void operator()(const f32x4 (&acc)[2][2][4][2], const Unit& u, int wr, int wc, int fr, int fq) const {
        const int row0 = u.pm * BM + wr * 64 + fr; int colt = u.pn * BM; bf16_t* base = O;
        if (split_cols) { const int t = colt / split_cols; base += (size_t)t * split_stride; colt -= t * split_cols; }
        const int col0 = colt + wc * 32 + 8 * fq, bcol0 = u.pn * BM + wc * 32 + 8 * fq;
        bf16_t* p0 = base + (size_t)row0 * ldc + col0;
#pragma unroll
        for (int bj = 0; bj < 2; ++bj) {
            f32x4 b0 = (f32x4){0.f, 0.f, 0.f, 0.f}, b1 = b0;
            if (HAS_BIAS) { b0 = *(const f32x4*)(bias + bcol0 + bj * HALF); b1 = *(const f32x4*)(bias + bcol0 + bj * HALF + 4); }
#pragma unroll
            for (int ai = 0; ai < 2; ++ai)
#pragma unroll
                for (int m = 0; m < 4; ++m) { const f32x4 v0 = acc[ai][bj][m][0] * scale + b0, v1 = acc[ai][bj][m][1] * scale + b1;
                    u32x4 w; w.x = cvt_pk_bf16(v0[0], v0[1]); w.y = cvt_pk_bf16(v0[2], v0[3]); w.z = cvt_pk_bf16(v1[0], v1[1]); w.w = cvt_pk_bf16(v1[2], v1[3]);
                    *(u32x4*)(p0 + (size_t)(ai * HALF + m * 16) * ldc + bj * HALF) = w; }
        }
    }
};
template <bool HAS_BIAS> struct EpiOut8 {
    static constexpr bool PERM = true, AFTER_DRAIN = false;
    unsigned char* O; int ldc; const float* bias; int split_cols; float scale;
    __device__ __forceinline__ void operator()(const f32x4 (&acc)[2][2][4][2], const Unit& u, int wr, int wc, int fr, int fq) const {
        const int row0 = u.pm * BM + wr * 64 + fr; int colt = u.pn * BM; if (split_cols) colt %= split_cols;
        const int col0 = colt + wc * 32 + 8 * fq, bcol0 = u.pn * BM + wc * 32 + 8 * fq;
        const unsigned off0 = (unsigned)row0 * (unsigned)ldc + (unsigned)col0;
#pragma unroll
        for (int bj = 0; bj < 2; ++bj) {
            f32x4 b0 = (f32x4){0.f, 0.f, 0.f, 0.f}, b1 = b0;
            if (HAS_BIAS) { b0 = *(const f32x4*)(bias + bcol0 + bj * HALF); b1 = *(const f32x4*)(bias + bcol0 + bj * HALF + 4); }
#pragma unroll
            for (int ai = 0; ai < 2; ++ai)
#pragma unroll
                for (int m = 0; m < 4; ++m) { const f32x4 v0 = acc[ai][bj][m][0] * scale + b0, v1 = acc[ai][bj][m][1] * scale + b1;
                    uint2 w; w.x = pk4_fp8(v0[0], v0[1], v0[2], v0[3]); w.y = pk4_fp8(v1[0], v1[1], v1[2], v1[3]);
                    *(uint2*)(O + (off0 + (unsigned)((ai * HALF + m * 16) * ldc + bj * HALF))) = w; }
        }
    }
};
struct EpiSwiglu {
    static constexpr bool PERM = true, AFTER_DRAIN = false;
    bf16_t* O; int ldc; const float* bias; int ncols;
    __device__ __forceinline__ static float sw(float g, float l, float lim, float alpha) {
        g = fminf(g, lim); l = fminf(fmaxf(l, -lim), lim); return g * __builtin_amdgcn_rcpf(1.0f + __expf(-alpha * g)) * (l + 1.0f); }
    __device__ __forceinline__ void operator()(const f32x4 (&acc)[2][2][4][2], const Unit& u, int wr, int wc, int fr, int fq) const {
        const int row0 = u.pm * BM + wr * 64 + fr; const int bcol0 = u.pn * BM + wc * 32 + 8 * fq; const int col0 = (u.pn * BM) % ncols + wc * 32 + 8 * fq;
        bf16_t* p0 = O + (size_t)row0 * ldc + (col0 >> 1);
#pragma unroll
        for (int bj = 0; bj < 2; ++bj) {
            const f32x4 b0 = *(const f32x4*)(bias + bcol0 + bj * HALF), b1 = *(const f32x4*)(bias + bcol0 + bj * HALF + 4);
#pragma unroll
            for (int ai = 0; ai < 2; ++ai)
#pragma unroll
                for (int m = 0; m < 4; ++m) { const f32x4 v0 = acc[ai][bj][m][0] + b0, v1 = acc[ai][bj][m][1] + b1;
                    const float a0 = sw(v0[0], v0[1], 7.0f, 1.702f), a1 = sw(v0[2], v0[3], 7.0f, 1.702f), a2 = sw(v1[0], v1[1], 7.0f, 1.702f), a3 = sw(v1[2], v1[3], 7.0f, 1.702f);
                    uint2 w; w.x = cvt_pk_bf16(a0, a1); w.y = cvt_pk_bf16(a2, a3);
                    *(uint2*)(p0 + (size_t)(ai * HALF + m * 16) * ldc + bj * (HALF / 2)) = w; }
        }
    }
};
struct EpiSwiglu8 {
    static constexpr bool PERM = true, AFTER_DRAIN = false;
    unsigned char* O; int ldc; const float* bias; int ncols; float scale;
    __device__ __forceinline__ void operator()(const f32x4 (&acc)[2][2][4][2], const Unit& u, int wr, int wc, int fr, int fq) const {
        const int row0 = u.pm * BM + wr * 64 + fr; const int bcol0 = u.pn * BM + wc * 32 + 8 * fq; const int col0 = (u.pn * BM) % ncols + wc * 32 + 8 * fq;
        const unsigned off0 = (unsigned)row0 * (unsigned)ldc + (unsigned)(col0 >> 1);
#pragma unroll
        for (int bj = 0; bj < 2; ++bj) {
            const f32x4 b0 = *(const f32x4*)(bias + bcol0 + bj * HALF), b1 = *(const f32x4*)(bias + bcol0 + bj * HALF + 4);
#pragma unroll
            for (int ai = 0; ai < 2; ++ai)
#pragma unroll
                for (int m = 0; m < 4; ++m) { const f32x4 v0 = acc[ai][bj][m][0] * scale + b0, v1 = acc[ai][bj][m][1] * scale + b1;
                    const float a0 = EpiSwiglu::sw(v0[0], v0[1], 7.0f, 1.702f), a1 = EpiSwiglu::sw(v0[2], v0[3], 7.0f, 1.702f), a2 = EpiSwiglu::sw(v1[0], v1[1], 7.0f, 1.702f), a3 = EpiSwiglu::sw(v1[2], v1[3], 7.0f, 1.702f);
                    *(unsigned*)(O + (off0 + (unsigned)((ai * HALF + m * 16) * ldc + bj * (HALF / 2)))) = pk4_fp8(a0, a1, a2, a3); }
        }
    }
};
struct MoeOrder {
    int nN, total, G, c, evec;
    __device__ __forceinline__ int rb_of(int i, int& tn) const {
        if (G % 8 != 0) { const int L = i * G + c; tn = L % nN; return L / nN; }
        const int x = c % 8, q = c / 8, per = G / 8; const int U = i * per + q; tn = U % nN; return (U / nN) * 8 + x; }
    __device__ __forceinline__ void init(const int* blke, int nblk, int nN_, int G_, int c_) { nN = nN_; total = nblk * nN_; G = G_; c = c_;
        const int lane = (int)__builtin_amdgcn_mbcnt_hi(~0u, __builtin_amdgcn_mbcnt_lo(~0u, 0u)); int tn; const int rb = rb_of(lane, tn); evec = rb * nN < total ? blke[rb] : 0; }
    __device__ __forceinline__ bool next(int i, Unit& u) const {
        int tn; const int rb = rb_of(i, tn); if (rb * nN >= total || i >= 64) return false;
        u.pm = rb; u.pn = __builtin_amdgcn_readlane(evec, i) * nN + tn; return true;
    }
    __device__ __forceinline__ void a_ready(const Unit&) const {}
    __device__ __forceinline__ void done(const Unit&) const {}
};
template <class Epi, class Sched, bool ALIGN_EPI = false, bool SP2 = false, bool GATHER = false, bool FP8 = false>
__device__ __forceinline__ void gemm_phase(PG8_LAS unsigned char* lds, const Gemm g, const Sched& S, const Epi& E) {
    int tid_ = threadIdx.x; asm volatile("" : "+v"(tid_));
    const int tid = tid_, wid = __builtin_amdgcn_readfirstlane(tid >> 6), lane = tid & 63, wr = wid >> 2, wc = wid & 3, fr = lane & 15, fq = lane >> 4;
    const int K = g.K, nt = K / BK;
    unsigned voffA[2], voffB[2]; int gR[2], gC[2];
#pragma unroll
    for (int i = 0; i < 2; ++i) { int R, C; stage_rc(tid * 16 + i * 8192, R, C); const int Rb = Epi::PERM ? ((R & ~31) + perm32(R & 31)) : R;
        voffA[i] = (unsigned)(R * K + C) * 2u; voffB[i] = (unsigned)(Rb * K + C) * 2u; gR[i] = R & 15; gC[i] = C; }
    static_assert(!GATHER || SP2, "the gathered A operand is wired into the SP2 loop only");
    unsigned gc[2][2], gn[2][2]; typedef int i32x16 __attribute__((ext_vector_type(16)));
#define PG8_LOADOFF(o, PM) do { _Pragma("unroll") for (int _h = 0; _h < 2; ++_h) _Pragma("unroll") for (int _i = 0; _i < 2; ++_i) { \
        const int* _tb = g.rowtok + (size_t)(PM) * BM + _h * HALF + 16 * ((wid + 8 * _i) >> 1); int _tok = 0; i32x16 _t; \
        asm volatile("s_load_dwordx16 %0, %1, 0x0\n\ts_waitcnt lgkmcnt(0)" : "=s"(_t) : "s"(_tb) : "memory");     \
        _Pragma("unroll") for (int _k = 0; _k < 16; ++_k) _tok = (gR[_i] == _k) ? _t[_k] : _tok; \
        o[_h][_i] = (unsigned)(_tok * K + gC[_i]) * 2u; } } while (0)
#define PG8_STAGE_A(bufoff, ptr, H, NXT, kbytes) do { if constexpr (GATHER) { if (NXT) PG8_STAGE_G(bufoff, (const char*)g.A + (kbytes), gn[H]); else PG8_STAGE_G(bufoff, (const char*)g.A + (kbytes), gc[H]); } \
        else PG8_STAGE(bufoff, ptr, voffA); } while (0)
    const size_t kstep = (size_t)(BK * 2);
    const size_t rstep64 = (size_t)64 * K * 2;
    const size_t hstep = (size_t)HALF * K * 2;
    const size_t tstep = 2 * hstep;
    const unsigned ldsw = (unsigned)wid * 1024u;
    const int aoff = lds_byte(wr * 64 + fr, fq * 8), boff = lds_byte(wc * 32 + fr, fq * 8);
    const int aoff0 = aoff, aoff1 = aoff + 1024;
    const int boff0 = boff, boff1 = boff + 1024;
    typedef int i32x4_t __attribute__((ext_vector_type(4))); typedef int i32x8_t __attribute__((ext_vector_type(8)));
    const PG8_LAS unsigned char* ldsA = lds + aoff0; const PG8_LAS unsigned char* ldsB = lds + 4 * HTB + boff0;
#define PG8_SA(b, h) (((b) * 2 + (h)) * HTB)
#define PG8_SB(b, h) ((4 + (b) * 2 + (h)) * HTB)
#define PG8_STAGE(bufoff, gbase, voff) do { _Pragma("unroll") for (int _i = 0; _i < 2; ++_i) \
        __builtin_amdgcn_global_load_lds((const unsigned*)((const char*)(gbase) + (size_t)_i * rstep64 + (voff)[0]), (PG8_LAS unsigned*)(lds + (bufoff) + ldsw + _i * 8192), 16, 0, 0); } while (0)
#define PG8_STAGE_G(bufoff, gbase, voff) do { _Pragma("unroll") for (int _i = 0; _i < 2; ++_i) \
        __builtin_amdgcn_global_load_lds((const unsigned*)((const char*)(gbase) + (voff)[_i]), (PG8_LAS unsigned*)(lds + (bufoff) + ldsw + _i * 8192), 16, 0, 0); } while (0)
#define PG8_LDA(dst, b, h) do { _Pragma("unroll") for (int m = 0; m < 4; ++m) _Pragma("unroll") for (int k = 0; k < 2; ++k) dst[m][k] = *(const PG8_LAS bf16x8*)(ldsA + (PG8_SA(b, h) + (k ? aoff1 - aoff0 : 0) + m * 2048)); } while (0)
#define PG8_LDB(dst, b, h) do { _Pragma("unroll") for (int n = 0; n < 2; ++n) _Pragma("unroll") for (int k = 0; k < 2; ++k) dst[n][k] = *(const PG8_LAS bf16x8*)(ldsB + (PG8_SB(b, h) - 4 * HTB + (k ? boff1 - boff0 : 0) + n * 2048)); } while (0)
#define PG8_CAT8(x) __builtin_shufflevector(__builtin_bit_cast(i32x4_t, (x)[0]), __builtin_bit_cast(i32x4_t, (x)[1]), 0, 1, 2, 3, 4, 5, 6, 7)
#define PG8_MMA(ai, bj, At, Bt) do { __builtin_amdgcn_s_setprio(1); if constexpr (FP8) { _Pragma("unroll") for (int m = 0; m < 4; ++m) _Pragma("unroll") for (int n = 0; n < 2; ++n) \
        acc[ai][bj][m][n] = __builtin_amdgcn_mfma_scale_f32_16x16x128_f8f6f4(PG8_CAT8(Bt[n]), PG8_CAT8(At[m]), acc[ai][bj][m][n], 0, 0, 0, 127, 0, 127); } else { \
        _Pragma("unroll") for (int m = 0; m < 4; ++m) _Pragma("unroll") for (int n = 0; n < 2; ++n) _Pragma("unroll") for (int k = 0; k < 2; ++k) \
        acc[ai][bj][m][n] = __builtin_amdgcn_mfma_f32_16x16x32_bf16(Bt[n][k], At[m][k], acc[ai][bj][m][n], 0, 0, 0); } __builtin_amdgcn_s_setprio(0); } while (0)
#define PG8_WAIT_V(n) asm volatile("s_waitcnt vmcnt(" #n ")" ::: "memory")
#define PG8_WAIT_L(n) asm volatile("s_waitcnt lgkmcnt(" #n ")" ::: "memory")
#define PG8_BAR __builtin_amdgcn_s_barrier()
#define PG8_SCHED __builtin_amdgcn_sched_barrier(0)
    Unit cur, nxt; int ui = 0;
    if (!S.next(0, cur)) return;
    f32x4 acc[2][2][4][2];
#pragma unroll
    for (int a = 0; a < 2; ++a)
#pragma unroll
        for (int b = 0; b < 2; ++b)
#pragma unroll
            for (int m = 0; m < 4; ++m)
#pragma unroll
                for (int n = 0; n < 2; ++n) acc[a][b][m][n] = (f32x4){0.f, 0.f, 0.f, 0.f};
    bf16x8 At[4][2], B0[2][2], B1[2][2];
    const char* cA = (const char*)g.A + (size_t)cur.pm * tstep; const char* cB = (const char*)g.Bt + (size_t)cur.pn * tstep;
    S.a_ready(cur);
    if constexpr (GATHER) PG8_LOADOFF(gc, cur.pm);
    if constexpr (SP2) {
        PG8_STAGE(PG8_SB(0, 0), cB, voffB); PG8_STAGE(PG8_SB(0, 1), cB + hstep, voffB); PG8_STAGE_A(PG8_SA(0, 0), cA, 0, false, (size_t)0); PG8_STAGE_A(PG8_SA(0, 1), cA + hstep, 1, false, (size_t)0);
        if (wr == 1) PG8_BAR;
        PG8_WAIT_V(2); PG8_BAR;
        PG8_STAGE(PG8_SB(1, 0), cB + kstep, voffB); PG8_STAGE_A(PG8_SA(1, 0), cA + kstep, 0, false, kstep); PG8_STAGE(PG8_SB(1, 1), cB + hstep + kstep, voffB);
        PG8_WAIT_V(6); PG8_BAR;
    } else {
        PG8_STAGE(PG8_SB(0, 0), cB, voffB); PG8_STAGE(PG8_SA(0, 0), cA, voffA); PG8_STAGE(PG8_SB(0, 1), cB + hstep, voffB); PG8_STAGE(PG8_SA(0, 1), cA + hstep, voffA);
        if (wr == 1) PG8_BAR;
        PG8_WAIT_V(4); PG8_BAR;
        PG8_STAGE(PG8_SB(1, 0), cB + kstep, voffB); PG8_STAGE(PG8_SA(1, 0), cA + kstep, voffA); PG8_STAGE(PG8_SB(1, 1), cB + hstep + kstep, voffB);
        PG8_WAIT_V(6); PG8_BAR;
    }
    for (;;) {
        const bool has_next = S.next(ui + 1, nxt);
        if constexpr (GATHER) { if (has_next) PG8_LOADOFF(gn, nxt.pm); else { _Pragma("unroll") for (int _h = 0; _h < 2; ++_h) _Pragma("unroll") for (int _i = 0; _i < 2; ++_i) gn[_h][_i] = gc[_h][_i]; } }
        const char* nA = has_next ? (const char*)g.A + (size_t)nxt.pm * tstep : cA; const char* nB = has_next ? (const char*)g.Bt + (size_t)nxt.pn * tstep : cB;
#pragma unroll 1
        for (int t = 0; t < nt; t += 2) {
            const bool last = (t == nt - 2);
            const char* a1 = cA + (size_t)(t + 1) * kstep;
            const char* a2 = last ? nA : cA + (size_t)(t + 2) * kstep; const char* b2 = last ? nB : cB + (size_t)(t + 2) * kstep;
            const char* a3 = a2 + kstep; const char* b3 = b2 + kstep;
            const size_t gk1 = (size_t)(t + 1) * kstep, gk2 = last ? (size_t)0 : (size_t)(t + 2) * kstep;
            if (last && has_next) S.a_ready(nxt);
            if constexpr (SP2) {
            PG8_LDB(B0, 0, 0); PG8_LDB(B1, 0, 1); PG8_SCHED; PG8_LDA(At, 0, 0); PG8_STAGE_A(PG8_SA(1, 1), a1 + hstep, 1, false, gk1);
            PG8_WAIT_V(8); PG8_WAIT_L(0); PG8_BAR; PG8_MMA(0, 0, At, B0); PG8_MMA(0, 1, At, B1); PG8_BAR; PG8_SCHED;
            PG8_LDA(At, 0, 1); PG8_STAGE(PG8_SB(0, 0), b2, voffB); PG8_STAGE(PG8_SB(0, 1), b2 + hstep, voffB); PG8_STAGE_A(PG8_SA(0, 0), a2, 0, last, gk2);
            PG8_WAIT_V(8); PG8_WAIT_L(0); PG8_BAR; PG8_MMA(1, 0, At, B0); PG8_MMA(1, 1, At, B1); PG8_BAR; PG8_SCHED;
            PG8_LDB(B0, 1, 0); PG8_LDB(B1, 1, 1); PG8_SCHED; PG8_LDA(At, 1, 0); PG8_STAGE_A(PG8_SA(0, 1), a2 + hstep, 1, last, gk2);
            PG8_WAIT_V(8); PG8_WAIT_L(0); PG8_BAR; PG8_MMA(0, 0, At, B0); PG8_MMA(0, 1, At, B1); PG8_BAR; PG8_SCHED;
            PG8_LDA(At, 1, 1); PG8_STAGE(PG8_SB(1, 0), b3, voffB); PG8_STAGE(PG8_SB(1, 1), b3 + hstep, voffB); PG8_STAGE_A(PG8_SA(1, 0), a3, 0, last, gk2 + kstep);
            PG8_WAIT_V(8); PG8_WAIT_L(0); PG8_BAR; PG8_MMA(1, 0, At, B0); PG8_MMA(1, 1, At, B1); PG8_BAR; PG8_SCHED;
            } else {
            PG8_LDB(B0, 0, 0); PG8_SCHED; PG8_LDA(At, 0, 0); PG8_STAGE(PG8_SA(1, 1), a1 + hstep, voffA);
            PG8_WAIT_L(8); PG8_BAR; PG8_WAIT_L(0); PG8_MMA(0, 0, At, B0); PG8_BAR; PG8_SCHED;
            PG8_LDB(B1, 0, 1); PG8_STAGE(PG8_SB(0, 0), b2, voffB);
            PG8_BAR; PG8_WAIT_L(0); PG8_MMA(0, 1, At, B1); PG8_BAR;
            PG8_LDA(At, 0, 1); PG8_STAGE(PG8_SA(0, 0), a2, voffA);
            PG8_BAR; PG8_WAIT_L(0); PG8_MMA(1, 0, At, B0); PG8_BAR; PG8_SCHED;
            PG8_STAGE(PG8_SB(0, 1), b2 + hstep, voffB);
            PG8_WAIT_V(6); PG8_BAR; PG8_MMA(1, 1, At, B1); PG8_BAR;
            PG8_LDB(B0, 1, 0); PG8_SCHED; PG8_LDA(At, 1, 0); PG8_STAGE(PG8_SA(0, 1), a2 + hstep, voffA);
            PG8_WAIT_L(8); PG8_BAR; PG8_WAIT_L(0); PG8_MMA(0, 0, At, B0); PG8_BAR; PG8_SCHED;
            PG8_LDB(B1, 1, 1); PG8_STAGE(PG8_SB(1, 0), b3, voffB);
            PG8_BAR; PG8_WAIT_L(0); PG8_MMA(0, 1, At, B1); PG8_BAR;
            PG8_LDA(At, 1, 1); PG8_STAGE(PG8_SA(1, 0), a3, voffA);
            PG8_BAR; PG8_WAIT_L(0); PG8_MMA(1, 0, At, B0); PG8_BAR; PG8_SCHED;
            PG8_STAGE(PG8_SB(1, 1), b3 + hstep, voffB);
            PG8_WAIT_V(6); PG8_BAR; PG8_MMA(1, 1, At, B1); PG8_BAR;
            }
        }
        if constexpr (ALIGN_EPI) { if (wr == 0) PG8_BAR; }
        if constexpr (!Epi::AFTER_DRAIN) { const int ln_ = (int)__builtin_amdgcn_mbcnt_hi(~0u, __builtin_amdgcn_mbcnt_lo(~0u, 0u));
            E(acc, cur, wr, wc, ln_ & 15, ln_ >> 4); S.done(cur); }
        if (!has_next) break;
#pragma unroll
        for (int a = 0; a < 2; ++a)
#pragma unroll
            for (int b = 0; b < 2; ++b)
#pragma unroll
                for (int m = 0; m < 4; ++m)
#pragma unroll
                    for (int n = 0; n < 2; ++n) acc[a][b][m][n] = (f32x4){0.f, 0.f, 0.f, 0.f};
        cur = nxt; cA = nA; cB = nB; ++ui;
        if constexpr (GATHER) { _Pragma("unroll") for (int _h = 0; _h < 2; ++_h) _Pragma("unroll") for (int _i = 0; _i < 2; ++_i) gc[_h][_i] = gn[_h][_i]; }
        if constexpr (ALIGN_EPI) { if (wr == 1) PG8_BAR; }
    }
    PG8_WAIT_V(0);
    if constexpr (!ALIGN_EPI) { if (wr == 0) PG8_BAR; }
    PG8_BAR;
    if constexpr (Epi::AFTER_DRAIN) { E.fused(acc, cur, wr, wc, fr, fq, lds, wid, lane); S.done(cur); }
#undef PG8_SA
#undef PG8_SB
#undef PG8_STAGE
#undef PG8_STAGE_G
#undef PG8_STAGE_A
#undef PG8_LOADOFF
#undef PG8_LDA
#undef PG8_LDB
#undef PG8_MMA
#undef PG8_CAT8
#undef PG8_WAIT_V
#undef PG8_WAIT_L
#undef PG8_BAR
#undef PG8_SCHED
}
}
#define GAS __attribute__((address_space(1)))
typedef unsigned v4u __attribute__((ext_vector_type(4)));
#define LDS_WAIT() asm volatile("s_waitcnt lgkmcnt(0)" ::: "memory")
#define VM_WAIT() asm volatile("s_waitcnt vmcnt(0)" ::: "memory")
__device__ __forceinline__ unsigned pk2(float lo, float hi) { return cvt_pk_bf16(lo, hi); }
#define XB_TMO      128
#define XB_XCNT(j)  (256  + 64 * (j))
#define XB_XSUB(j)  (1280 + 64 * (j))
#define XB_XGEN(j)  (2304 + 64 * (j))
#define XB_TOP      3328
#define XB_TOPGEN   3392
#define XCD_BAR_WORDS 3456
#define XB_SPIN_CAP (1u << 18)
__device__ __forceinline__ unsigned xb_ld(unsigned* p)              { return __hip_atomic_load(p, __ATOMIC_RELAXED, __HIP_MEMORY_SCOPE_AGENT); }
__device__ __forceinline__ unsigned xb_add(unsigned* p, unsigned v) { return __hip_atomic_fetch_add(p, v, __ATOMIC_RELAXED, __HIP_MEMORY_SCOPE_AGENT); }
__device__ __forceinline__ unsigned xb_xcc_id() { return (unsigned)__builtin_amdgcn_s_getreg((3 << 11) | 20) & 0xFu; }
#define XB_SPIN(cond, bar) do { unsigned _sp = 0; while (cond) { __builtin_amdgcn_s_sleep(1); \
    if ((++_sp & 255u) == 0u) { if (xb_ld(&(bar)[XB_TMO])) break; if (_sp > XB_SPIN_CAP) { atomicAdd(&(bar)[XB_TMO], 1u); break; } } } } while (0)

struct XcdBarrier {
    unsigned* bar; unsigned x;
    volatile LAS unsigned* st;
};

__device__ __forceinline__ XcdBarrier xcd_barrier_post(unsigned* bar, volatile LAS unsigned* st) {
    XcdBarrier b; b.bar = bar; b.x = xb_xcc_id(); b.st = st;
    if (threadIdx.x == 0) (void)xb_add(&bar[XB_XCNT(b.x)], 1u);
    return b;
}
__device__ __forceinline__ void xcd_barrier_complete(unsigned* bar, unsigned x, unsigned& nloc, unsigned& nx) {
    const unsigned G = gridDim.x * gridDim.y * gridDim.z;
    unsigned sum, cnt, mine, sp = 0u;
    for (;;) {
        sum = 0u; cnt = 0u; mine = 0u;
#pragma unroll
        for (unsigned j = 0; j < 16; ++j) { const unsigned c = xb_ld(&bar[XB_XCNT(j)]); sum += c; cnt += (c > 0u) ? 1u : 0u; mine = (j == x) ? c : mine; }
        if (sum == G) break;
        __builtin_amdgcn_s_sleep(1);
        if ((++sp & 255u) == 0u) { if (xb_ld(&bar[XB_TMO])) break; if (sp > XB_SPIN_CAP) { atomicAdd(&bar[XB_TMO], 1u); break; } }
    }
    nloc = mine > 0u ? mine : 1u; nx = cnt > 0u ? cnt : 1u;
}

__device__ __forceinline__ void xcd_barrier(const XcdBarrier& b) {
    asm volatile("s_waitcnt vmcnt(0)" ::: "memory");
    __syncthreads();
    if (threadIdx.x == 0) {
        unsigned* bar = b.bar;
        __builtin_amdgcn_s_waitcnt(0);
        unsigned nloc = b.st[0], nx = b.st[1];
        if (nloc == 0u) { xcd_barrier_complete(bar, b.x, nloc, nx); b.st[0] = nloc; b.st[1] = nx; }
        const unsigned old = xb_add(&bar[XB_XSUB(b.x)], 1u);
        const unsigned gen = old / nloc;
        if (old + 1u == (gen + 1u) * nloc) {
            __builtin_amdgcn_fence(__ATOMIC_RELEASE, "agent");
            asm volatile("s_waitcnt vmcnt(0)" ::: "memory");
            const unsigned og = xb_add(&bar[XB_TOP], 1u);
            const unsigned tg = og / nx;
            if (og + 1u == (tg + 1u) * nx) xb_add(&bar[XB_TOPGEN], 1u);
            else XB_SPIN(xb_ld(&bar[XB_TOPGEN]) == tg, bar);
            __builtin_amdgcn_fence(__ATOMIC_ACQUIRE, "agent");
            xb_add(&bar[XB_XGEN(b.x)], 1u);
            asm volatile("s_waitcnt vmcnt(0)" ::: "memory");
        } else {
            XB_SPIN(xb_ld(&bar[XB_XGEN(b.x)]) == gen, bar);
            __builtin_amdgcn_fence(__ATOMIC_ACQUIRE, "agent");
            asm volatile("s_waitcnt vmcnt(0)" ::: "memory");
        }
    }
    __syncthreads();
}


constexpr int NWAVES = 8, NT = NWAVES * 64;
constexpr int RING_OFF = 0, RING_BYTES = 147456;
constexpr int LDSCTL_OFF = RING_BYTES, MISC_OFF = LDSCTL_OFF + 320;
constexpr int LDS_BYTES = 148480;
static_assert(MISC_OFF + 128 <= LDS_BYTES && NWV * WAVE_LDS <= RING_BYTES, "LDS map");

struct Args { const float* in[20]; float* out; unsigned char* ws; int ph_lo, ph_hi; };
struct Env { LAS unsigned char* lds; XcdBarrier bar; int lo, hi; };
typedef const __attribute__((address_space(4))) Args* KArgs;
__device__ __forceinline__ void load_p(P& p) {
    KArgs ka = (KArgs)__builtin_amdgcn_kernarg_segment_ptr(); asm volatile("" : "+s"(ka));
    p.x = ka->in[0]; p.c = ka->in[1]; p.ctx = ka->in[2]; p.c_ctx = ka->in[3]; p.w_mod = ka->in[4]; p.b_mod = ka->in[5]; p.w_in = ka->in[6]; p.pool_w = ka->in[7]; p.pool_scale = ka->in[8]; p.attn_sink = ka->in[9];
    p.ret_decay = ka->in[10]; p.w_out = ka->in[11]; p.ln_g = ka->in[12]; p.ln_b = ka->in[13]; p.router_w = ka->in[14]; p.router_b = ka->in[15]; p.exp_w1 = ka->in[16]; p.exp_b1 = ka->in[17]; p.exp_w2 = ka->in[18]; p.exp_b2 = ka->in[19];
    p.out = ka->out; p.ws = ka->ws; fill_views(p);
}
#define PH_LOAD() P p; load_p(p)
#define SIMPLE(n, CALL) do { const long _n = (long)(n); int _t = threadIdx.x; asm volatile("" : "+v"(_t)); for (long gid = (long)blockIdx.x * NT + _t; gid < _n; gid += (long)gridDim.x * NT) { CALL; } } while (0)
#define SEAM(k) do { if (env.lo <= (k) && (k) + 1 < env.hi) xcd_barrier(env.bar); } while (0)
#define LDSP (env.lds + RING_OFF)
#define BLOCKPHASE(CALL) do { CALL; } while (0)

__device__ __forceinline__ void p0_transpose_item(const float* W, int K, int N, bf16* WT, LAS float* scr, int item, int lane) {
    const int nblk = N / 32, kb = item / nblk, nb = item % nblk, k0 = 64 * kb, n0 = 32 * nb;
    float wv[32];
#pragma unroll
    for (int i = 0; i < 32; ++i) wv[i] = __builtin_nontemporal_load(W + (size_t)(k0 + 2 * i + (lane >> 5)) * N + n0 + (lane & 31));
#pragma unroll
    for (int i = 0; i < 32; ++i) scr[(2 * i + (lane >> 5)) * 33 + (lane & 31)] = wv[i];
    LDS_WAIT(); asm volatile("" ::: "memory");
    const int c = lane & 7;
#pragma unroll
    for (int j = 0; j < 4; ++j) { const int n = (lane >> 3) + 8 * j; const LAS float* s = scr + (8 * c) * 33 + n;
        v4u o; o.x = pk2(s[0 * 33], s[1 * 33]); o.y = pk2(s[2 * 33], s[3 * 33]); o.z = pk2(s[4 * 33], s[5 * 33]); o.w = pk2(s[6 * 33], s[7 * 33]);
        *(GAS v4u*)(WT + (size_t)(n0 + n) * K + k0 + 8 * c) = o; }
    LDS_WAIT(); asm volatile("" ::: "memory");
}
#define TRANSPOSE(Wp, nmat, K_, N_, WTp) do { int _t = threadIdx.x; asm volatile("" : "+v"(_t)); const int _wave = __builtin_amdgcn_readfirstlane(_t >> 6), _lane = _t & 63; LAS float* scr = (LAS float*)(env.lds + RING_OFF + _wave * 16384); const int per = ((K_) / 64) * ((N_) / 32); \
    for (long it = (long)blockIdx.x * NWAVES + _wave; it < (long)(nmat) * per; it += (long)gridDim.x * NWAVES) { const int mi = (int)(it / per), r = (int)(it % per); \
        p0_transpose_item((Wp) + (size_t)mi * (K_) * (N_), (K_), (N_), (WTp) + (size_t)mi * (K_) * (N_), scr, r, _lane); } } while (0)
#define GEMM_PLAIN(Ap, Btp, M_, N_, K_, Op, ldc_, biasp, splitc, splits) do { pg8::Gemm g{(Ap), (Btp), (M_), (N_), (K_)}; pg8::StaticOrder S; S.init((M_), (N_), (int)gridDim.x, (int)blockIdx.x); \
    pg8::EpiOut<false> E{(Op), (ldc_), nullptr, (splitc), (size_t)(splits), 1.0f}; pg8::gemm_phase<pg8::EpiOut<false>, pg8::StaticOrder, true, true>(env.lds + RING_OFF, g, S, E); } while (0)
#define GEMM_MOE_SW(Ap, Btp, nN_, K_, Op, ldc_, biasp, ncols_) do { pg8::Gemm g{(const pg8::bf16_t*)(Ap), (const pg8::bf16_t*)(Btp), 0, 0, (K_) / 2}; pg8::MoeOrder S; S.init(p.blke, p.blke[NBLKMAX], (nN_), (int)gridDim.x, (int)blockIdx.x); \
    pg8::EpiSwiglu8 E{(Op), (ldc_), (biasp), (ncols_), 1.0f / W8_SCALE}; pg8::gemm_phase<pg8::EpiSwiglu8, pg8::MoeOrder, true, true, false, true>(env.lds + RING_OFF, g, S, E); } while (0)
#define GEMM_MOE(Ap, Btp, nN_, K_, Op, ldc_, biasp, splitc) do { pg8::Gemm g{(const pg8::bf16_t*)(Ap), (const pg8::bf16_t*)(Btp), 0, 0, (K_) / 2}; pg8::MoeOrder S; S.init(p.blke, p.blke[NBLKMAX], (nN_), (int)gridDim.x, (int)blockIdx.x); \
    pg8::EpiOut8<true> E{(Op), (ldc_), (biasp), (splitc), 1.0f / W8_SCALE}; pg8::gemm_phase<pg8::EpiOut8<true>, pg8::MoeOrder, true, true, false, true>(env.lds + RING_OFF, g, S, E); } while (0)
__device__ __forceinline__ void t8_load(float (&wv)[32], const float* W, int N, int item, int lane) {
    const int nblk = N / 32, kb = item / nblk, nb = item % nblk, k0 = 64 * kb, n0 = 32 * nb;
#pragma unroll
    for (int i = 0; i < 32; ++i) wv[i] = __builtin_nontemporal_load(W + (size_t)(k0 + 2 * i + (lane >> 5)) * N + n0 + (lane & 31));
}
__device__ __forceinline__ void t8_pack(const float (&wv)[32], int K, int N, unsigned char* WT, LAS float* scr, int item, int lane) {
    const int nblk = N / 32, kb = item / nblk, nb = item % nblk, k0 = 64 * kb, n0 = 32 * nb;
#pragma unroll
    for (int i = 0; i < 32; ++i) scr[(2 * i + (lane >> 5)) * 33 + (lane & 31)] = wv[i] * W8_SCALE;
    LDS_WAIT(); asm volatile("" ::: "memory");
    const int n = lane & 31, hf = lane >> 5; const LAS float* sp = scr + (32 * hf) * 33 + n;
    v4u o0, o1;
#pragma unroll
    for (int q = 0; q < 4; ++q) { o0[q] = pk4_fp8(sp[(4 * q) * 33], sp[(4 * q + 1) * 33], sp[(4 * q + 2) * 33], sp[(4 * q + 3) * 33]); o1[q] = pk4_fp8(sp[(16 + 4 * q) * 33], sp[(17 + 4 * q) * 33], sp[(18 + 4 * q) * 33], sp[(19 + 4 * q) * 33]); }
    GAS v4u* dst = (GAS v4u*)(WT + (size_t)(n0 + n) * K + k0 + 32 * hf); dst[0] = o0; dst[1] = o1;
    LDS_WAIT(); asm volatile("" ::: "memory");
}
__device__ __forceinline__ void transpose8_stream(const float* Wp, int nmat, int K, int N, unsigned char* WTp, LAS unsigned char* lds) {
    int _t = threadIdx.x; asm volatile("" : "+v"(_t)); const int wave = __builtin_amdgcn_readfirstlane(_t >> 6), lane = _t & 63; LAS float* scr = (LAS float*)(lds + wave * 16384);
    const int per = (K / 64) * (N / 32); const long total = (long)nmat * per, stride = (long)gridDim.x * NWAVES;
    long it = (long)blockIdx.x * NWAVES + wave; if (it >= total) return;
    float wa[32], wb[32];
    t8_load(wa, Wp + (size_t)(it / per) * K * N, N, (int)(it % per), lane);
    for (;;) {
        const long n1 = it + stride; const bool h1 = n1 < total;
        if (h1) t8_load(wb, Wp + (size_t)(n1 / per) * K * N, N, (int)(n1 % per), lane);
        t8_pack(wa, K, N, WTp + (size_t)(it / per) * K * N, scr, (int)(it % per), lane);
        if (!h1) break;
        const long n2 = n1 + stride; const bool h2 = n2 < total;
        if (h2) t8_load(wa, Wp + (size_t)(n2 / per) * K * N, N, (int)(n2 % per), lane);
        t8_pack(wb, K, N, WTp + (size_t)(n1 / per) * K * N, scr, (int)(n1 % per), lane);
        if (!h2) break;
        it = n2;
    }
}
#define TRANSPOSE8(Wp, nmat, K_, N_, WTp) transpose8_stream((Wp), (nmat), (K_), (N_), (WTp), env.lds + RING_OFF)
#define DUMP(name, ptr, rows, cols, isbf)
#else
struct Env { int lo, hi; std::string dir; };
static P g_P;
#define PH_LOAD() const P& p = g_P
#define SIMPLE(n, CALL) do { const long _n = (long)(n); for (long gid = 0; gid < _n; ++gid) { CALL; } } while (0)
#define SEAM(k)
#define LDSP (emu::g_lds)
#ifndef EMU_GRID
#define EMU_GRID 3
#endif
#define BLOCKPHASE(CALL) do { for (int _b = 0; _b < EMU_GRID; ++_b) emu::run_block(_b, EMU_GRID, 512, [&]() { CALL; }); } while (0)
#define TRANSPOSE(Wp, nmat, K_, N_, WTp) do { for (int mi = 0; mi < (nmat); ++mi) for (int k = 0; k < (K_); ++k) for (int n = 0; n < (N_); ++n) \
    (WTp)[(size_t)mi * (K_) * (N_) + (size_t)n * (K_) + k] = (bf16)f2bf((Wp)[(size_t)mi * (K_) * (N_) + (size_t)k * (N_) + n]); } while (0)
static void cpu_gemm_rows(const bf16* A, const bf16* Bt, int r0, int r1, int N, int K, int bcol_off, bf16* O, int ldc, const float* bias, int splitc, size_t splits, int swiglu) {
    std::vector<float> Bf((size_t)N * K);
    for (int n = 0; n < N; ++n) for (int k = 0; k < K; ++k) Bf[(size_t)n * K + k] = bf2f(Bt[(size_t)(bcol_off + n) * K + k]);
#pragma omp parallel for schedule(static)
    for (int r = r0; r < r1; ++r) {
        std::vector<float> u(N), a(K);
        for (int k = 0; k < K; ++k) a[k] = bf2f(A[(size_t)r * K + k]);
        for (int n = 0; n < N; ++n) { float acc = 0.f; const float* b = &Bf[(size_t)n * K]; for (int k = 0; k < K; ++k) acc += a[k] * b[k];
            u[n] = acc + (bias ? bias[bcol_off + n] : 0.f); }
        if (swiglu) { for (int n = 0; n < N / 2; ++n) { float g = fminf(u[2 * n], SW_LIMIT), l = fminf(fmaxf(u[2 * n + 1], -SW_LIMIT), SW_LIMIT); O[(size_t)r * ldc + n] = (bf16)f2bf(g * (1.0f / (1.0f + expf(-SW_ALPHA * g))) * (l + 1.0f)); } }
        else for (int n = 0; n < N; ++n) { int col = n; bf16* base = O; if (splitc) { const int t = col / splitc; base += (size_t)t * splits; col -= t * splitc; } base[(size_t)r * ldc + col] = (bf16)f2bf(u[n]); }
    }
}
#define GEMM_PLAIN(Ap, Btp, M_, N_, K_, Op, ldc_, biasp, splitc, splits) cpu_gemm_rows((Ap), (Btp), 0, (M_), (N_), (K_), 0, (Op), (ldc_), (biasp), (splitc), (size_t)(splits), 0)
static void cpu_gemm_rows8(const unsigned char* A, const unsigned char* Bt, int r0, int r1, int N, int K, int bcol_off, void* Ov, int ldc, const float* bias, int swiglu) {
    std::vector<float> Bf((size_t)N * K);
    for (int n = 0; n < N; ++n) for (int k = 0; k < K; ++k) Bf[(size_t)n * K + k] = fp8_to_f32(Bt[(size_t)(bcol_off + n) * K + k]);
#pragma omp parallel for schedule(static)
    for (int r = r0; r < r1; ++r) {
        std::vector<float> u(N), a(K);
        for (int k = 0; k < K; ++k) a[k] = fp8_to_f32(A[(size_t)r * K + k]);
        for (int n = 0; n < N; ++n) { float acc = 0.f; const float* b = &Bf[(size_t)n * K]; for (int k = 0; k < K; ++k) acc += a[k] * b[k]; u[n] = acc * (1.0f / W8_SCALE) + bias[bcol_off + n]; }
        if (swiglu) { unsigned char* O = (unsigned char*)Ov; for (int n = 0; n < N / 2; ++n) { float g = fminf(u[2 * n], SW_LIMIT), l = fminf(fmaxf(u[2 * n + 1], -SW_LIMIT), SW_LIMIT); O[(size_t)r * ldc + n] = (unsigned char)f32_to_fp8_sw(g * (1.0f / (1.0f + expf(-SW_ALPHA * g))) * (l + 1.0f)); } }
        else { unsigned char* O = (unsigned char*)Ov; for (int n = 0; n < N; ++n) O[(size_t)r * ldc + n] = (unsigned char)f32_to_fp8_sw(u[n]); }
    }
}
#define GEMM_MOE_SW(Ap, Btp, nN_, K_, Op, ldc_, biasp, ncols_) do { const int nblk = p.blke[NBLKMAX]; for (int rb = 0; rb < nblk; ++rb) { const int e = p.blke[rb]; \
    cpu_gemm_rows8((Ap), (Btp), rb * MOEB, (rb + 1) * MOEB, (ncols_), (K_), e * (ncols_), (Op), (ldc_), (biasp), 1); } } while (0)
#define GEMM_MOE(Ap, Btp, nN_, K_, Op, ldc_, biasp, splitc) do { const int nblk = p.blke[NBLKMAX]; for (int rb = 0; rb < nblk; ++rb) { const int e = p.blke[rb]; \
    cpu_gemm_rows8((Ap), (Btp), rb * MOEB, (rb + 1) * MOEB, (splitc), (K_), e * (splitc), (Op), (ldc_), (biasp), 0); } } while (0)
#define TRANSPOSE8(Wp, nmat, K_, N_, WTp) do { for (int mi = 0; mi < (nmat); ++mi) for (int k = 0; k < (K_); ++k) for (int n = 0; n < (N_); ++n) \
    (WTp)[(size_t)mi * (K_) * (N_) + (size_t)n * (K_) + k] = (unsigned char)f32_to_fp8_sw((Wp)[(size_t)mi * (K_) * (N_) + (size_t)k * (N_) + n] * W8_SCALE); } while (0)
static void dump_buf(const std::string& dir, const char* name, int l, const void* ptr, long rows, long cols, int isbf) {
    std::vector<float> v((size_t)rows * cols);
    for (long i = 0; i < rows * cols; ++i) v[i] = isbf == 1 ? bf2f(((const bf16*)ptr)[i]) : isbf == 2 ? (float)((const int*)ptr)[i] : ((const float*)ptr)[i];
    char fn[512]; snprintf(fn, sizeof fn, "%s/c_L%d_%s.bin", dir.c_str(), l, name); FILE* f = fopen(fn, "wb"); fwrite(v.data(), 4, v.size(), f); fclose(f);
}
#define DUMP(name, ptr, rows, cols, isbf) dump_buf(env.dir, name, l, ptr, rows, cols, isbf)
#endif
constexpr int NPL = 14, NPHASE = 1 + NPL * DEPTH;
#define IN(k) (env.lo <= (k) && (k) < env.hi)
#ifndef PROBE_MASK
#define PROBE_MASK 0
#endif
#define REP(bit) for (int _rep = 0; _rep < (((PROBE_MASK) >> (bit)) & 1 ? 2 : 1); ++_rep)
#define QB() const_cast<P&>(p).qbank = _rep
template <int L> HD void layer_phases(Env& env) {
        constexpr int l = L;
        const int pb = 1 + NPL * l;
        const bool last = (l == DEPTH - 1);
        const int tlo = last ? TC : 0;
        if (IN(pb + 0)) { PH_LOAD(); if (l == 0) { REP(10) BLOCKPHASE(ph_rows_ln0(p, LDSP));
            REP(9) {
            TRANSPOSE(p.w_in, DEPTH, D, INW, p.WinT);
            TRANSPOSE(p.w_out, DEPTH, D, D, p.WoutT);
            TRANSPOSE8(p.exp_w1, DEPTH * NE, D, 2 * DE, p.W1T8);
            TRANSPOSE8(p.exp_w2, DEPTH * NE, DE, D, p.W2T8);
            }
            SEAM(pb + 0); } DUMP("h", p.hb, T, D, 1); }
        if (IN(pb + 1)) { PH_LOAD(); REP(0) GEMM_PLAIN(p.hb, p.WinT + (size_t)l * INW * D, T, INW, D, p.pj, INW, (const float*)nullptr, 0, 0); DUMP("pj", p.pj, T, INW, 1); SEAM(pb + 1); }
        if (IN(pb + 2)) { PH_LOAD(); REP(1) { QB();
            if (!last) SIMPLE((long)TC * QW, ph_fch(p, gid));
            BLOCKPHASE(ph_fftA(p, l, LDSP));
            BLOCKPHASE(ph_retA(p, l, LDSP)); }
            SEAM(pb + 2);
        }
        if (IN(pb + 3)) { PH_LOAD();
            SIMPLE((long)2 * NB * RH * RDK * RDK / 2, ph_retscan(p, l, gid));
            REP(2) { QB(); BLOCKPHASE(ph_attn_wave(p, l, LDSP, !last)); }
            REP(3) { QB();
            BLOCKPHASE(ph_pool_wave(p, l, LDSP, !last));
            if (!last) SIMPLE((long)TC * QW, ph_fctx(p, gid));
            BLOCKPHASE(ph_fftB(p, l, LDSP)); }
            SEAM(pb + 3);
        }
        if (IN(pb + 4)) { PH_LOAD(); REP(4) { QB(); BLOCKPHASE(ph_retC(p, l, LDSP, !last)); } DUMP("mix", p.mix, T, D, 1); SEAM(pb + 4); }
        if (IN(pb + 5)) { PH_LOAD(); REP(5) { if (last) GEMM_PLAIN(p.mix + (size_t)TC * D, p.WoutT + (size_t)l * D * D, TL, D, D, p.y + (size_t)TC * D, D, (const float*)nullptr, 0, 0);
                                        else GEMM_PLAIN(p.mix, p.WoutT + (size_t)l * D * D, T, D, D, p.y, D, (const float*)nullptr, 0, 0); } DUMP("y", p.y, T, D, 1); SEAM(pb + 5); }
        if (IN(pb + 6)) { PH_LOAD(); BLOCKPHASE(ph_rows_res1(p, l, tlo, LDSP)); DUMP("x1", p.xs, T, D, 1); DUMP("logits", p.logits, T, NE, 0); DUMP("topi", p.topi, T, TOPK, 2); SEAM(pb + 6); }
        if (IN(pb + 9)) { PH_LOAD(); REP(6) BLOCKPHASE(ph_dispatch(p, l, tlo, LDSP)); SEAM(pb + 9); }
        if (IN(pb + 11)) { PH_LOAD(); REP(7) GEMM_MOE_SW(p.as8, p.W1T8 + (size_t)l * NE * 2 * DE * D, 2 * DE / 256, D, p.act8, DE, p.exp_b1 + (size_t)l * NE * 2 * DE, 2 * DE); SEAM(pb + 11); }
        if (IN(pb + 12)) { PH_LOAD(); REP(8) GEMM_MOE(p.act8, p.W2T8 + (size_t)l * NE * D * DE, D / 256, DE, p.ym8, D, p.exp_b2 + (size_t)l * NE * D, D); SEAM(pb + 12); }
        if (IN(pb + 13)) { PH_LOAD(); if (last) { REP(12) BLOCKPHASE(ph_rows_res2(p, l, tlo, LDSP)); } else BLOCKPHASE(ph_rows_res2(p, l, tlo, LDSP)); SEAM(pb + 13); }
}
HD void program(Env& env) {
    if (IN(0)) { PH_LOAD();
        REP(11) BLOCKPHASE(ph_mod_block(p, LDSP));
        SIMPLE((long)2 * 64 * 64 + 2 * FN1 * FN1, ph_ftab(p, gid));
        SIMPLE((long)DEPTH * 4 * PGW * PGW, ph_pwt(p, gid));
        SIMPLE((long)128 * 16, ph_rtab(p, gid));
        SIMPLE((long)LCTX, ph_ctab(p, gid));
        SEAM(0);
    }
    layer_phases<0>(env);
    layer_phases<1>(env);
    static_assert(DEPTH == 2, "two layers");
}
#ifndef CPU_TEST
#ifndef MK_ONE_LAUNCH
#define MK_ONE_LAUNCH 1
#endif
__global__ void __launch_bounds__(NT, 2) hpg_fwd(Args a) {
    extern __shared__ __attribute__((aligned(16))) unsigned char lds[];
    Env env; env.lds = (LAS unsigned char*)lds; env.lo = a.ph_lo; env.hi = a.ph_hi;
    for (int u = threadIdx.x; u < (LDS_BYTES - LDSCTL_OFF) / 4; u += NT) ((LAS unsigned*)(env.lds + LDSCTL_OFF))[u] = 0u;
    __syncthreads();
    volatile LAS unsigned* MISC = (volatile LAS unsigned*)(env.lds + MISC_OFF);
    env.bar = xcd_barrier_post((unsigned*)(a.ws + WS_CTL) + CW_BAR, MISC + 8);
    program(env);
}

extern "C" void kernel_launch(void* const* d_in, const int* in_sizes, int n_in, void* d_out, int out_size, void* d_ws, size_t ws_size, hipStream_t stream) {
    static int grid = 0;
    if (grid == 0) {
        if (n_in != 20 || in_sizes[0] != TL * D || out_size != TL * D || ws_size < WS_TOTAL) {
            fprintf(stderr, "kernel_launch: built for 20 inputs, x/out of %d floats, >= %zu bytes of workspace; got n_in %d, in0 %d, out %d, ws %zu; nothing launched\n", TL * D, (size_t)WS_TOTAL, n_in, n_in > 0 ? in_sizes[0] : -1, out_size, ws_size);
            grid = -1; return; }
        int dev = 0, cus = 0, per_cu = 0;
        if (hipGetDevice(&dev) != hipSuccess || hipDeviceGetAttribute(&cus, hipDeviceAttributeMultiprocessorCount, dev) != hipSuccess) { fprintf(stderr, "kernel_launch: device query failed\n"); grid = -1; return; }
        if (hipFuncSetAttribute((const void*)hpg_fwd, hipFuncAttributeMaxDynamicSharedMemorySize, LDS_BYTES) != hipSuccess) { fprintf(stderr, "kernel_launch: hipFuncSetAttribute failed\n"); grid = -1; return; }
        if (hipOccupancyMaxActiveBlocksPerMultiprocessor(&per_cu, (const void*)hpg_fwd, NT, LDS_BYTES) != hipSuccess || per_cu < 1)
            fprintf(stderr, "kernel_launch: note: occupancy query reports %d workgroups per CU\n", per_cu);
        (void)hipGetLastError();
        grid = cus;
    }
    if (grid < 0) return;
    if (hipMemsetAsync((char*)d_ws + WS_CTL, 0, CTL_ZERO_BYTES, stream) != hipSuccess) { fprintf(stderr, "kernel_launch: memset failed\n"); return; }
    Args a{};
    for (int i = 0; i < 20; ++i) a.in[i] = (const float*)d_in[i];
    a.out = (float*)d_out; a.ws = (unsigned char*)d_ws;
#if MK_ONE_LAUNCH
    a.ph_lo = 0; a.ph_hi = NPHASE;
    hipLaunchKernelGGL(hpg_fwd, dim3(grid), dim3(NT), LDS_BYTES, stream, a);
#else
    for (int k = 0; k < NPHASE; ++k) { a.ph_lo = k; a.ph_hi = k + 1; hipLaunchKernelGGL(hpg_fwd, dim3(grid), dim3(NT), LDS_BYTES, stream, a); }
#endif
    const hipError_t le = hipPeekAtLastError();
    if (le != hipSuccess) fprintf(stderr, "kernel_launch: launch failed: %s\n", hipGetErrorName(le));
}
#else
int main(int argc, char** argv) {
    std::string dir = argc > 1 ? argv[1] : "t";
    const size_t sizes[20] = {(size_t)TL * D, (size_t)NB * D, (size_t)TC * D, (size_t)D, (size_t)DEPTH * D * 6 * D, (size_t)DEPTH * 6 * D, (size_t)DEPTH * D * INW, (size_t)DEPTH * 4 * PGW * PGW, (size_t)DEPTH * QW,
        (size_t)DEPTH * NH, (size_t)DEPTH * 2 * RH, (size_t)DEPTH * D * D, (size_t)DEPTH * 2 * D, (size_t)DEPTH * 2 * D, (size_t)DEPTH * D * NE, (size_t)DEPTH * NE, (size_t)DEPTH * NE * D * 2 * DE, (size_t)DEPTH * NE * 2 * DE,
        (size_t)DEPTH * NE * DE * D, (size_t)DEPTH * NE * D};
    std::vector<std::vector<float>> in(20);
    FILE* f = fopen((dir + "/inputs.bin").c_str(), "rb"); if (!f) { printf("no inputs\n"); return 1; }
    for (int i = 0; i < 20; ++i) { in[i].resize(sizes[i]); if (fread(in[i].data(), 4, sizes[i], f) != sizes[i]) { printf("short read %d\n", i); return 1; } }
    fclose(f);
    std::vector<unsigned char> ws(WS_TOTAL, 0xCD); memset(ws.data(), 0, CTL_ZERO_BYTES);
    std::vector<float> out((size_t)TL * D, 0.f);
    P& p = g_P; const float** pp = (const float**)&p.x; for (int i = 0; i < 20; ++i) pp[i] = in[i].data();
    p.out = out.data(); p.ws = ws.data(); fill_views(p);
    Env env; env.lo = 0; env.hi = NPHASE; env.dir = dir;
    program(env);
    f = fopen((dir + "/c_out.bin").c_str(), "wb"); fwrite(out.data(), 4, out.size(), f); fclose(f);
    printf("cpu test done, T=%d PMAX=%d nblk(last)=%d\n", T, PMAX, p.blke[NBLKMAX]);
    return 0;
}
#endif
```

```cpp
#ifndef CPU_TEST
#include <hip/hip_runtime.h>
#include <cstdio>
#include <cstdint>
#define HD __device__ __forceinline__
#define OPAQUE_V(x) asm volatile("" : "+v"(x))
#else
#define OPAQUE_V(x)
#include <cstdio>
#include <cstdint>
#include <cstdlib>
#include <cstring>
#include <cmath>
#include <vector>
#include <string>
#include "emu.h"
#define HD static inline
static inline int atomicAdd(int* p, int v) { int o = *p; *p = o + v; return o; }
static inline float cospif(float x) { return (float)cos(M_PI * (double)x); }
static inline float sinpif(float x) { return (float)sin(M_PI * (double)x); }
struct uint4 { unsigned x, y, z, w; };
#endif

#ifndef CFG_D
#define CFG_D 1024
#define CFG_NB 4
#define CFG_SEQ 8192
#define CFG_LCTX 256
#define CFG_GW 64
#define CFG_HDIM 64
#define CFG_WIN 128
#define CFG_NE 32
#endif
constexpr int D = CFG_D, NB = CFG_NB, SEQ = CFG_SEQ, LCTX = CFG_LCTX, GW = CFG_GW, HDIM = CFG_HDIM, WIN = CFG_WIN, NE = CFG_NE;
constexpr int DEPTH = 2, TOPK = 4, DE = D;
constexpr int QW = D / 4;
constexpr int NH = QW / HDIM, NKV = 2, GQ = NH / NKV;
constexpr int RH = 4, RDK = QW / RH;
constexpr int FG = 4, FC = QW / FG;
constexpr int PGW = QW / 4;
constexpr int INW = 2 * D;
constexpr int A_OFF = 0, B_OFF = QW, Q_OFF = 2 * QW, K_OFF = 3 * QW, V_OFF = 3 * QW + QW / 2, RQ_OFF = 4 * QW, RK_OFF = 5 * QW, RV_OFF = 6 * QW, RG_OFF = 7 * QW;
constexpr int TC = NB * LCTX, TL = NB * SEQ, T = TC + TL;
constexpr int MOEB = 256;
constexpr int PMAX = T * TOPK + NE * MOEB, NBLKMAX = PMAX / MOEB;
constexpr float LN_EPS = 1e-6f, SW_LIMIT = 7.0f, SW_ALPHA = 1.702f;
constexpr float DN_ALPHA = 1.41421356237309515f;
constexpr float ROPE_BASE = 10000.0f;
static_assert(NH * HDIM == QW && RH * RDK == QW && FG * FC == QW && GQ * NKV == NH, "shape algebra");

typedef unsigned short bf16;
#ifndef CPU_TEST
typedef float cvt_f32x2_t __attribute__((ext_vector_type(2))); typedef __bf16 cvt_bf16x2_t __attribute__((ext_vector_type(2)));
HD unsigned cvt_pk_bf16(float lo, float hi) { const cvt_f32x2_t v = {lo, hi}; return __builtin_bit_cast(unsigned, __builtin_convertvector(v, cvt_bf16x2_t)); }
HD unsigned f2bf(float f) { return cvt_pk_bf16(f, f) & 0xffffu; }
#else
HD unsigned f2bf(float f) { unsigned u; __builtin_memcpy(&u, &f, 4); return (u + 0x7fffu + ((u >> 16) & 1u)) >> 16; }
HD unsigned cvt_pk_bf16(float lo, float hi) { return f2bf(lo) | (f2bf(hi) << 16); }
#endif
HD float bf2f(bf16 h) { unsigned u = (unsigned)h << 16; float f; __builtin_memcpy(&f, &u, 4); return f; }
#ifndef CPU_TEST
HD float rcp_f(float x) { return __builtin_amdgcn_rcpf(x); }
#define ST_WT16(ptr, v) asm volatile("global_store_dwordx4 %0, %1, off sc1\n\ts_nop 1" :: "v"(ptr), "v"(v) : "memory")
HD float exp2_f(float x) { return __builtin_amdgcn_exp2f(x); }
HD void sincos_rev(float rev, float& c, float& s) { c = __builtin_amdgcn_cosf(rev); s = __builtin_amdgcn_sinf(rev); }
HD float rsq_f(float x) { return __builtin_amdgcn_rsqf(x); }
HD float silu_f(float x) { return x * __builtin_amdgcn_rcpf(1.0f + __expf(-x)); }
#else
HD float rcp_f(float x) { return 1.0f / x; }
#define ST_WT16(ptr, v) (*(u32x4*)(ptr) = (v))
HD float exp2_f(float x) { return exp2f(x); }
HD void sincos_rev(float rev, float& c, float& s) { c = cospif(2.0f * rev); s = sinpif(2.0f * rev); }
HD float rsq_f(float x) { return 1.0f / sqrtf(x); }
HD float silu_f(float x) { return x / (1.0f + expf(-x)); }
#endif
constexpr float W8_SCALE = 32.0f;
HD float fp8_to_f32(unsigned c) { const unsigned sg = (c >> 7) & 1u, e = (c >> 3) & 15u, m = c & 7u; float v = e == 0 ? (float)m * 0.001953125f : ldexpf(1.0f + (float)m * 0.125f, (int)e - 7); return sg ? -v : v; }
HD unsigned f32_to_fp8_sw(float f) {
    const unsigned sg = f < 0.f ? 0x80u : 0u; float a = fabsf(f); if (!(a == a)) return 0x7Fu; if (a > 448.0f) a = 448.0f;
    if (a < 0.015625f) { const int q = (int)nearbyintf(a * 512.0f); return sg | (unsigned)q; }
    int ex; const float fr = frexpf(a, &ex); int e = ex - 1; int q = (int)nearbyintf((fr * 2.0f - 1.0f) * 8.0f); if (q == 8) { q = 0; ++e; }
    if (e > 8 || (e == 8 && q == 7)) { e = 8; q = 6; }
    return sg | (unsigned)((e + 7) << 3) | (unsigned)q;
}
#ifndef CPU_TEST
typedef float f32x4_h __attribute__((ext_vector_type(4))); typedef float f32x2_h __attribute__((ext_vector_type(2)));
HD f32x4_h unpk4_fp8(unsigned w) { const f32x2_h lo = __builtin_amdgcn_cvt_pk_f32_fp8((int)w, false), hi = __builtin_amdgcn_cvt_pk_f32_fp8((int)w, true); return (f32x4_h){lo[0], lo[1], hi[0], hi[1]}; }
HD unsigned pk4_fp8(float a, float b, float c, float d) { int w = 0; w = __builtin_amdgcn_cvt_pk_fp8_f32(a, b, w, false); w = __builtin_amdgcn_cvt_pk_fp8_f32(c, d, w, true); return (unsigned)w; }
#else
typedef float f32x4_h __attribute__((ext_vector_type(4)));
HD f32x4_h unpk4_fp8(unsigned w) { return (f32x4_h){fp8_to_f32(w & 255u), fp8_to_f32((w >> 8) & 255u), fp8_to_f32((w >> 16) & 255u), fp8_to_f32(w >> 24)}; }
HD unsigned pk4_fp8(float a, float b, float c, float d) { return f32_to_fp8_sw(a) | (f32_to_fp8_sw(b) << 8) | (f32_to_fp8_sw(c) << 16) | (f32_to_fp8_sw(d) << 24); }
#endif

constexpr size_t al256(size_t x) { return (x + 255) & ~(size_t)255; }
constexpr size_t WS_CTL = 0, CTL_ZERO_BYTES = 1u << 20;
constexpr int CW_BAR = 4096;
constexpr int CW_CNT = 16384;
constexpr size_t WS_MOD = CTL_ZERO_BYTES;
constexpr size_t WS_WIN = al256(WS_MOD + (size_t)DEPTH * (NB + 1) * 6 * D * 4);
constexpr size_t WS_WOUT = al256(WS_WIN + (size_t)DEPTH * INW * D * 2);
constexpr size_t WS_W1 = al256(WS_WOUT + (size_t)DEPTH * D * D * 2);
constexpr size_t WS_W2 = al256(WS_W1 + (size_t)DEPTH * NE * 2 * DE * D * 2);
constexpr size_t WS_WDFT = al256(WS_W2 + (size_t)DEPTH * NE * D * DE * 2);
constexpr size_t WS_XS = al256(WS_WDFT + (size_t)(4u << 20));
constexpr size_t WS_HB = al256(WS_XS + (size_t)T * D * 4);
constexpr size_t WS_LOG = al256(WS_HB + (size_t)T * D * 2);
constexpr size_t WS_TOPI = al256(WS_LOG + (size_t)T * NE * 4);
constexpr size_t WS_GATE = al256(WS_TOPI + (size_t)T * TOPK * 4);
constexpr size_t WS_RANK = al256(WS_GATE + (size_t)T * TOPK * 4);
constexpr size_t WS_POS = al256(WS_RANK + (size_t)T * TOPK * 4);
constexpr size_t WS_BLKE = al256(WS_POS + (size_t)T * TOPK * 4);
constexpr size_t WS_BLKCNT = al256(WS_BLKE + (size_t)(NBLKMAX + 64) * 4);
constexpr size_t WS_HB8 = al256(WS_BLKCNT + (size_t)DEPTH * 1024 * NE * 4);
constexpr size_t WS_ARENA = al256(WS_HB8 + (size_t)T * D);
constexpr size_t WS_PJ = WS_ARENA;
constexpr size_t WS_QR = al256(WS_PJ + (size_t)T * INW * 2);
constexpr size_t WS_KR = al256(WS_QR + (size_t)T * QW * 2);
constexpr size_t WS_ZT = al256(WS_KR + (size_t)T * (QW / 2) * 2);
constexpr size_t WS_ZC = al256(WS_ZT + (size_t)NB * QW * 2 * SEQ * 2);
constexpr size_t WS_OF = al256(WS_ZC + (size_t)TC * 2 * QW * 4);
constexpr size_t WS_MIX = al256(WS_OF + (size_t)2 * T * QW * 4);
constexpr size_t WS_Y = al256(WS_MIX + (size_t)T * D * 2);
constexpr size_t WS_MIXER_END = al256(WS_Y + (size_t)T * D * 2);
constexpr size_t WS_AS = WS_ARENA;
constexpr size_t WS_ACT = al256(WS_AS + (size_t)PMAX * D * 2);
constexpr size_t WS_YM = al256(WS_ACT + (size_t)PMAX * DE * 2);
constexpr size_t WS_MOE_END = al256(WS_YM + (size_t)PMAX * D * 2);
constexpr size_t WS_TOTAL = WS_MIXER_END > WS_MOE_END ? WS_MIXER_END : WS_MOE_END;

struct P {
    const float *x, *c, *ctx, *c_ctx, *w_mod, *b_mod, *w_in, *pool_w, *pool_scale, *attn_sink, *ret_decay, *w_out, *ln_g, *ln_b, *router_w, *router_b, *exp_w1, *exp_b1, *exp_w2, *exp_b2;
    float* out;
    unsigned char* ws; int qbank;
    float* mod; bf16 *WinT, *WoutT, *W1T, *W2T, *Wdft; bf16* xs; bf16* hb; float* logits; int* topi; float* gate; int* rank; int* pos; int* blke; int* cnt; int* blkcnt; int* rowtok; unsigned char *hb8, *W1T8, *W2T8, *as8, *act8, *ym8;
    bf16 *pj, *qr, *kr, *zt; float* zc; float* of; float* rs; bf16* rs16; bf16 *ft64, *ft128, *ct, *pwt; float* rtab; float* ctab; bf16 *mix, *y; bf16 *as, *act, *ym;
};
HD void fill_views(P& p) {
    unsigned char* ws = p.ws; p.qbank = 0;
    p.mod = (float*)(ws + WS_MOD); p.WinT = (bf16*)(ws + WS_WIN); p.WoutT = (bf16*)(ws + WS_WOUT); p.W1T = (bf16*)(ws + WS_W1); p.W2T = (bf16*)(ws + WS_W2); p.Wdft = (bf16*)(ws + WS_WDFT);
    p.xs = (bf16*)(ws + WS_XS); p.hb = (bf16*)(ws + WS_HB); p.logits = (float*)(ws + WS_LOG); p.topi = (int*)(ws + WS_TOPI); p.gate = (float*)(ws + WS_GATE); p.rank = (int*)(ws + WS_RANK);
    p.pos = (int*)(ws + WS_POS); p.blke = (int*)(ws + WS_BLKE); p.cnt = (int*)(ws + WS_CTL) + CW_CNT; p.blkcnt = (int*)(ws + WS_BLKCNT); p.rowtok = (int*)(ws + WS_AS); p.hb8 = ws + WS_HB8; p.W1T8 = ws + WS_W1; p.W2T8 = ws + WS_W2; p.as8 = ws + WS_AS; p.act8 = ws + WS_ACT; p.ym8 = ws + WS_YM;
    p.pj = (bf16*)(ws + WS_PJ); p.qr = (bf16*)(ws + WS_QR); p.kr = (bf16*)(ws + WS_KR); p.zt = (bf16*)(ws + WS_ZT); p.zc = (float*)(ws + WS_ZC); p.of = (float*)(ws + WS_OF); p.rs = (float*)(ws + WS_OF); p.rs16 = (bf16*)(ws + WS_OF); p.ft64 = (bf16*)(ws + WS_WDFT); p.ft128 = (bf16*)(ws + WS_WDFT + 65536); p.ct = (bf16*)(ws + WS_ZT); p.pwt = (bf16*)(ws + WS_WDFT + 262144); p.rtab = (float*)(ws + WS_WDFT + 524288); p.ctab = (float*)(ws + WS_WDFT + 786432);
    p.mix = (bf16*)(ws + WS_MIX); p.y = (bf16*)(ws + WS_Y); p.as = (bf16*)(ws + WS_AS); p.act = (bf16*)(ws + WS_ACT); p.ym = (bf16*)(ws + WS_YM);
}
HD int row_slot(int t) { return t < TC ? NB : (t - TC) / SEQ; }
HD void row_seq(int t, int& n, int& N, int& t0) { if (t < TC) { n = t % LCTX; N = LCTX; t0 = t - n; } else { n = (t - TC) % SEQ; N = SEQ; t0 = t - n; } }
HD const float* modp(const P& p, int l, int slot, int which) { return p.mod + ((size_t)(l * (NB + 1) + slot) * 6 + which) * D; }
HD void ph_fch(const P& p, long gid) {
    const int gc = (int)(gid % QW), t = (int)(gid / QW); const int g = gc / FC, cp = gc % FC;
    const bf16* a = p.pj + (size_t)t * INW + A_OFF + g * FC;
    float br = 0.f, bs = 0.f;
    for (int c = 0; c < FC; ++c) { float cs, sn; sincos_rev((float)((c * cp) % FC) * (1.0f / (float)FC), cs, sn); const float v = bf2f(a[c]); br += v * cs; bs += v * sn; }
    { const float s = 1.0f / sqrtf((float)LCTX * FC); p.zc[(size_t)t * 2 * QW + gc] = br * s; p.zc[(size_t)t * 2 * QW + QW + gc] = -bs * s; }
}
HD void ph_ctab(const P& p, long gid) { const float a = 2.0f * (float)gid / (float)LCTX; p.ctab[2 * gid] = cospif(a); p.ctab[2 * gid + 1] = sinpif(a); }
HD void ph_fctx(const P& p, long gid) {
    const int gc = (int)(gid % QW), t = (int)(gid / QW); const int k = t % LCTX, t0 = t - k;
    float acc = 0.f;
    float zr[16], zi[16], zr1[16], zi1[16];
#pragma unroll
    for (int u = 0; u < 16; ++u) { const float* z = p.zc + (size_t)(t0 + u) * 2 * QW; zr[u] = z[gc]; zi[u] = z[QW + gc]; }
    for (int n0 = 0; n0 < LCTX; n0 += 16) {
        if (n0 + 16 < LCTX) {
#pragma unroll
            for (int u = 0; u < 16; ++u) { const float* z = p.zc + (size_t)(t0 + n0 + 16 + u) * 2 * QW; zr1[u] = z[gc]; zi1[u] = z[QW + gc]; } }
#pragma unroll
        for (int u = 0; u < 16; ++u) { const int m = ((n0 + u) * k) % LCTX; acc += p.ctab[2 * m] * zr[u] + p.ctab[2 * m + 1] * zi[u]; }
#pragma unroll
        for (int u = 0; u < 16; ++u) { zr[u] = zr1[u]; zi[u] = zi1[u]; }
    }
    p.mix[(size_t)t * D + gc] = (bf16)f2bf(acc);
}
HD void ph_pwt(const P& p, long gid) { const int c = (int)(gid % PGW), d = (int)(gid / PGW) % PGW; const long lg = gid / (PGW * PGW); p.pwt[gid] = (bf16)f2bf(p.pool_w[(lg * PGW + c) * PGW + d]); }
#ifndef CPU_TEST
#define LAS __attribute__((address_space(3)))
typedef short bf16x8 __attribute__((ext_vector_type(8)));
typedef float f32x4 __attribute__((ext_vector_type(4)));
typedef float f32x16 __attribute__((ext_vector_type(16)));
typedef unsigned u32x4 __attribute__((ext_vector_type(4)));
typedef unsigned u32x2 __attribute__((ext_vector_type(2)));
typedef _Float16 half8 __attribute__((ext_vector_type(8)));
#define WAVE_LDS_FENCE() asm volatile("s_waitcnt lgkmcnt(0)" ::: "memory")
#define SCHED_FENCE() __builtin_amdgcn_sched_barrier(0)
#else
#define LAS
#define WAVE_LDS_FENCE() emu::wave_sync()
#define SCHED_FENCE()
#endif
constexpr int NWV = 8;
constexpr int TS = 72;
constexpr int TILE_B = 64 * TS * 2;
constexpr int WAVE_LDS = 2 * TILE_B;
HD unsigned pk2f(float lo, float hi) { return cvt_pk_bf16(lo, hi); }
template <int CTRL, int BANK = 0xF> HD float dpp_mov(float old, float v) { return __builtin_bit_cast(float, __builtin_amdgcn_update_dpp(__builtin_bit_cast(int, old), __builtin_bit_cast(int, v), CTRL, 0xF, BANK, false)); }
template <int M> HD float xchg_xor(float v) {
    if constexpr (M == 1) return dpp_mov<0xB1>(v, v);
    else if constexpr (M == 2) return dpp_mov<0x4E>(v, v);
    else if constexpr (M == 4) { float r = dpp_mov<0x104, 0x5>(v, v); return dpp_mov<0x114, 0xA>(r, v); }
    else if constexpr (M == 8) return dpp_mov<0x128>(v, v);
    else return __shfl_xor(v, M);
}
#ifndef CPU_TEST
HD float row16_sum(float v) { v += dpp_mov<0x128>(v, v);
    asm volatile("s_nop 1\n\tv_add_f32_dpp %0, %0, %0 row_ror:4 row_mask:0xf bank_mask:0xf\n\ts_nop 1\n\tv_add_f32_dpp %0, %0, %0 quad_perm:[2,3,0,1] row_mask:0xf bank_mask:0xf\n\t"
                 "s_nop 1\n\tv_add_f32_dpp %0, %0, %0 quad_perm:[1,0,3,2] row_mask:0xf bank_mask:0xf\n\ts_nop 1" : "+v"(v));
    return v; }
HD float row16_max(float v) { v = fmaxf(v, dpp_mov<0x128>(v, v));
    asm volatile("s_nop 1\n\tv_max_f32_dpp %0, %0, %0 row_ror:4 row_mask:0xf bank_mask:0xf\n\ts_nop 1\n\tv_max_f32_dpp %0, %0, %0 quad_perm:[2,3,0,1] row_mask:0xf bank_mask:0xf\n\t"
                 "s_nop 1\n\tv_max_f32_dpp %0, %0, %0 quad_perm:[1,0,3,2] row_mask:0xf bank_mask:0xf\n\ts_nop 1" : "+v"(v));
    return v; }
#else
HD float row16_sum(float v) { v += dpp_mov<0x128>(v, v); v += dpp_mov<0x124>(v, v); v += dpp_mov<0x4E>(v, v); v += dpp_mov<0xB1>(v, v); return v; }
HD float row16_max(float v) { v = fmaxf(v, dpp_mov<0x128>(v, v)); v = fmaxf(v, dpp_mov<0x124>(v, v)); v = fmaxf(v, dpp_mov<0x4E>(v, v)); v = fmaxf(v, dpp_mov<0xB1>(v, v)); return v; }
#endif
#ifndef CPU_TEST
#define R16_STEP4(op, ctl) op " %0, %0, %0 " ctl " row_mask:0xf bank_mask:0xf\n\t" op " %1, %1, %1 " ctl " row_mask:0xf bank_mask:0xf\n\t" op " %2, %2, %2 " ctl " row_mask:0xf bank_mask:0xf\n\t" op " %3, %3, %3 " ctl " row_mask:0xf bank_mask:0xf\n\t"
HD void row16_sum4(float (&v)[4]) {
    asm("s_nop 1\n\t" R16_STEP4("v_add_f32_dpp", "row_ror:8") R16_STEP4("v_add_f32_dpp", "row_ror:4") R16_STEP4("v_add_f32_dpp", "quad_perm:[2,3,0,1]") R16_STEP4("v_add_f32_dpp", "quad_perm:[1,0,3,2]") "s_nop 1"
        : "+v"(v[0]), "+v"(v[1]), "+v"(v[2]), "+v"(v[3])); }
HD void row16_max4(float (&v)[4]) {
    asm("s_nop 1\n\t" R16_STEP4("v_max_f32_dpp", "row_ror:8") R16_STEP4("v_max_f32_dpp", "row_ror:4") R16_STEP4("v_max_f32_dpp", "quad_perm:[2,3,0,1]") R16_STEP4("v_max_f32_dpp", "quad_perm:[1,0,3,2]") "s_nop 1"
        : "+v"(v[0]), "+v"(v[1]), "+v"(v[2]), "+v"(v[3])); }
#else
HD void row16_sum4(float (&v)[4]) { for (int j = 0; j < 4; ++j) v[j] = row16_sum(v[j]); }
HD void row16_max4(float (&v)[4]) { for (int j = 0; j < 4; ++j) v[j] = row16_max(v[j]); }
#endif
HD float rdlane(float v, int l) { return __builtin_bit_cast(float, __builtin_amdgcn_readlane(__builtin_bit_cast(int, v), l)); }
HD bf16x8 ldfrag(const LAS bf16* tile, int row, int k) { return *(const LAS bf16x8*)(tile + row * TS + k); }
HD void stage_tile_ld(u32x4 (&v)[8], const bf16* src, size_t gs, int lane) {
#pragma unroll
    for (int it = 0; it < 8; ++it) { const int r = it * 8 + (lane >> 3), cc = lane & 7; v[it] = *(const u32x4*)(src + (size_t)r * gs + cc * 8); }
}
HD void stage_tile_st(LAS bf16* dst, const u32x4 (&v)[8], int lane) {
#pragma unroll
    for (int it = 0; it < 8; ++it) { const int r = it * 8 + (lane >> 3), cc = lane & 7; *(LAS u32x4*)(dst + r * TS + cc * 8) = v[it]; }
}
HD void stage_tile(LAS bf16* dst, const bf16* src, size_t gs, int lane) {
#pragma unroll 4
    for (int it = 0; it < 8; ++it) { const int r = it * 8 + (lane >> 3), cc = lane & 7; const u32x4 v = *(const u32x4*)(src + (size_t)r * gs + cc * 8); *(LAS u32x4*)(dst + r * TS + cc * 8) = v; }
}
HD void stage_tile_T_ld(u32x4 (&v)[8], const bf16* src, size_t gs, int lane) {
#pragma unroll
    for (int cc = 0; cc < 8; ++cc) v[cc] = *(const u32x4*)(src + (size_t)lane * gs + cc * 8);
}
HD void stage_tile_T_st(LAS bf16* dst, const u32x4 (&v)[8], int lane, float lg, int mode, float s) {
    const int r = lane; const float w = mode == 0 ? s : s * __expf(lg * (float)(mode == 1 ? 63 - r : r));
#pragma unroll
    for (int cc = 0; cc < 8; ++cc)
#pragma unroll
        for (int e = 0; e < 4; ++e) { const unsigned u = v[cc][e];
            if (mode == 0 && s == 1.0f) { dst[(cc * 8 + 2 * e) * TS + r] = (bf16)(u & 0xffffu); dst[(cc * 8 + 2 * e + 1) * TS + r] = (bf16)(u >> 16); }
            else { dst[(cc * 8 + 2 * e) * TS + r] = (bf16)f2bf(bf2f((bf16)(u & 0xffffu)) * w); dst[(cc * 8 + 2 * e + 1) * TS + r] = (bf16)f2bf(bf2f((bf16)(u >> 16)) * w); } }
}
HD void stage_tile_T(LAS bf16* dst, const bf16* src, size_t gs, int lane, float lg, int mode, float s) { u32x4 v[8]; stage_tile_T_ld(v, src, gs, lane); stage_tile_T_st(dst, v, lane, lg, mode, s); }
HD void stage_tile_f32(LAS bf16* dst, const float* src, int lane) {
#pragma unroll 8
    for (int it = 0; it < 16; ++it) { const int r = it * 4 + (lane >> 4), c4 = lane & 15; const f32x4 v = *(const f32x4*)(src + r * 64 + c4 * 4);
        u32x2 o; o.x = pk2f(v[0], v[1]); o.y = pk2f(v[2], v[3]); *(LAS u32x2*)(dst + r * TS + c4 * 4) = o; }
}

#ifndef CPU_TEST
HD int q_pop_wave(int* ctr, int lane) { int v = 0; if (lane == 0) v = __hip_atomic_fetch_add(ctr, 1, __ATOMIC_RELAXED, __HIP_MEMORY_SCOPE_AGENT); return __builtin_amdgcn_readfirstlane(v); }
#else
HD int q_pop_wave(int* ctr, int lane) { const int base = emu::g_cur & ~63; emu::wave_sync(); if (lane == 0) emu::g_xi[base] = (*ctr)++; emu::wave_sync(); const int v = emu::g_xi[base]; emu::wave_sync(); return v; }
#endif
HD int static_task(int qiter, int ntask, int gw, int nw) {
    if (qiter == 0) return gw;
    const int rem = ntask - qiter * nw; if (rem <= 0) return 0x7fffffff;
    if (rem >= nw) return qiter * nw + gw;
    const int stride = nw / rem, r = nw - 1 - gw;
    return (r % stride == 0 && r / stride < rem) ? qiter * nw + r / stride : 0x7fffffff;
}
HD int* q_ctr(const P& p, int l, int k) { return p.cnt + 1024 + ((p.qbank * DEPTH + l) * 8 + k) * 64; }
constexpr int RCH = 64, NCH = (LCTX + SEQ) / RCH, NCHC = LCTX / RCH;
HD int ret_row0(int b, int c) { return c < NCHC ? b * LCTX + c * RCH : TC + b * SEQ + (c - NCHC) * RCH; }
HD size_t rs_off(int dir, int b, int h, int c) { return ((((size_t)dir * NB + b) * RH + h) * NCH + c) * (size_t)(RDK * RDK); }
HD void ph_retA(const P& p, int l, LAS unsigned char* lds) {
    static_assert(RDK == 64 && LCTX % RCH == 0 && SEQ % RCH == 0, "retention wave kernels are written for dk = dv = 64");
    int tid = threadIdx.x; OPAQUE_V(tid); const int wave = __builtin_amdgcn_readfirstlane(tid >> 6);
    LAS bf16* buf0 = (LAS bf16*)(lds + wave * WAVE_LDS); LAS bf16* buf1 = buf0 + 64 * TS;
    const float ksc = 1.0f / sqrtf((float)RDK);
    int qiter = 0;
    for (;;) {
        int lane = tid & 63; OPAQUE_V(lane);
        const int task = static_task(qiter++, NB * RH * NCH, (int)blockIdx.x * NWV + wave, (int)gridDim.x * NWV); if (task >= NB * RH * NCH) break;
        const int fr = lane & 15, fq = lane >> 4;
        const int c = task % NCH, h = (task / NCH) % RH, b = task / (NCH * RH);
        const bf16* base = p.pj + (size_t)ret_row0(b, c) * INW + h * RDK;
        WAVE_LDS_FENCE();
        u32x4 vv[8];
        { u32x4 kv[8]; stage_tile_T_ld(kv, base + RK_OFF, INW, lane); stage_tile_T_ld(vv, base + RV_OFF, INW, lane);
          stage_tile_T_st(buf1, kv, lane, 0.f, 0, 1.0f); }
        for (int dir = 0; dir < 2; ++dir) {
            const float lg = -expf(p.ret_decay[(l * 2 + dir) * RH + h]);
            WAVE_LDS_FENCE();
            stage_tile_T_st(buf0, vv, lane, lg, dir == 0 ? 1 : 2, ksc);
            WAVE_LDS_FENCE();
            f32x4 acc[4][4];
#pragma unroll
            for (int a = 0; a < 4; ++a)
#pragma unroll
                for (int bb = 0; bb < 4; ++bb) acc[a][bb] = (f32x4){0.f, 0.f, 0.f, 0.f};
#pragma unroll
            for (int ks = 0; ks < 2; ++ks) {
                bf16x8 af[4], bfr[4];
#pragma unroll
                for (int a = 0; a < 4; ++a) { af[a] = ldfrag(buf0, 16 * a + fr, 32 * ks + 8 * fq); bfr[a] = ldfrag(buf1, 16 * a + fr, 32 * ks + 8 * fq); }
#pragma unroll
                for (int a = 0; a < 4; ++a)
#pragma unroll
                    for (int bb = 0; bb < 4; ++bb) acc[a][bb] = __builtin_amdgcn_mfma_f32_16x16x32_bf16(af[a], bfr[bb], acc[a][bb], 0, 0, 0);
            }
            WAVE_LDS_FENCE();
#pragma unroll
            for (int a = 0; a < 4; ++a)
#pragma unroll
                for (int bb = 0; bb < 4; ++bb)
#pragma unroll
                    for (int j = 0; j < 4; ++j) buf0[(16 * a + 4 * fq + j) * TS + 16 * bb + fr] = (bf16)f2bf(acc[a][bb][j]);
            WAVE_LDS_FENCE();
            { bf16* out = p.rs16 + rs_off(dir, b, h, c);
#pragma unroll 4
              for (int it = 0; it < 8; ++it) { const int r = it * 8 + (lane >> 3), cc = lane & 7; { const u32x4 sv_ = *(const LAS u32x4*)(buf0 + r * TS + cc * 8); ST_WT16(out + r * RDK + cc * 8, sv_); } } }
        }
    }
}
HD void ph_retscan(const P& p, int l, long gid) {
    const int e2 = (int)(gid % (RDK * RDK / 2)); int r = (int)(gid / (RDK * RDK / 2)); const int h = r % RH; r /= RH; const int b = r % NB, dir = r / NB;
    const float lg = -expf(p.ret_decay[(l * 2 + dir) * RH + h]); const float dec = expf(lg * (float)RCH);
    float c0 = 0.f, c1 = 0.f;
    constexpr int SB = 44; static_assert(NCH % SB == 0, "scan batches");
#define RSC_PTR(step_) ((unsigned*)(p.rs16 + rs_off(dir, b, h, dir == 0 ? (step_) : ((step_) < NCHC ? NCHC - 1 - (step_) : NCH - 1 - ((step_) - NCHC)))) + e2)
    unsigned tv0[SB], tv1[SB];
#pragma unroll
    for (int u = 0; u < SB; ++u) tv0[u] = *RSC_PTR(u);
    for (int s0 = 0; s0 < NCH; s0 += SB) {
        if (s0 + SB < NCH) {
#pragma unroll
            for (int u = 0; u < SB; ++u) tv1[u] = *RSC_PTR(s0 + SB + u); }
#pragma unroll
        for (int u = 0; u < SB; ++u) { *RSC_PTR(s0 + u) = pk2f(c0, c1); c0 = dec * c0 + bf2f((bf16)(tv0[u] & 0xffffu)); c1 = dec * c1 + bf2f((bf16)(tv0[u] >> 16)); }
#pragma unroll
        for (int u = 0; u < SB; ++u) tv0[u] = tv1[u];
    }
#undef RSC_PTR
}
HD void ph_retC(const P& p, int l, LAS unsigned char* lds, bool with_ctx) {
    int tid = threadIdx.x; OPAQUE_V(tid); const int wave = __builtin_amdgcn_readfirstlane(tid >> 6);
    LAS bf16* buf0 = (LAS bf16*)(lds + wave * WAVE_LDS); LAS bf16* buf1 = buf0 + 64 * TS;
    const float ksc = 1.0f / sqrtf((float)RDK);
    const int nch = with_ctx ? NCH : NCH - NCHC;
    int qiter = 0;
    for (;;) {
        int lane = tid & 63; OPAQUE_V(lane);
        const int task = static_task(qiter++, NB * RH * nch, (int)blockIdx.x * NWV + wave, (int)gridDim.x * NWV); if (task >= NB * RH * nch) break;
        const int fr = lane & 15, fq = lane >> 4;
        const int c = task % nch + (NCH - nch), h = (task / nch) % RH, b = task / (nch * RH);
        const int row0 = ret_row0(b, c);
        const bf16* base = p.pj + (size_t)row0 * INW + h * RDK;
        const float lgf = -expf(p.ret_decay[(l * 2 + 0) * RH + h]), lgb = -expf(p.ret_decay[(l * 2 + 1) * RH + h]);
        WAVE_LDS_FENCE();
        u32x4 rpre[8];
        { u32x4 qv[8], kv[8]; stage_tile_ld(qv, base + RQ_OFF, INW, lane); stage_tile_ld(kv, base + RK_OFF, INW, lane); stage_tile_ld(rpre, p.rs16 + rs_off(0, b, h, c), RDK, lane);
          stage_tile_st(buf0, qv, lane); stage_tile_st(buf1, kv, lane); }
        WAVE_LDS_FENCE();
        bf16x8 qa[4][2];
#pragma unroll
        for (int a = 0; a < 4; ++a)
#pragma unroll
            for (int ks = 0; ks < 2; ++ks) qa[a][ks] = ldfrag(buf0, 16 * a + fr, 32 * ks + 8 * fq);
        f32x4 O[4][4];
#pragma unroll
        for (int a = 0; a < 4; ++a)
#pragma unroll
            for (int bb = 0; bb < 4; ++bb) O[a][bb] = (f32x4){0.f, 0.f, 0.f, 0.f};
        u32x4 vpre[8];
#pragma unroll
        for (int dir = 0; dir < 2; ++dir) {
            WAVE_LDS_FENCE();
            stage_tile_st(buf0, rpre, lane);
            if (dir == 0) stage_tile_ld(rpre, p.rs16 + rs_off(1, b, h, c), RDK, lane); else stage_tile_T_ld(vpre, base + RV_OFF, INW, lane);
            WAVE_LDS_FENCE();
            const float lgd = dir == 0 ? lgf : lgb;
#pragma unroll
            for (int bb = 0; bb < 4; ++bb) {
                f32x4 tmp[4];
#pragma unroll
                for (int a = 0; a < 4; ++a) tmp[a] = (f32x4){0.f, 0.f, 0.f, 0.f};
#pragma unroll
                for (int ks = 0; ks < 2; ++ks) { const bf16x8 rb = ldfrag(buf0, 16 * bb + fr, 32 * ks + 8 * fq);
#pragma unroll
                    for (int a = 0; a < 4; ++a) tmp[a] = __builtin_amdgcn_mfma_f32_16x16x32_bf16(qa[a][ks], rb, tmp[a], 0, 0, 0); }
#pragma unroll
                for (int a = 0; a < 4; ++a)
#pragma unroll
                    for (int j = 0; j < 4; ++j) { const int i = 16 * a + 4 * fq + j; const float xi = __expf(lgd * (float)(dir == 0 ? i + 1 : RCH - i)); O[a][bb][j] += xi * tmp[a][j]; }
                SCHED_FENCE();
            }
        }
        u32x4 gpre[8]; stage_tile_ld(gpre, base + RG_OFF, INW, lane);
        WAVE_LDS_FENCE();
#pragma unroll
        for (int bb = 0; bb < 4; ++bb) {
            f32x4 S4[4];
#pragma unroll
            for (int a = 0; a < 4; ++a) S4[a] = (f32x4){0.f, 0.f, 0.f, 0.f};
#pragma unroll
            for (int ks = 0; ks < 2; ++ks) { const bf16x8 kb = ldfrag(buf1, 16 * bb + fr, 32 * ks + 8 * fq);
#pragma unroll
                for (int a = 0; a < 4; ++a) S4[a] = __builtin_amdgcn_mfma_f32_16x16x32_bf16(qa[a][ks], kb, S4[a], 0, 0, 0); }
#pragma unroll
            for (int a = 0; a < 4; ++a)
#pragma unroll
                for (int j = 0; j < 4; ++j) { const int i = 16 * a + 4 * fq + j, jj = 16 * bb + fr;
                    const float m = (i >= jj ? __expf(lgf * (float)(i - jj)) : 0.f) + (jj >= i ? __expf(lgb * (float)(jj - i)) : 0.f);
                    buf0[i * TS + jj] = (bf16)f2bf(S4[a][j] * m * ksc); }
            SCHED_FENCE();
        }
        WAVE_LDS_FENCE();
        stage_tile_T_st(buf1, vpre, lane, 0.f, 0, 1.0f);
        WAVE_LDS_FENCE();
#pragma unroll
        for (int ks = 0; ks < 2; ++ks) {
            bf16x8 pa[4], vb[4];
#pragma unroll
            for (int a = 0; a < 4; ++a) { pa[a] = ldfrag(buf0, 16 * a + fr, 32 * ks + 8 * fq); vb[a] = ldfrag(buf1, 16 * a + fr, 32 * ks + 8 * fq); }
#pragma unroll
            for (int a = 0; a < 4; ++a)
#pragma unroll
                for (int bb = 0; bb < 4; ++bb) O[a][bb] = __builtin_amdgcn_mfma_f32_16x16x32_bf16(pa[a], vb[bb], O[a][bb], 0, 0, 0);
        }
        WAVE_LDS_FENCE();
        stage_tile_st(buf1, gpre, lane);
        WAVE_LDS_FENCE();
#pragma unroll
        for (int a = 0; a < 4; ++a) {
            float s4[4], q4[4];
#pragma unroll
            for (int j = 0; j < 4; ++j) s4[j] = (O[a][0][j] + O[a][1][j]) + (O[a][2][j] + O[a][3][j]);
            row16_sum4(s4);
#pragma unroll
            for (int j = 0; j < 4; ++j) { const float mu = s4[j] * (1.0f / RDK); s4[j] = mu; float q = 0.f;
#pragma unroll
                for (int bb = 0; bb < 4; ++bb) { const float d = O[a][bb][j] - mu; q += d * d; }
                q4[j] = q; }
            row16_sum4(q4);
#pragma unroll
            for (int j = 0; j < 4; ++j) {
                const float mu = s4[j], rstd = rsq_f(q4[j] * (1.0f / RDK) + LN_EPS);
                const int i = 16 * a + 4 * fq + j;
#pragma unroll
                for (int bb = 0; bb < 4; ++bb) { const int v = 16 * bb + fr; const float g = bf2f(buf1[i * TS + v]);
                    buf0[i * TS + v] = (bf16)f2bf(silu_f(g) * (O[a][bb][j] - mu) * rstd); }
            }
            SCHED_FENCE();
        }
        WAVE_LDS_FENCE();
        { bf16* orow = p.mix + (size_t)row0 * D + 3 * QW + h * RDK;
#pragma unroll 2
          for (int it = 0; it < 8; ++it) { const int r = it * 8 + (lane >> 3), cc = lane & 7; { const u32x4 sv_ = *(const LAS u32x4*)(buf0 + r * TS + cc * 8); ST_WT16(orow + (size_t)r * D + cc * 8, sv_); } } }
    }
}

constexpr int NJ = D / 256;
HD float wave_sum(float v) { v = row16_sum(v); return (rdlane(v, 0) + rdlane(v, 16)) + (rdlane(v, 32) + rdlane(v, 48)); }
HD void row_stats(const f32x4 (&v)[NJ], float& mu, float& rstd) {
    float s = 0.f;
#pragma unroll
    for (int j = 0; j < NJ; ++j) s += (v[j][0] + v[j][1]) + (v[j][2] + v[j][3]);
    mu = wave_sum(s) * (1.0f / D); float q = 0.f;
#pragma unroll
    for (int j = 0; j < NJ; ++j) { const f32x4 d = v[j] - mu; q += (d[0] * d[0] + d[1] * d[1]) + (d[2] * d[2] + d[3] * d[3]); }
    rstd = rsq_f(wave_sum(q) * (1.0f / D) + LN_EPS);
}
HD f32x4 ld4(const float* p) { return *(const f32x4*)p; }
HD f32x4 ld4bf(const bf16* p) { const u32x2 u = *(const u32x2*)p; f32x4 r; r[0] = bf2f((bf16)(u.x & 0xffffu)); r[1] = bf2f((bf16)(u.x >> 16)); r[2] = bf2f((bf16)(u.y & 0xffffu)); r[3] = bf2f((bf16)(u.y >> 16)); return r; }
HD void st4bf(bf16* p, f32x4 v) { u32x2 o; o.x = pk2f(v[0], v[1]); o.y = pk2f(v[2], v[3]); *(u32x2*)p = o; }
HD void row_lnmod_store(const P& p, int l, int which, int t, const f32x4 (&v)[NJ], int lane, f32x4 (*keep)[NJ], bool as_fp8 = false) {
    float mu, rstd; row_stats(v, mu, rstd);
    const int slot = row_slot(t); const float* sh = modp(p, l, slot, which); const float* sc = modp(p, l, slot, which + 1);
#pragma unroll
    for (int j = 0; j < NJ; ++j) { const int c = 4 * lane + 256 * j; const f32x4 h = (v[j] - mu) * rstd * (ld4(sc + c) + 1.0f) + ld4(sh + c);
        if (as_fp8) *(unsigned*)(p.hb8 + (size_t)t * D + c) = pk4_fp8(h[0], h[1], h[2], h[3]); else st4bf(p.hb + (size_t)t * D + c, h);
        if (keep) (*keep)[j] = h; }
}
HD void ph_mod_block(const P& p, LAS unsigned char* lds) {
    int tid = threadIdx.x; OPAQUE_V(tid);
    LAS float* sl = (LAS float*)lds;
    LAS float* red = sl + (NB + 1) * D;
    static_assert(((NB + 1) * D + 8 * (NB + 1) * 64) * 4 <= 147456 && D % 256 == 0 && (NB + 1) * 64 <= NWV * 64, "mod GEMV LDS / shape");
    { static_assert(((NB + 1) * D) % (NWV * 64) == 0, "mod input staging"); constexpr int NI = (NB + 1) * D / (NWV * 64); float cv[NI];
#pragma unroll
      for (int u = 0; u < NI; ++u) { const int i = tid + u * NWV * 64; const int slot = i / D, k = i % D; cv[u] = slot < NB ? p.c[(size_t)slot * D + k] : p.c_ctx[k]; }
#pragma unroll
      for (int u = 0; u < NI; ++u) sl[tid + u * NWV * 64] = silu_f(cv[u]); }
    __syncthreads();
    constexpr int GPL = 6 * D / 64, KP = D / 8;
    for (int grp = blockIdx.x; grp < DEPTH * GPL; grp += gridDim.x) {
        const int l = grp / GPL, j0 = (grp % GPL) * 64, col = tid & 63, kp = tid >> 6;
        const float* w = p.w_mod + ((size_t)l * D + (size_t)kp * KP) * 6 * D + j0 + col;
        float acc[NB + 1];
#pragma unroll
        for (int sidx = 0; sidx <= NB; ++sidx) acc[sidx] = 0.f;
        for (int k0 = 0; k0 < KP; k0 += 32) {
            float wv[32];
#pragma unroll
            for (int u = 0; u < 32; ++u) wv[u] = w[(size_t)(k0 + u) * 6 * D];
#pragma unroll
            for (int u = 0; u < 32; ++u)
#pragma unroll
                for (int sidx = 0; sidx <= NB; ++sidx) acc[sidx] += sl[sidx * D + kp * KP + k0 + u] * wv[u];
        }
#pragma unroll
        for (int sidx = 0; sidx <= NB; ++sidx) red[(kp * (NB + 1) + sidx) * 64 + col] = acc[sidx];
        __syncthreads();
        if (tid < (NB + 1) * 64) { const int sidx = tid >> 6; float t = p.b_mod[(size_t)l * 6 * D + j0 + col];
#pragma unroll
            for (int q = 0; q < 8; ++q) t += red[(q * (NB + 1) + sidx) * 64 + col];
            p.mod[((size_t)l * (NB + 1) + sidx) * 6 * D + j0 + col] = t; }
        __syncthreads();
    }
}
HD void ln0_row(const P& p, int t, bool live, int lane) {
    const float* src = t < TC ? p.ctx + (size_t)t * D : p.x + (size_t)(t - TC) * D;
    f32x4 v[NJ];
#pragma unroll
    for (int j = 0; j < NJ; ++j) v[j] = ld4(src + 4 * lane + 256 * j);
    float mu, rstd; row_stats(v, mu, rstd);
    const int slot = row_slot(t); const float* sh = modp(p, 0, slot, 0); const float* sc = modp(p, 0, slot, 1);
    if (live) {
#pragma unroll
        for (int j = 0; j < NJ; ++j) { const int c = 4 * lane + 256 * j; { const f32x4 h = (v[j] - mu) * rstd * (ld4(sc + c) + 1.0f) + ld4(sh + c); *(unsigned*)(p.hb8 + (size_t)t * D + c) = pk4_fp8(h[0], h[1], h[2], h[3]); } } }
}
HD void ph_rows_ln0(const P& p, LAS unsigned char* lds) {
    int tid = threadIdx.x; OPAQUE_V(tid); const int wave = __builtin_amdgcn_readfirstlane(tid >> 6);
    int lane = tid & 63; OPAQUE_V(lane);
    const int S = (int)gridDim.x * NWV; int t = (int)blockIdx.x * NWV + wave; if (t >= T) return;
#define LN0_LD(t_, x_, sh_, sc_) do { const float* src_ = (t_) < TC ? p.ctx + (size_t)(t_) * D : p.x + (size_t)((t_) - TC) * D; const int slot_ = row_slot(t_); \
        _Pragma("unroll") for (int j_ = 0; j_ < NJ; ++j_) { const int c_ = 4 * lane + 256 * j_; x_[j_] = ld4(src_ + c_); sh_[j_] = ld4(modp(p, 0, slot_, 0) + c_); sc_[j_] = ld4(modp(p, 0, slot_, 1) + c_); } } while (0)
    f32x4 x0[NJ], x1[NJ], sh0[NJ], sh1[NJ], sc0[NJ], sc1[NJ];
    LN0_LD(t, x0, sh0, sc0);
    for (; t < T; t += S) {
        if (t + S < T) LN0_LD(t + S, x1, sh1, sc1);
        float mu, rstd; row_stats(x0, mu, rstd);
#pragma unroll
        for (int j = 0; j < NJ; ++j) { const int c = 4 * lane + 256 * j; const f32x4 h = (x0[j] - mu) * rstd * (sc0[j] + 1.0f) + sh0[j]; *(unsigned*)(p.hb8 + (size_t)t * D + c) = pk4_fp8(h[0], h[1], h[2], h[3]); }
#pragma unroll
        for (int j = 0; j < NJ; ++j) { x0[j] = x1[j]; sh0[j] = sh1[j]; sc0[j] = sc1[j]; }
    }
#undef LN0_LD
}
#ifndef CPU_TEST
#define LDS_ATOMIC_INC(ptr) __hip_atomic_fetch_add((ptr), 1, __ATOMIC_RELAXED, __HIP_MEMORY_SCOPE_WORKGROUP)
#else
#define LDS_ATOMIC_INC(ptr) ((*(ptr))++)
#endif
HD int rows_per_block(int tlo) { return (T - tlo + (int)gridDim.x - 1) / (int)gridDim.x; }
template <bool L0> HD void rows_res1_impl(const P& p, int l, int tlo, LAS unsigned char* lds) {
    int tid = threadIdx.x; OPAQUE_V(tid); const int wave = __builtin_amdgcn_readfirstlane(tid >> 6);
    constexpr int WS_ = D + 8, NT = (NE + 15) / 16;
    LAS _Float16* wt = (LAS _Float16*)lds;
    LAS _Float16* ht = wt + NE * WS_ + wave * (4 * WS_);
    LAS int* hist = (LAS int*)(lds + (NE * WS_ + NWV * 4 * WS_) * 2);
    static_assert((NE * WS_ + NWV * 4 * WS_) * 2 + NE * 4 <= 147456 && NE <= 32 && D % 256 == 0, "router LDS");
    const int lane0 = tid & 63;
    { const float* rw = p.router_w + (size_t)l * D * NE;
      static_assert((D * NE) % (NWV * 64 * 4 * 16) == 0 && NE % 4 == 0, "router staging");
#pragma unroll 1
      for (int base = 0; base < D * NE; base += NWV * 64 * 4 * 16) { f32x4 rv[16];
#pragma unroll
          for (int u = 0; u < 16; ++u) rv[u] = ld4(rw + base + (u * NWV * 64 + tid) * 4);
#pragma unroll
          for (int u = 0; u < 16; ++u) { const int idx = base + (u * NWV * 64 + tid) * 4; const int i = idx / NE, e = idx % NE;
#pragma unroll
              for (int q = 0; q < 4; ++q) wt[(e + q) * WS_ + i] = (_Float16)rv[u][q]; } } }
    if (wave == 0) hist[lane0 % NE] = 0;
    __syncthreads();
    const int R = rows_per_block(tlo); const int rbeg = tlo + (int)blockIdx.x * R; const int rend = rbeg + R < T ? rbeg + R : T;
    const int nrows = rend - rbeg; const int nfull = (nrows / 32) * 8;
    const int nbatch = nfull + (nrows - nfull * 4);
    int lanep = tid & 63; OPAQUE_V(lanep);
    f32x4 lgv[NJ], lbv[NJ];
    { const float* lg = p.ln_g + (size_t)(l * 2 + 0) * D; const float* lb = p.ln_b + (size_t)(l * 2 + 0) * D;
#pragma unroll
      for (int j = 0; j < NJ; ++j) { lgv[j] = ld4(lg + 4 * lanep + 256 * j); lbv[j] = ld4(lb + 4 * lanep + 256 * j); } }
    typedef typename std::conditional<L0, f32x4, u32x2>::type xr_t;
#define R1_ROW0(bi_) ((bi_) < nfull ? rbeg + 4 * (bi_) : rbeg + 4 * nfull + ((bi_) - nfull))
#define R1_LD(t_, xr_, yv_, g1_, sh_, sc_) do { const int slot_ = row_slot(t_); \
        _Pragma("unroll") for (int j_ = 0; j_ < NJ; ++j_) { const int c_ = 4 * lanep + 256 * j_; \
            if constexpr (L0) xr_[j_] = ld4(((t_) < TC ? p.ctx + (size_t)(t_) * D : p.x + (size_t)((t_) - TC) * D) + c_); else xr_[j_] = *(const u32x2*)(p.xs + (size_t)(t_) * D + c_); \
            yv_[j_] = *(const u32x2*)(p.y + (size_t)(t_) * D + c_); g1_[j_] = ld4(modp(p, l, slot_, 2) + c_); sh_[j_] = ld4(modp(p, l, slot_, 3) + c_); sc_[j_] = ld4(modp(p, l, slot_, 4) + c_); } } while (0)
    xr_t xr0[NJ], xr1[NJ]; u32x2 yv0[NJ], yv1[NJ]; f32x4 g10[NJ], g11[NJ], sh0[NJ], sh1[NJ], sc0[NJ], sc1[NJ];
    if (wave < nbatch) { const int tf = R1_ROW0(wave); R1_LD(tf, xr0, yv0, g10, sh0, sc0); }
    for (int bi = wave; bi < nbatch; bi += NWV) {
        int lane = tid & 63; OPAQUE_V(lane);
        const int fr = lane & 15, fq = lane >> 4;
        const int t0 = R1_ROW0(bi); const int nr = bi < nfull ? 4 : 1;
        WAVE_LDS_FENCE();
#pragma unroll 1
        for (int r = 0; r < nr; ++r) {
            const int t = t0 + r;
            { const bool more = r + 1 < nr; const int bn = bi + NWV; const bool any = more || bn < nbatch; const int tn = more ? t + 1 : (bn < nbatch ? R1_ROW0(bn) : t);
              if (any) R1_LD(tn, xr1, yv1, g11, sh1, sc1); }
            f32x4 v[NJ];
#pragma unroll
            for (int j = 0; j < NJ; ++j) {
                f32x4 xr; if constexpr (L0) xr = xr0[j]; else { xr[0] = bf2f((bf16)(xr0[j].x & 0xffffu)); xr[1] = bf2f((bf16)(xr0[j].x >> 16)); xr[2] = bf2f((bf16)(xr0[j].y & 0xffffu)); xr[3] = bf2f((bf16)(xr0[j].y >> 16)); }
                f32x4 yr; yr[0] = bf2f((bf16)(yv0[j].x & 0xffffu)); yr[1] = bf2f((bf16)(yv0[j].x >> 16)); yr[2] = bf2f((bf16)(yv0[j].y & 0xffffu)); yr[3] = bf2f((bf16)(yv0[j].y >> 16));
                v[j] = xr * DN_ALPHA + g10[j] * yr; }
            float mu, rstd; row_stats(v, mu, rstd);
#pragma unroll
            for (int j = 0; j < NJ; ++j) { const int c = 4 * lane + 256 * j; v[j] = (v[j] - mu) * rstd * lgv[j] + lbv[j]; st4bf(p.xs + (size_t)t * D + c, v[j]); }
            float mu2, rstd2; row_stats(v, mu2, rstd2);
#pragma unroll
            for (int j = 0; j < NJ; ++j) { const int c = 4 * lane + 256 * j; const f32x4 h = (v[j] - mu2) * rstd2 * (sc0[j] + 1.0f) + sh0[j];
                *(unsigned*)(p.hb8 + (size_t)t * D + c) = pk4_fp8(h[0], h[1], h[2], h[3]);
                typedef _Float16 half4 __attribute__((ext_vector_type(4))); const half4 o = {(_Float16)h[0], (_Float16)h[1], (_Float16)h[2], (_Float16)h[3]}; *(LAS half4*)(ht + r * WS_ + c) = o; }
#pragma unroll
            for (int j = 0; j < NJ; ++j) { xr0[j] = xr1[j]; yv0[j] = yv1[j]; g10[j] = g11[j]; sh0[j] = sh1[j]; sc0[j] = sc1[j]; }
        }
        WAVE_LDS_FENCE();
        f32x4 acc[NT];
#pragma unroll
        for (int nt = 0; nt < NT; ++nt) acc[nt] = (f32x4){0.f, 0.f, 0.f, 0.f};
        { const int arow = nr == 4 ? (fr & 3) : 0;
#pragma unroll 4
          for (int ks = 0; ks < D / 32; ++ks) { const half8 a = *(const LAS half8*)(ht + arow * WS_ + 32 * ks + 8 * fq);
#pragma unroll
              for (int nt = 0; nt < NT; ++nt) { const int e = 16 * nt + fr; const half8 bw = *(const LAS half8*)(wt + (e < NE ? e : NE - 1) * WS_ + 32 * ks + 8 * fq);
                  acc[nt] = __builtin_amdgcn_mfma_f32_16x16x32_f16(a, bw, acc[nt], 0, 0, 0); } } }
        float lo = fq == 0 ? acc[0][0] : fq == 1 ? acc[0][1] : fq == 2 ? acc[0][2] : acc[0][3];
        float hi = -3.0e38f;
        if constexpr (NT > 1) hi = fq == 0 ? acc[NT - 1][0] : fq == 1 ? acc[NT - 1][1] : fq == 2 ? acc[NT - 1][2] : acc[NT - 1][3];
        lo = fr < NE ? lo + p.router_b[l * NE + fr] : -3.0e38f;
        if constexpr (NT > 1) hi = 16 + fr < NE ? hi + p.router_b[l * NE + (16 + fr < NE ? 16 + fr : 0)] : -3.0e38f;
        const bool rowlive = fq < nr; const int t = t0 + (rowlive ? fq : 0);
#ifdef CPU_TEST
        if (rowlive) { if (fr < NE) p.logits[(size_t)t * NE + fr] = lo; if (16 + fr < NE) p.logits[(size_t)t * NE + 16 + fr] = hi; }
#endif
        float tv0 = 0.f, tv1 = 0.f, tv2 = 0.f, tv3 = 0.f; int te0 = 0, te1 = 0, te2 = 0, te3 = 0;
#pragma unroll
        for (int k = 0; k < TOPK; ++k) {
            const float mx = row16_max(fmaxf(lo, hi));
            const unsigned blo = (unsigned)(__ballot(lo == mx) >> (16 * fq)) & 0xffffu, bhi = (unsigned)(__ballot(hi == mx) >> (16 * fq)) & 0xffffu;
            const int we = blo ? __builtin_ctz(blo) : 16 + __builtin_ctz(bhi | 0x10000u);
            if (k == 0) { tv0 = mx; te0 = we; } else if (k == 1) { tv1 = mx; te1 = we; } else if (k == 2) { tv2 = mx; te2 = we; } else { tv3 = mx; te3 = we; }
            if (we == fr) lo = -3.0e38f; if (we == 16 + fr) hi = -3.0e38f;
        }
        if (rowlive && fr < TOPK) { const float e1 = __expf(tv1 - tv0), e2 = __expf(tv2 - tv0), e3 = __expf(tv3 - tv0); const float rs = 1.0f / (1.0f + e1 + e2 + e3);
            const int ek = fr == 0 ? te0 : fr == 1 ? te1 : fr == 2 ? te2 : te3; const float gk = (fr == 0 ? 1.0f : fr == 1 ? e1 : fr == 2 ? e2 : e3) * rs;
            p.topi[(size_t)t * TOPK + fr] = ek; p.gate[(size_t)t * TOPK + fr] = gk; LDS_ATOMIC_INC(hist + ek); }
    }
    __syncthreads();
    if (wave == 0) p.blkcnt[((size_t)l * 1024 + blockIdx.x) * NE + lane0 % NE] = hist[lane0 % NE];
    __syncthreads();
}
#undef R1_LD
#undef R1_ROW0
HD void ph_rows_res1(const P& p, int l, int tlo, LAS unsigned char* lds) { if (l == 0) rows_res1_impl<true>(p, l, tlo, lds); else rows_res1_impl<false>(p, l, tlo, lds); }
HD void ph_dispatch(const P& p, int l, int tlo, LAS unsigned char* lds) {
    int tid = threadIdx.x; OPAQUE_V(tid); const int wave = __builtin_amdgcn_readfirstlane(tid >> 6), lane = tid & 63;
    LAS int* part = (LAS int*)lds;
    LAS int* tot = part + 16 * 2 * NE;
    LAS int* cur = tot + NE;
    LAS int* pst = cur + NE;
    LAS int* posl = pst + NE + 8;
    const int G = (int)gridDim.x, me = (int)blockIdx.x;
    { const int e = tid % NE, pt = tid / NE;
      const int pq = pt % 16; int st = 0, sb = 0;
#pragma unroll 1
      for (int b0 = pq; b0 < G; b0 += 16 * 16) { int cv[16];
#pragma unroll
          for (int u = 0; u < 16; ++u) { const int b = b0 + 16 * u; cv[u] = b < G ? p.blkcnt[((size_t)l * 1024 + b) * NE + e] : 0; }
#pragma unroll
          for (int u = 0; u < 16; ++u) { const int b = b0 + 16 * u; st += cv[u]; sb += b < me ? cv[u] : 0; } }
      part[(pq * 2 + 0) * NE + e] = st; part[(pq * 2 + 1) * NE + e] = sb; }
    __syncthreads();
    if (wave == 0) { const int e = lane % NE; int st = 0, sb = 0; for (int pt = 0; pt < 16; ++pt) { st += part[(pt * 2 + 0) * NE + e]; sb += part[(pt * 2 + 1) * NE + e]; } tot[e] = st; cur[e] = sb; }
    __syncthreads();
    if (wave == 0) { const int e = lane % NE; int s = 0, all = 0;
#pragma unroll
        for (int k = 0; k < NE; ++k) { const int pk = (tot[k] + MOEB - 1) / MOEB * MOEB; s += k < e ? pk : 0; all += pk; }
        const int ce = cur[e]; WAVE_LDS_FENCE(); pst[e] = s; cur[e] = ce + s; pst[NE] = all; }
    __syncthreads();
    if (me == 0) {
        const int nblk = pst[NE] / MOEB;
        for (int rb = tid; rb < nblk; rb += NWV * 64) { int e = 0;
#pragma unroll
            for (int k = 1; k < NE; ++k) e += pst[k] <= rb * MOEB ? 1 : 0;
            p.blke[rb] = e; }
        if (tid == 0) p.blke[NBLKMAX] = nblk;
    }
    const int R = rows_per_block(tlo); const int rbeg = tlo + me * R; const int rend = rbeg + R < T ? rbeg + R : T; const int na = (rend - rbeg) * TOPK;
    for (int a0 = tid; a0 < na; a0 += 4 * NWV * 64) { int ev[4];
#pragma unroll
        for (int q = 0; q < 4; ++q) { const int a = a0 + q * NWV * 64; ev[q] = a < na ? p.topi[(size_t)rbeg * TOPK + a] : 0; }
#pragma unroll
        for (int q = 0; q < 4; ++q) { const int a = a0 + q * NWV * 64; if (a < na) { const int ps = LDS_ATOMIC_INC(cur + ev[q]); posl[a] = ps; p.pos[(size_t)rbeg * TOPK + a] = ps; } } }
    __syncthreads();
    static_assert(D == 1024, "a gathered fp8 row is 64 lanes x 16 bytes");
#define DSP_LD(a0_, v_, ps_) do { _Pragma("unroll") for (int q_ = 0; q_ < 8; ++q_) { const int a_ = (a0_) + q_ < na ? (a0_) + q_ : na - 1; ps_[q_] = posl[a_]; const int t_ = rbeg + a_ / TOPK; v_[q_] = *(const u32x4*)(p.hb8 + (size_t)t_ * D + lane * 16); } } while (0)
    { u32x4 v0[8], v1[8]; int ps0[8], ps1[8];
      if (wave * 8 < na) DSP_LD(wave * 8, v0, ps0);
      for (int a0 = wave * 8; a0 < na; a0 += NWV * 8) {
        if (a0 + NWV * 8 < na) DSP_LD(a0 + NWV * 8, v1, ps1);
#pragma unroll
        for (int q = 0; q < 8; ++q) *(u32x4*)(p.as8 + (size_t)ps0[q] * D + lane * 16) = v0[q];
#pragma unroll
        for (int q = 0; q < 8; ++q) { v0[q] = v1[q]; ps0[q] = ps1[q]; }
      } }
#undef DSP_LD
    for (int i = me * NWV + wave; i < NE * MOEB; i += G * NWV) { const int e = i / MOEB, r = i % MOEB; const int row = pst[e] + tot[e] + r;
        if (row < pst[e + 1]) { unsigned zz = 0u; OPAQUE_V(zz); const u32x4 z = {zz, zz, zz, zz}; *(u32x4*)(p.as8 + (size_t)row * D + lane * 16) = z; } }
    __syncthreads();
}
HD void res2_row(const P& p, int l, int t, bool live, int lane, const float* lg, const float* lb) {
    const int slot = row_slot(t); const float* g2 = modp(p, l, slot, 5);
    const int* ps = p.pos + (size_t)t * TOPK; const float* ga = p.gate + (size_t)t * TOPK;
    const unsigned char* y0 = p.ym8 + (size_t)ps[0] * D; const unsigned char* y1 = p.ym8 + (size_t)ps[1] * D; const unsigned char* y2 = p.ym8 + (size_t)ps[2] * D; const unsigned char* y3 = p.ym8 + (size_t)ps[3] * D;
    const float a0 = ga[0], a1 = ga[1], a2 = ga[2], a3 = ga[3];
    f32x4 v[NJ];
#pragma unroll
    for (int j = 0; j < NJ; ++j) { const int c = 4 * lane + 256 * j;
        const f32x4 f = unpk4_fp8(*(const unsigned*)(y0 + c)) * a0 + unpk4_fp8(*(const unsigned*)(y1 + c)) * a1 + unpk4_fp8(*(const unsigned*)(y2 + c)) * a2 + unpk4_fp8(*(const unsigned*)(y3 + c)) * a3;
        v[j] = ld4bf(p.xs + (size_t)t * D + c) * DN_ALPHA + ld4(g2 + c) * f; }
    float mu, rstd; row_stats(v, mu, rstd);
#pragma unroll
    for (int j = 0; j < NJ; ++j) { const int c = 4 * lane + 256 * j; v[j] = (v[j] - mu) * rstd * ld4(lg + c) + ld4(lb + c); }
    if (l == DEPTH - 1) {
        if (live) {
#pragma unroll
            for (int j = 0; j < NJ; ++j) *(f32x4*)(p.out + (size_t)(t - TC) * D + 4 * lane + 256 * j) = v[j]; }
    } else {
        float mu2, rstd2; row_stats(v, mu2, rstd2);
        const float* sh = modp(p, l + 1, slot, 0); const float* sc = modp(p, l + 1, slot, 1);
        if (live) {
#pragma unroll
            for (int j = 0; j < NJ; ++j) { const int c = 4 * lane + 256 * j; st4bf(p.xs + (size_t)t * D + c, v[j]); const f32x4 h = (v[j] - mu2) * rstd2 * (ld4(sc + c) + 1.0f) + ld4(sh + c); *(unsigned*)(p.hb8 + (size_t)t * D + c) = pk4_fp8(h[0], h[1], h[2], h[3]); } }
    }
}
template <bool LASTL> HD void rows_res2_pipe(const P& p, int l, int tlo) {
    static_assert(TOPK == 4, "four gathered rows");
    typedef int i32x4 __attribute__((ext_vector_type(4)));
    int tid = threadIdx.x; OPAQUE_V(tid); const int wave = __builtin_amdgcn_readfirstlane(tid >> 6);
    int lane = tid & 63; OPAQUE_V(lane);
    const int S = (int)gridDim.x * NWV; int t = tlo + (int)blockIdx.x * NWV + wave; if (t >= T) return;
    f32x4 lgv[NJ], lbv[NJ];
    { const float* lg = p.ln_g + (size_t)(l * 2 + 1) * D; const float* lb = p.ln_b + (size_t)(l * 2 + 1) * D;
#pragma unroll
      for (int j = 0; j < NJ; ++j) { lgv[j] = ld4(lg + 4 * lane + 256 * j); lbv[j] = ld4(lb + 4 * lane + 256 * j); } }
#define R2_LD1(t_, ps_, ga_) do { ps_ = *(const i32x4*)(p.pos + (size_t)(t_) * TOPK); ga_ = *(const f32x4*)(p.gate + (size_t)(t_) * TOPK); } while (0)
#define R2_LD2(t_, ps_, ym_, xs_, g2_, sh_, sc_) do { const int slot_ = row_slot(t_); const float* g2p_ = modp(p, l, slot_, 5); \
        _Pragma("unroll") for (int e_ = 0; e_ < 4; ++e_) { const unsigned char* y_ = p.ym8 + (size_t)ps_[e_] * D + 4 * lane; _Pragma("unroll") for (int j_ = 0; j_ < NJ; ++j_) ym_[e_][j_] = *(const unsigned*)(y_ + 256 * j_); } \
        _Pragma("unroll") for (int j_ = 0; j_ < NJ; ++j_) { const int c_ = 4 * lane + 256 * j_; xs_[j_] = *(const u32x2*)(p.xs + (size_t)(t_) * D + c_); g2_[j_] = ld4(g2p_ + c_); \
            if (!LASTL) { sh_[j_] = ld4(modp(p, l + 1, slot_, 0) + c_); sc_[j_] = ld4(modp(p, l + 1, slot_, 1) + c_); } } } while (0)
    i32x4 ps0, ps1; f32x4 ga0, ga1;
    unsigned ym0[4][NJ], ym1[4][NJ]; u32x2 xs0[NJ], xs1[NJ]; f32x4 g20[NJ], g21[NJ], sh0[NJ], sh1[NJ], sc0[NJ], sc1[NJ];
    R2_LD1(t, ps0, ga0); ps1 = ps0; ga1 = ga0; if (t + S < T) R2_LD1(t + S, ps1, ga1);
    R2_LD2(t, ps0, ym0, xs0, g20, sh0, sc0);
    for (; t < T; t += S) {
        i32x4 ps2 = ps1; f32x4 ga2 = ga1;
        if (t + 2 * S < T) R2_LD1(t + 2 * S, ps2, ga2);
        if (t + S < T) R2_LD2(t + S, ps1, ym1, xs1, g21, sh1, sc1);
        f32x4 v[NJ];
#pragma unroll
        for (int j = 0; j < NJ; ++j) {
            const f32x4 f = unpk4_fp8(ym0[0][j]) * ga0[0] + unpk4_fp8(ym0[1][j]) * ga0[1] + unpk4_fp8(ym0[2][j]) * ga0[2] + unpk4_fp8(ym0[3][j]) * ga0[3];
            f32x4 xr; xr[0] = bf2f((bf16)(xs0[j].x & 0xffffu)); xr[1] = bf2f((bf16)(xs0[j].x >> 16)); xr[2] = bf2f((bf16)(xs0[j].y & 0xffffu)); xr[3] = bf2f((bf16)(xs0[j].y >> 16));
            v[j] = xr * DN_ALPHA + g20[j] * f; }
        float mu, rstd; row_stats(v, mu, rstd);
#pragma unroll
        for (int j = 0; j < NJ; ++j) v[j] = (v[j] - mu) * rstd * lgv[j] + lbv[j];
        if (LASTL) {
#pragma unroll
            for (int j = 0; j < NJ; ++j) *(f32x4*)(p.out + (size_t)(t - TC) * D + 4 * lane + 256 * j) = v[j];
        } else {
            float mu2, rstd2; row_stats(v, mu2, rstd2);
#pragma unroll
            for (int j = 0; j < NJ; ++j) { const int c = 4 * lane + 256 * j; st4bf(p.xs + (size_t)t * D + c, v[j]); const f32x4 h = (v[j] - mu2) * rstd2 * (sc0[j] + 1.0f) + sh0[j];
                *(unsigned*)(p.hb8 + (size_t)t * D + c) = pk4_fp8(h[0], h[1], h[2], h[3]); }
        }
        ps0 = ps1; ga0 = ga1; ps1 = ps2; ga1 = ga2;
#pragma unroll
        for (int j = 0; j < NJ; ++j) { xs0[j] = xs1[j]; g20[j] = g21[j]; sh0[j] = sh1[j]; sc0[j] = sc1[j];
#pragma unroll
            for (int e = 0; e < 4; ++e) ym0[e][j] = ym1[e][j]; }
    }
#undef R2_LD1
#undef R2_LD2
}
HD void ph_rows_res2(const P& p, int l, int tlo, LAS unsigned char* lds) {
    if (l == DEPTH - 1) rows_res2_pipe<true>(p, l, tlo); else rows_res2_pipe<false>(p, l, tlo);
}
HD void ph_rtab(const P& p, long gid) { const int j = (int)(gid % 16), pos = (int)(gid / 16); const float inv = powf(ROPE_BASE, -(float)(2 * j) / 32.0f); const float a = (float)pos * inv; p.rtab[2 * gid] = cosf(a); p.rtab[2 * gid + 1] = sinf(a); }
HD void stage_tile_rope_ld(u32x4 (&v)[8], const bf16* src, size_t gs, int lane) {
    const int q = lane & 3, hf = q >> 1, sc = q & 1; const int c1 = 32 * hf + 8 * sc;
#pragma unroll
    for (int it = 0; it < 4; ++it) { const int r = it * 16 + (lane >> 2); v[2 * it] = *(const u32x4*)(src + (size_t)r * gs + c1); v[2 * it + 1] = *(const u32x4*)(src + (size_t)r * gs + c1 + 16); }
}
HD void stage_tile_rope_st(LAS bf16* dst, const u32x4 (&v)[8], int lane, int n0, const float* rtab) {
    static_assert(GW == 64 || GW == 32 || GW == 16, "grid width");
    const int q = lane & 3, hf = q >> 1, sc = q & 1; const int c1 = 32 * hf + 8 * sc;
#pragma unroll
    for (int it = 0; it < 4; ++it) { const int r = it * 16 + (lane >> 2); const int n = n0 + r; const int pos = hf == 0 ? n / GW : n % GW;
        const u32x4 a = v[2 * it], b = v[2 * it + 1];
        const f32x4* tp = (const f32x4*)(rtab + (size_t)(pos * 16 + 8 * sc) * 2);
        u32x4 oa, ob;
#pragma unroll
        for (int e = 0; e < 4; ++e) { const f32x4 t = tp[e];
            const float x1l = bf2f((bf16)(a[e] & 0xffffu)), x1h = bf2f((bf16)(a[e] >> 16)), x2l = bf2f((bf16)(b[e] & 0xffffu)), x2h = bf2f((bf16)(b[e] >> 16));
            oa[e] = pk2f(x1l * t[0] - x2l * t[1], x1h * t[2] - x2h * t[3]); ob[e] = pk2f(x2l * t[0] + x1l * t[1], x2h * t[2] + x1h * t[3]); }
        *(LAS u32x4*)(dst + r * TS + c1) = oa; *(LAS u32x4*)(dst + r * TS + c1 + 16) = ob; }
}
HD void stage_tile_rope(LAS bf16* dst, const bf16* src, size_t gs, int lane, int n0, const float* rtab) {
    const int q = lane & 3, hf = q >> 1, sc = q & 1; const int c1 = 32 * hf + 8 * sc;
#pragma unroll 2
    for (int it = 0; it < 4; ++it) { const int r = it * 16 + (lane >> 2); const int n = n0 + r; const int pos = hf == 0 ? n / GW : n % GW;
        const u32x4 a = *(const u32x4*)(src + (size_t)r * gs + c1), b = *(const u32x4*)(src + (size_t)r * gs + c1 + 16);
        const f32x4* tp = (const f32x4*)(rtab + (size_t)(pos * 16 + 8 * sc) * 2);
        u32x4 oa, ob;
#pragma unroll
        for (int e = 0; e < 4; ++e) { const f32x4 t = tp[e];
            const float x1l = bf2f((bf16)(a[e] & 0xffffu)), x1h = bf2f((bf16)(a[e] >> 16)), x2l = bf2f((bf16)(b[e] & 0xffffu)), x2h = bf2f((bf16)(b[e] >> 16));
            oa[e] = pk2f(x1l * t[0] - x2l * t[1], x1h * t[2] - x2h * t[3]); ob[e] = pk2f(x2l * t[0] + x1l * t[1], x2h * t[2] + x1h * t[3]); }
        *(LAS u32x4*)(dst + r * TS + c1) = oa; *(LAS u32x4*)(dst + r * TS + c1 + 16) = ob; }
}
HD void ph_krope(const P& p, LAS unsigned char* lds) {
    int tid = threadIdx.x; OPAQUE_V(tid); const int wave = __builtin_amdgcn_readfirstlane(tid >> 6);
    LAS bf16* buf = (LAS bf16*)(lds + wave * WAVE_LDS);
    for (int task = blockIdx.x * NWV + wave; task < (TL / 64) * NKV; task += gridDim.x * NWV) {
        int lane = tid & 63; OPAQUE_V(lane);
        const int kvh = task % NKV, rb = task / NKV; const int row0 = TC + rb * 64, n0 = (rb * 64) % SEQ;
        WAVE_LDS_FENCE();
        stage_tile_rope(buf, p.pj + (size_t)row0 * INW + K_OFF + kvh * HDIM, INW, lane, n0, p.rtab);
        WAVE_LDS_FENCE();
        bf16* orow = p.kr + (size_t)row0 * (QW / 2) + kvh * HDIM;
#pragma unroll 2
        for (int it = 0; it < 8; ++it) { const int r = it * 8 + (lane >> 3), cc = lane & 7; { const u32x4 sv_ = *(const LAS u32x4*)(buf + r * TS + cc * 8); ST_WT16(orow + (size_t)r * (QW / 2) + cc * 8, sv_); } }
    }
}
HD void ph_vtrans(const P& p, LAS unsigned char* lds) {
    int tid = threadIdx.x; OPAQUE_V(tid); const int wave = __builtin_amdgcn_readfirstlane(tid >> 6);
    LAS bf16* buf = (LAS bf16*)(lds + wave * WAVE_LDS);
    for (int task = blockIdx.x * NWV + wave; task < (T / 64) * NKV; task += gridDim.x * NWV) {
        int lane = tid & 63; OPAQUE_V(lane);
        const int kvh = task % NKV, row0 = (task / NKV) * 64;
        WAVE_LDS_FENCE();
        stage_tile_T(buf, p.pj + (size_t)row0 * INW + V_OFF + kvh * HDIM, INW, lane, 0.f, 0, 1.0f);
        WAVE_LDS_FENCE();
        bf16* orow = p.qr + (size_t)(kvh * HDIM) * T + row0;
#pragma unroll 2
        for (int it = 0; it < 8; ++it) { const int r = it * 8 + (lane >> 3), cc = lane & 7; { const u32x4 sv_ = *(const LAS u32x4*)(buf + r * TS + cc * 8); ST_WT16(orow + (size_t)r * T + cc * 8, sv_); } }
    }
}

HD void ph_attn_wave(const P& p, int l, LAS unsigned char* lds, bool with_ctx) {
    static_assert(HDIM == 64 && WIN == 128 && SEQ % 64 == 0 && LCTX % 64 == 0, "attention wave kernel is written for head dim 64, window 128");
    int tid = threadIdx.x; OPAQUE_V(tid); const int wave = __builtin_amdgcn_readfirstlane(tid >> 6);
    LAS bf16* buf0 = (LAS bf16*)(lds + wave * WAVE_LDS); LAS bf16* buf1 = buf0 + 64 * TS;
    constexpr int NQB = SEQ / 64, NCB = LCTX / 64, NLAT = NB * NH * NQB;
    const int ntask = NLAT + (with_ctx ? NB * NH * NCB : 0);
    int qiter = 0;
    for (;;) {
        int lane = tid & 63; OPAQUE_V(lane);
        const int task = static_task(qiter++, ntask, (int)blockIdx.x * NWV + wave, (int)gridDim.x * NWV); if (task >= ntask) break;
        const int fr = lane & 15, fq = lane >> 4;
        const bool isctx = task >= NLAT; const int r = isctx ? task - NLAT : task; const int nqb = isctx ? NCB : NQB;
        const int qb = r % nqb, h = (r / nqb) % NH, b = r / (nqb * NH), kvh = h / GQ;
        const int qrow0 = isctx ? b * LCTX + qb * 64 : TC + b * SEQ + qb * 64;
        WAVE_LDS_FENCE();
        if (isctx) stage_tile(buf0, p.pj + (size_t)qrow0 * INW + Q_OFF + h * HDIM, INW, lane);
        else stage_tile_rope(buf0, p.pj + (size_t)qrow0 * INW + Q_OFF + h * HDIM, INW, lane, qb * 64, p.rtab);
        WAVE_LDS_FENCE();
        bf16x8 qa[4][2];
#pragma unroll
        for (int a = 0; a < 4; ++a)
#pragma unroll
            for (int ks = 0; ks < 2; ++ks) qa[a][ks] = ldfrag(buf0, 16 * a + fr, 32 * ks + 8 * fq);
        f32x4 O[4][4]; float m[4][4], ls[4][4];
        const float sink = p.attn_sink[l * NH + h];
#pragma unroll
        for (int a = 0; a < 4; ++a)
#pragma unroll
            for (int j = 0; j < 4; ++j) { m[a][j] = sink * 1.44269504089f; ls[a][j] = 1.0f; O[a][j] = (f32x4){0.f, 0.f, 0.f, 0.f}; }
        const int tlo = isctx ? 0 : (qb >= 2 ? -2 : -qb), thi = isctx ? -1 : (qb + 2 < NQB ? 2 : NQB - 1 - qb); const int nl = thi - tlo + 1, nst = nl + NCB;
#define ATT_SRC(st_, kp, kgs, vp, mt) do { if ((st_) < nl) { const int tt = tlo + (st_); const int krow0 = TC + b * SEQ + qb * 64 + 64 * tt; kp = p.kr + (size_t)krow0 * (QW / 2) + kvh * HDIM; kgs = QW / 2; \
            vp = p.qr + (size_t)(kvh * HDIM) * T + krow0; mt = tt == -2 ? 1 : (tt == 2 ? 2 : 0); } else { const int krow0 = b * LCTX + ((st_) - nl) * 64; kp = p.pj + (size_t)krow0 * INW + K_OFF + kvh * HDIM; kgs = INW; \
            vp = p.qr + (size_t)(kvh * HDIM) * T + krow0; mt = 0; } } while (0)
        u32x4 kpre[8], vpre[8]; int mtype = 0;
        { const bf16* kp; const bf16* vp; size_t kgs; ATT_SRC(0, kp, kgs, vp, mtype); stage_tile_ld(kpre, kp, kgs, lane); stage_tile_ld(vpre, vp, T, lane); }
#pragma unroll 1
        for (int st = 0; st < nst; ++st) {
            const int mcur = mtype; const int sn = st + 1 < nst ? st + 1 : st;
            const bf16* kpn; const bf16* vpn; size_t kgn; ATT_SRC(sn, kpn, kgn, vpn, mtype);
            WAVE_LDS_FENCE();
            stage_tile_st(buf0, kpre, lane); stage_tile_st(buf1, vpre, lane);
            WAVE_LDS_FENCE();
            f32x4 S[4][4];
#pragma unroll
            for (int bb = 0; bb < 4; ++bb) { const bf16x8 kb0 = ldfrag(buf0, 16 * bb + fr, 8 * fq), kb1 = ldfrag(buf0, 16 * bb + fr, 32 + 8 * fq);
#pragma unroll
                for (int a = 0; a < 4; ++a) S[a][bb] = __builtin_amdgcn_mfma_f32_16x16x32_bf16(qa[a][0], kb0, (f32x4){0.f, 0.f, 0.f, 0.f}, 0, 0, 0);
#pragma unroll
                for (int a = 0; a < 4; ++a) S[a][bb] = __builtin_amdgcn_mfma_f32_16x16x32_bf16(qa[a][1], kb1, S[a][bb], 0, 0, 0); }
#pragma unroll
            for (int a = 0; a < 4; ++a)
#pragma unroll
                for (int bb = 0; bb < 4; ++bb) S[a][bb] = S[a][bb] * (0.125f * 1.44269504089f);
            WAVE_LDS_FENCE();
            int frk = fr, fqk = fq; OPAQUE_V(frk); OPAQUE_V(fqk);
#pragma unroll
            for (int a = 0; a < 4; ++a) {
                float mx[4], al[4], rs[4];
#pragma unroll
                for (int j = 0; j < 4; ++j) {
                    const int i = 16 * a + 4 * fqk + j;
                    mx[j] = -3.0e38f;
                    if (mcur != 0) {
#pragma unroll
                        for (int bb = 0; bb < 4; ++bb) { const int jj = 16 * bb + frk; if ((mcur == 1 && jj < i) || (mcur == 2 && jj > i)) S[a][bb][j] = -1.0e30f; } }
#pragma unroll
                    for (int bb = 0; bb < 4; ++bb) mx[j] = fmaxf(mx[j], S[a][bb][j]);
                }
                row16_max4(mx);
#pragma unroll
                for (int j = 0; j < 4; ++j) {
                    const int i = 16 * a + 4 * fqk + j;
                    const float mn = fmaxf(m[a][j], mx[j]); al[j] = exp2_f(m[a][j] - mn); m[a][j] = mn;
                    rs[j] = 0.f;
#pragma unroll
                    for (int bb = 0; bb < 4; ++bb) { const float pe = exp2_f(S[a][bb][j] - mn); rs[j] += pe; buf0[i * TS + 16 * bb + frk] = (bf16)f2bf(pe); }
                }
                row16_sum4(rs);
#pragma unroll
                for (int j = 0; j < 4; ++j) {
                    ls[a][j] = ls[a][j] * al[j] + rs[j];
#pragma unroll
                    for (int vb = 0; vb < 4; ++vb) O[a][vb][j] *= al[j];
                }
                SCHED_FENCE();
                if (a == 2) stage_tile_ld(kpre, kpn, kgn, lane);
                if (a == 3) stage_tile_ld(vpre, vpn, T, lane);
            }
            WAVE_LDS_FENCE();
#pragma unroll
            for (int ks = 0; ks < 2; ++ks) {
                bf16x8 pa[4], vb[4];
#pragma unroll
                for (int a = 0; a < 4; ++a) { pa[a] = ldfrag(buf0, 16 * a + fr, 32 * ks + 8 * fq); vb[a] = ldfrag(buf1, 16 * a + fr, 32 * ks + 8 * fq); }
#pragma unroll
                for (int a = 0; a < 4; ++a)
#pragma unroll
                    for (int bb = 0; bb < 4; ++bb) O[a][bb] = __builtin_amdgcn_mfma_f32_16x16x32_bf16(pa[a], vb[bb], O[a][bb], 0, 0, 0);
            }
        }
        WAVE_LDS_FENCE();
#pragma unroll
        for (int a = 0; a < 4; ++a)
#pragma unroll
            for (int j = 0; j < 4; ++j) { const float rl = rcp_f(ls[a][j]); const int i = 16 * a + 4 * fq + j;
#pragma unroll
                for (int vb = 0; vb < 4; ++vb) buf0[i * TS + 16 * vb + fr] = (bf16)f2bf(O[a][vb][j] * rl); }
        WAVE_LDS_FENCE();
        { bf16* orow = p.mix + (size_t)qrow0 * D + 2 * QW + h * HDIM;
#pragma unroll 2
          for (int it = 0; it < 8; ++it) { const int rr = it * 8 + (lane >> 3), cc = lane & 7; { const u32x4 sv_ = *(const LAS u32x4*)(buf0 + rr * TS + cc * 8); ST_WT16(orow + (size_t)rr * D + cc * 8, sv_); } } }
    }
}
#undef ATT_SRC

constexpr int FN1 = SEQ / 64;
HD void ph_ftab(const P& p, long gid) {
    if (gid < 2 * 64 * 64) { const int s = (int)(gid / 4096), r = (int)(gid % 4096) / 64, k = (int)(gid % 64); const float a = 2.0f * (float)((r * k) % 64) / 64.0f; p.ft64[gid] = (bf16)f2bf(s == 0 ? cospif(a) : sinpif(a)); }
    else { const long g2 = gid - 2 * 64 * 64; const int s = (int)(g2 / (FN1 * FN1)), r = (int)(g2 % (FN1 * FN1)) / FN1, k = (int)(g2 % FN1); const float a = 2.0f * (float)((r * k) % FN1) / (float)FN1; p.ft128[g2] = (bf16)f2bf(s == 0 ? cospif(a) : sinpif(a)); }
}
constexpr int XS = FN1 + 8;
HD void ph_fftA(const P& p, int l, LAS unsigned char* lds) {
    static_assert(FC == 64 && FN1 % 32 == 0 && FN1 <= 16 * NWV && SEQ == 64 * FN1, "FFT stage A is written for 64 channels per group and SEQ = 64 * 128");
    int tid = threadIdx.x; OPAQUE_V(tid); const int wave = __builtin_amdgcn_readfirstlane(tid >> 6);
    constexpr int NRT = FN1 / 16;
    LAS bf16* xt = (LAS bf16*)lds;
    LAS bf16* w64 = xt + 64 * XS;
    LAS bf16* ul = w64 + 2 * 64 * TS + wave * (2 * 16 * TS);
    static_assert((64 * XS + 2 * 64 * TS + NWV * 2 * 16 * TS) * 2 <= 147456, "FFT stage A LDS");
    __syncthreads();
    { static_assert(2 * 64 * 8 == 2 * NWV * 64, "two table pieces per thread"); u32x4 tv[2];
#pragma unroll
      for (int q = 0; q < 2; ++q) { const int i = tid + q * NWV * 64, r = i >> 3, cc = i & 7; tv[q] = *(const u32x4*)(p.ft64 + r * 64 + cc * 8); }
#pragma unroll
      for (int q = 0; q < 2; ++q) { const int i = tid + q * NWV * 64, r = i >> 3, cc = i & 7; *(LAS u32x4*)(w64 + r * TS + cc * 8) = tv[q]; } }
    constexpr int KST = FN1 / 32;
    bf16x8 wc[KST], wsn[KST];
    {
        const int lane0 = tid & 63, fr0 = lane0 & 15, fq0 = lane0 >> 4;
#pragma unroll
        for (int ks = 0; ks < KST; ++ks) {
            const int row = 16 * (wave % NRT) + fr0, k = 32 * ks + 8 * fq0;

            wc[ks] = *(const bf16x8*)(p.ft128 + row * FN1 + k); wsn[ks] = *(const bf16x8*)(p.ft128 + FN1 * FN1 + row * FN1 + k);
        }
    }
    const int ntask = NB * FG * 64;
    static_assert(FN1 * 8 == 2 * NWV * 64, "two X pieces per thread");
    u32x4 xv[2];
#define FFTA_LD(tk) do { const int n2_ = (tk) % 64, g_ = ((tk) / 64) % FG, b_ = (tk) / (64 * FG); _Pragma("unroll") for (int q_ = 0; q_ < 2; ++q_) { const int i_ = tid + q_ * NWV * 64, n1_ = i_ % FN1, cc_ = i_ / FN1; \
        xv[q_] = *(const u32x4*)(p.pj + (size_t)(TC + b_ * SEQ + n1_ * 64 + n2_) * INW + A_OFF + g_ * FC + cc_ * 8); } } while (0)
    if ((int)blockIdx.x < ntask) FFTA_LD((int)blockIdx.x);
    for (int task = blockIdx.x; task < ntask; task += gridDim.x) {
        int lane = tid & 63; OPAQUE_V(lane);
        const int fr = lane & 15, fq = lane >> 4;
        __syncthreads();
        const int n2 = task % 64, g = (task / 64) % FG, b = task / (64 * FG);
#pragma unroll
        for (int q = 0; q < 2; ++q) { const int i = tid + q * NWV * 64, n1 = i % FN1, cc = i / FN1; const u32x4 v = xv[q];
#pragma unroll
            for (int e = 0; e < 4; ++e) { xt[(cc * 8 + 2 * e) * XS + n1] = (bf16)(v[e] & 0xffffu); xt[(cc * 8 + 2 * e + 1) * XS + n1] = (bf16)(v[e] >> 16); } }
        if (task + (int)gridDim.x < ntask) FFTA_LD(task + (int)gridDim.x);
        __syncthreads();
        if (wave < NRT) {
            f32x4 Uc[4], Us[4];
#pragma unroll
            for (int ct = 0; ct < 4; ++ct) { Uc[ct] = (f32x4){0.f, 0.f, 0.f, 0.f}; Us[ct] = (f32x4){0.f, 0.f, 0.f, 0.f}; }
#pragma unroll
            for (int ks = 0; ks < KST; ++ks)
#pragma unroll
                for (int ct = 0; ct < 4; ++ct) { const bf16x8 xb = *(const LAS bf16x8*)(xt + (16 * ct + fr) * XS + 32 * ks + 8 * fq);
                    Uc[ct] = __builtin_amdgcn_mfma_f32_16x16x32_bf16(wc[ks], xb, Uc[ct], 0, 0, 0); Us[ct] = __builtin_amdgcn_mfma_f32_16x16x32_bf16(wsn[ks], xb, Us[ct], 0, 0, 0); }
            WAVE_LDS_FENCE();
#pragma unroll
            for (int ct = 0; ct < 4; ++ct)
#pragma unroll
                for (int j = 0; j < 4; ++j) { ul[(4 * fq + j) * TS + 16 * ct + fr] = (bf16)f2bf(Uc[ct][j]); ul[(16 + 4 * fq + j) * TS + 16 * ct + fr] = (bf16)f2bf(Us[ct][j]); }
            WAVE_LDS_FENCE();
            f32x4 T1[4], T2[4], T3[4];
#pragma unroll
            for (int ct = 0; ct < 4; ++ct) { T1[ct] = (f32x4){0.f, 0.f, 0.f, 0.f}; T2[ct] = (f32x4){0.f, 0.f, 0.f, 0.f}; T3[ct] = (f32x4){0.f, 0.f, 0.f, 0.f}; }
#pragma unroll
            for (int ks = 0; ks < 2; ++ks) { const bf16x8 uc = ldfrag(ul, fr, 32 * ks + 8 * fq), us = ldfrag(ul + 16 * TS, fr, 32 * ks + 8 * fq);
#pragma unroll
                for (int ct = 0; ct < 4; ++ct) { const bf16x8 cb = ldfrag(w64, 16 * ct + fr, 32 * ks + 8 * fq), sb = ldfrag(w64 + 64 * TS, 16 * ct + fr, 32 * ks + 8 * fq);
                    T1[ct] = __builtin_amdgcn_mfma_f32_16x16x32_bf16(uc, cb, T1[ct], 0, 0, 0); T2[ct] = __builtin_amdgcn_mfma_f32_16x16x32_bf16(us, sb, T2[ct], 0, 0, 0);
                    T3[ct] = __builtin_amdgcn_mfma_f32_16x16x32_bf16(uc, sb, T3[ct], 0, 0, 0); T3[ct] = __builtin_amdgcn_mfma_f32_16x16x32_bf16(us, cb, T3[ct], 0, 0, 0); } }
            WAVE_LDS_FENCE();
            LAS bf16* ot = ul;
            static_assert(16 * 136 <= 2 * 16 * TS, "FFT stage A output tile fits the per-wave slice");
#pragma unroll
            for (int j = 0; j < 4; ++j) { const int k1 = 16 * wave + 4 * fq + j;
                float cs, sn; sincos_rev((float)((n2 * k1) % SEQ) * (1.0f / (float)SEQ), cs, sn);
#pragma unroll
                for (int ct = 0; ct < 4; ++ct) { const float cre = T1[ct][j] - T2[ct][j], cim = -T3[ct][j];
                    ot[(4 * fq + j) * 136 + 16 * ct + fr] = (bf16)f2bf(cre * cs + cim * sn); ot[(4 * fq + j) * 136 + 64 + 16 * ct + fr] = (bf16)f2bf(cim * cs - cre * sn); } }
            WAVE_LDS_FENCE();
            { bf16* obase = p.ct + ((size_t)((b * FG + g) * 64 + n2) * FN1 + 16 * wave) * 128;
#pragma unroll
              for (int it = 0; it < 4; ++it) { const int rr = it * 4 + (lane >> 4), cc = lane & 15; { const u32x4 sv_ = *(const LAS u32x4*)(ot + rr * 136 + cc * 8); ST_WT16(obase + (size_t)rr * 128 + cc * 8, sv_); } } }
        }
    }
    __syncthreads();
}
#undef FFTA_LD
HD void ph_fftB(const P& p, int l, LAS unsigned char* lds) {
    int tid = threadIdx.x; OPAQUE_V(tid); const int wave = __builtin_amdgcn_readfirstlane(tid >> 6);
    LAS bf16* buf0 = (LAS bf16*)(lds + wave * WAVE_LDS); LAS bf16* buf1 = buf0 + 64 * TS;
    const float scale = 1.0f / sqrtf((float)SEQ * 64.0f);
    const int ntask = NB * FG * FN1;
    int qiter = 0;
    for (;;) {
        int lane = tid & 63; OPAQUE_V(lane);
        const int task = static_task(qiter++, ntask, (int)blockIdx.x * NWV + wave, (int)gridDim.x * NWV); if (task >= ntask) break;
        const int fr = lane & 15, fq = lane >> 4;
        const int k1 = task % FN1, g = (task / FN1) % FG, b = task / (FN1 * FG);
        const bf16* src = p.ct + ((size_t)((b * FG + g) * 64) * FN1 + k1) * 128;
        WAVE_LDS_FENCE();
        { u32x4 rv[8], iv[8]; stage_tile_T_ld(rv, src, (size_t)FN1 * 128, lane); stage_tile_T_ld(iv, src + 64, (size_t)FN1 * 128, lane);
          stage_tile_T_st(buf0, rv, lane, 0.f, 0, 1.0f);
          stage_tile_T_st(buf1, iv, lane, 0.f, 0, 1.0f); }
        WAVE_LDS_FENCE();
        f32x4 Y[4][4];
#pragma unroll
        for (int a = 0; a < 4; ++a)
#pragma unroll
            for (int bb = 0; bb < 4; ++bb) Y[a][bb] = (f32x4){0.f, 0.f, 0.f, 0.f};
#pragma unroll
        for (int ks = 0; ks < 2; ++ks) {
            bf16x8 ca[4], sa[4];
#pragma unroll
            for (int a = 0; a < 4; ++a) { ca[a] = *(const bf16x8*)(p.ft64 + (16 * a + fr) * 64 + 32 * ks + 8 * fq); sa[a] = *(const bf16x8*)(p.ft64 + 4096 + (16 * a + fr) * 64 + 32 * ks + 8 * fq); }
#pragma unroll
            for (int bb = 0; bb < 4; ++bb) { const bf16x8 rb = ldfrag(buf0, 16 * bb + fr, 32 * ks + 8 * fq), ib = ldfrag(buf1, 16 * bb + fr, 32 * ks + 8 * fq);
#pragma unroll
                for (int a = 0; a < 4; ++a) { Y[a][bb] = __builtin_amdgcn_mfma_f32_16x16x32_bf16(ca[a], rb, Y[a][bb], 0, 0, 0); Y[a][bb] = __builtin_amdgcn_mfma_f32_16x16x32_bf16(sa[a], ib, Y[a][bb], 0, 0, 0); } }
        }
        WAVE_LDS_FENCE();
#pragma unroll
        for (int a = 0; a < 4; ++a)
#pragma unroll
            for (int bb = 0; bb < 4; ++bb)
#pragma unroll
                for (int j = 0; j < 4; ++j) buf0[(16 * a + 4 * fq + j) * TS + 16 * bb + fr] = (bf16)f2bf(Y[a][bb][j] * scale);
        WAVE_LDS_FENCE();
        { bf16* orow = p.mix + (size_t)(TC + b * SEQ + k1) * D + g * FC;
#pragma unroll 2
          for (int it = 0; it < 8; ++it) { const int k2 = it * 8 + (lane >> 3), cc = lane & 7; { const u32x4 sv_ = *(const LAS u32x4*)(buf0 + k2 * TS + cc * 8); ST_WT16(orow + (size_t)k2 * FN1 * D + cc * 8, sv_); } } }
    }
}

template <int HW> HD void pool_frags(bf16x8 (&pa)[4][2], const LAS bf16* hb, int fr, int fq, int n0, int N) {
#pragma unroll
    for (int a = 0; a < 4; ++a) { const int i = 16 * a + fr, n = n0 + i; int lo = n - HW; if (lo < 0) lo = 0; int hi = n + HW; if (hi > N) hi = N; const float rc = rcp_f((float)(hi - lo));
#pragma unroll
        for (int ks = 0; ks < 2; ++ks) {
            float s[8];
#pragma unroll
            for (int e = 0; e < 8; ++e) s[e] = 0.f;
#pragma unroll
            for (int d = 0; d < 2 * HW; ++d) { const u32x4 v = *(const LAS u32x4*)(hb + (i + 8 - HW + d) * TS + 32 * ks + 8 * fq);
#pragma unroll
                for (int e = 0; e < 4; ++e) { s[2 * e] += bf2f((bf16)(v[e] & 0xffffu)); s[2 * e + 1] += bf2f((bf16)(v[e] >> 16)); } }
            const u32x4 sv = *(const LAS u32x4*)(hb + (i + 8) * TS + 32 * ks + 8 * fq);
            u32x4 o;
#pragma unroll
            for (int e = 0; e < 4; ++e) o[e] = pk2f(s[2 * e] * rc - bf2f((bf16)(sv[e] & 0xffffu)), s[2 * e + 1] * rc - bf2f((bf16)(sv[e] >> 16)));
            pa[a][ks] = __builtin_bit_cast(bf16x8, o);
        } }
}

HD void ph_pool_wave(const P& p, int l, LAS unsigned char* lds, bool with_ctx) {
    static_assert(PGW == 64 && LCTX % 64 == 0 && SEQ % 64 == 0 && 80 * TS * 2 <= WAVE_LDS, "pool wave kernel is written for 64-wide groups");
    int tid = threadIdx.x; OPAQUE_V(tid); const int wave = __builtin_amdgcn_readfirstlane(tid >> 6);
    LAS bf16* hb = (LAS bf16*)(lds + wave * WAVE_LDS);
    const int rb0 = with_ctx ? 0 : TC / 64; const int ntask = (T / 64 - rb0) * 4;
    int qiter = 0;
    for (;;) {
        int lane = tid & 63; OPAQUE_V(lane);
        const int task = static_task(qiter++, ntask, (int)blockIdx.x * NWV + wave, (int)gridDim.x * NWV); if (task >= ntask) break;
        const int fr = lane & 15, fq = lane >> 4;
        const int g = 3 - task / (T / 64 - rb0), rb = rb0 + task % (T / 64 - rb0);
        const int r0 = rb * 64; const int hw = 1 << g;
        int n0, N, t0; row_seq(r0, n0, N, t0);
        WAVE_LDS_FENCE();
        { u32x4 hv[10];
#pragma unroll
          for (int it = 0; it < 10; ++it) { const int rr = it * 8 + (lane >> 3), cc = lane & 7; const int n = n0 - 8 + rr;
              const u32x4 z = {0u, 0u, 0u, 0u}; hv[it] = z; if (n >= 0 && n < N) hv[it] = *(const u32x4*)(p.pj + (size_t)(t0 + n) * INW + B_OFF + g * PGW + cc * 8); }
#pragma unroll
          for (int it = 0; it < 10; ++it) { const int rr = it * 8 + (lane >> 3), cc = lane & 7; *(LAS u32x4*)(hb + rr * TS + cc * 8) = hv[it]; } }
        WAVE_LDS_FENCE();
        bf16x8 pa[4][2];
        switch (g) { case 0: pool_frags<1>(pa, hb, fr, fq, n0, N); break; case 1: pool_frags<2>(pa, hb, fr, fq, n0, N); break; case 2: pool_frags<4>(pa, hb, fr, fq, n0, N); break; default: pool_frags<8>(pa, hb, fr, fq, n0, N); break; }
        f32x4 Y[4][4];
#pragma unroll
        for (int a = 0; a < 4; ++a)
#pragma unroll
            for (int dt = 0; dt < 4; ++dt) Y[a][dt] = (f32x4){0.f, 0.f, 0.f, 0.f};
        const bf16* wt = p.pwt + (size_t)(l * 4 + g) * PGW * PGW;
#pragma unroll
        for (int dt = 0; dt < 4; ++dt)
#pragma unroll
            for (int ks = 0; ks < 2; ++ks) { const bf16x8 wb = *(const bf16x8*)(wt + (16 * dt + fr) * PGW + 32 * ks + 8 * fq);
#pragma unroll
                for (int a = 0; a < 4; ++a) Y[a][dt] = __builtin_amdgcn_mfma_f32_16x16x32_bf16(pa[a][ks], wb, Y[a][dt], 0, 0, 0); }
        WAVE_LDS_FENCE();
#pragma unroll
        for (int dt = 0; dt < 4; ++dt) { const float sc = p.pool_scale[(size_t)l * QW + g * PGW + 16 * dt + fr];
#pragma unroll
            for (int a = 0; a < 4; ++a)
#pragma unroll
                for (int j = 0; j < 4; ++j) hb[(16 * a + 4 * fq + j) * TS + 16 * dt + fr] = (bf16)f2bf(Y[a][dt][j] * sc); }
        WAVE_LDS_FENCE();
        { bf16* orow = p.mix + (size_t)r0 * D + QW + g * PGW;
#pragma unroll 2
          for (int it = 0; it < 8; ++it) { const int rr = it * 8 + (lane >> 3), cc = lane & 7; { const u32x4 sv_ = *(const LAS u32x4*)(hb + rr * TS + cc * 8); ST_WT16(orow + (size_t)rr * D + cc * 8, sv_); } } }
    }
}
#ifndef CPU_TEST
namespace pg8 {
#define PG8_LAS __attribute__((address_space(3)))
typedef unsigned short bf16_t;
typedef short bf16x8 __attribute__((ext_vector_type(8)));
typedef float f32x4 __attribute__((ext_vector_type(4)));
typedef unsigned u32x4 __attribute__((ext_vector_type(4)));
constexpr int BM = 256, BK = 64, HALF = 128, HTB = HALF * BK * 2  , STAGE_BYTES = 8 * HTB, NXCD = 8, WGM = 8;

__host__ __device__ __forceinline__ int lds_byte(int r, int c) { const int st = (r >> 4) * 2 + (c >> 5), rr = r & 15, cc = c & 31, ob = rr * 64 + cc * 2; return st * 1024 + (ob ^ (((ob >> 9) & 1) << 5)); }
__host__ __device__ __forceinline__ void stage_rc(int b, int& R, int& C) { const int st = b / 1024, sb = b % 1024, swz = sb ^ (((sb >> 9) & 1) << 5); R = (st >> 1) * 16 + swz / 64; C = (st & 1) * 32 + (swz % 64) / 2; }
__host__ __device__ __forceinline__ int perm32(int rho) { const int n = rho >> 4, i = rho & 15; return 8 * (i >> 2) + 4 * n + (i & 3); }
__host__ __device__ __forceinline__ int perm32sw(int rho) { const int n = rho >> 4, i = rho & 15; return 8 * (i >> 2) + 2 * (i & 3) + n; }

struct Unit { int pm, pn, idx; };
struct Gemm { const bf16_t* A; const bf16_t* Bt; int M, N, K; const int* rowtok; };

struct StaticOrder {
    int nM, nN, nwg, G, c;
    __host__ __device__ void init(int M, int N, int G_, int c_) { nM = M / BM; nN = N / BM; nwg = nM * nN; G = G_; c = c_; }
    __host__ __device__ bool next(int i, Unit& u) const {
        const long L = (long)i * G + c; if (L >= nwg) return false;
        int wgid = (int)L; { const int q = nwg / NXCD, r = nwg % NXCD, xcd = wgid % NXCD, off = wgid / NXCD; wgid = (xcd < r ? xcd * (q + 1) : r * (q + 1) + (xcd - r) * q) + off; }
        const int nig = WGM * nN, gid = wgid / nig, fm = gid * WGM, gsz = (nM - fm) < WGM ? (nM - fm) : WGM;
        u.pm = fm + ((wgid % nig) % gsz); u.pn = (wgid % nig) / gsz; u.idx = i; return true;
    }
    __device__ __forceinline__ void a_ready(const Unit&) const {}
    __device__ __forceinline__ void done(const Unit&) const {}
};

__device__ __forceinline__ unsigned cvt_pk_bf16(float lo, float hi) { unsigned r; asm volatile("v_cvt_pk_bf16_f32 %0, %1, %2" : "=v"(r) : "v"(lo), "v"(hi)); return r; }
typedef float f32x2 __attribute__((ext_vector_type(2)));
__device__ __forceinline__ f32x2 gelu_pk(f32x2 v) {
    const f32x2 av = __builtin_elementwise_abs(v), d = av * 0.2316418882f + 1.0f;
    f32x2 t; t.x = __builtin_amdgcn_rcpf(d.x); t.y = __builtin_amdgcn_rcpf(d.y);
    f32x2 q = t * 0.5307027145f + (-0.7265760135f); q = q * t + 0.7107068705f; q = q * t + (-0.142248368f); q = q * t + 0.127414796f; q = q * t;
    const f32x2 s = (v * v) * (-0.72134752044f);
    f32x2 e; e.x = __builtin_amdgcn_exp2f(s.x); e.y = __builtin_amdgcn_exp2f(s.y);
    const f32x2 m = v * (q * e), r = v - m;
    f32x2 o; o.x = v.x < 0.f ? m.x : r.x; o.y = v.y < 0.f ? m.y : r.y; return o;
}

template <int ACT  > struct EpiBf16 {
    static constexpr bool PERM = true, AFTER_DRAIN = false; __device__ __forceinline__ static int perm(int rho) { return perm32(rho); } static_assert(ACT == 0 || ACT == 1, "EpiBf16: ACT is 0 (none) or 1 (gelu_pk)");
    bf16_t* O; int ldc; const float* bias; int split_cols; size_t split_stride; float scale0;
    __device__ __forceinline__ void operator()(const f32x4 (&acc)[2][2][4][2], const Unit& u, int wr, int wc, int fr, int fq) const {
        const int row0 = u.pm * BM + wr * 64 + fr; int colt = u.pn * BM; bf16_t* base = O;
        float sc = 1.f; if (split_cols) { const int t = colt / split_cols; base += (size_t)t * split_stride; colt -= t * split_cols; if (t == 0) sc = scale0; }
        const int col0 = colt + wc * 32 + 8 * fq, bcol0 = u.pn * BM + wc * 32 + 8 * fq;
        f32x4 bv[2][2];
#pragma unroll
        for (int bj = 0; bj < 2; ++bj)
#pragma unroll
            for (int n = 0; n < 2; ++n) bv[bj][n] = bias ? *(const f32x4*)(bias + bcol0 + bj * HALF + 4 * n) : (f32x4){0.f, 0.f, 0.f, 0.f};
#pragma unroll
        for (int ai = 0; ai < 2; ++ai)
#pragma unroll
            for (int m = 0; m < 4; ++m) { bf16_t* rowp = base + (size_t)(row0 + ai * HALF + m * 16) * ldc + col0;
#pragma unroll
                for (int bj = 0; bj < 2; ++bj) { f32x4 v0 = acc[ai][bj][m][0] + bv[bj][0], v1 = acc[ai][bj][m][1] + bv[bj][1];
                    if (ACT == 1) { f32x2 a = gelu_pk((f32x2){v0[0], v0[1]}), b = gelu_pk((f32x2){v0[2], v0[3]}), c = gelu_pk((f32x2){v1[0], v1[1]}), d = gelu_pk((f32x2){v1[2], v1[3]});
                        v0 = (f32x4){a.x, a.y, b.x, b.y}; v1 = (f32x4){c.x, c.y, d.x, d.y}; }
                    v0 = v0 * sc; v1 = v1 * sc; u32x4 w; w.x = cvt_pk_bf16(v0[0], v0[1]); w.y = cvt_pk_bf16(v0[2], v0[3]); w.z = cvt_pk_bf16(v1[0], v1[1]); w.w = cvt_pk_bf16(v1[2], v1[3]);
                    *(u32x4*)(rowp + bj * HALF) = w; } }
    }
};
template <bool HAS_BIAS> struct EpiOut {
    static constexpr bool PERM = true, AFTER_DRAIN = false; __device__ __forceinline__ static int perm(int rho) { return perm32(rho); }
    bf16_t* O; int ldc; const float* bias; int split_cols; size_t split_stride; float scale; PG8_LAS unsigned char* stg;
    __device__ __forceinline__ void operator()(const f32x4 (&acc)[2][2][4][2], const Unit& u, int wr, int wc, int fr, int fq) const {
        static_assert(!HAS_BIAS, "dense GEMMs of this kernel carry no bias");
        const int tid = (wr * 4 + wc) * 64 + fq * 16 + fr;
        const unsigned wo = (unsigned)((wr * 32 + fr) * 256 + (((wc * 4 + fq) ^ fr) * 16));
        const int rr = tid >> 4;
        const unsigned ro = (unsigned)(rr * 256 + (((tid & 15) ^ (rr & 15)) * 16));
        bf16_t* gp = O + (size_t)(u.pm * BM + (rr & 31)) * ldc + u.pn * BM + (tid & 15) * 8;
#pragma unroll
        for (int bj = 0; bj < 2; ++bj)
#pragma unroll
            for (int ai = 0; ai < 2; ++ai)
#pragma unroll
                for (int mp = 0; mp < 2; ++mp) {
#pragma unroll
                    for (int mm = 0; mm < 2; ++mm) { const int m = 2 * mp + mm; const f32x4 v0 = acc[ai][bj][m][0] * scale, v1 = acc[ai][bj][m][1] * scale;
                        u32x4 w; w.x = cvt_pk_bf16(v0[0], v0[1]); w.y = cvt_pk_bf16(v0[2], v0[3]); w.z = cvt_pk_bf16(v1[0], v1[1]); w.w = cvt_pk_bf16(v1[2], v1[3]);
                        *(PG8_LAS u32x4*)(stg + wo + mm * 16 * 256) = w; }
                    __builtin_amdgcn_s_waitcnt(0xc07f); __builtin_amdgcn_s_barrier();
                    const u32x4 x0 = *(const PG8_LAS u32x4*)(stg + ro), x1 = *(const PG8_LAS u32x4*)(stg + ro + 32 * 256);
                    { bf16_t* q0 = gp + (size_t)(ai * HALF + 32 * mp) * ldc + bj * HALF; bf16_t* q1 = q0 + (size_t)64 * ldc;
                      asm volatile("global_store_dwordx4 %0, %1, off sc1\n\ts_nop 1" :: "v"(q0), "v"(x0) : "memory"); asm volatile("global_store_dwordx4 %0, %1, off sc1\n\ts_nop 1" :: "v"(q1), "v"(x1) : "memory"); }
                    if (!(bj == 1 && ai == 1 && mp == 1)) { __builtin_amdgcn_s_waitcnt(0xc07f); __builtin_amdgcn_s_barrier(); }
                }
    }
};
template <bool HAS_BIAS> struct EpiOut8 {
    static constexpr bool PERM = true, AFTER_DRAIN = false; __device__ __forceinline__ static int perm(int rho) { return perm32(rho); }
    unsigned char* O; int ldc; const PG8_LAS float* lbias; int split_cols; float scale; PG8_LAS unsigned char* stg;
    __device__ __forceinline__ void operator()(const f32x4 (&acc)[2][2][4][2], const Unit& u, int wr, int wc, int fr, int fq) const {
        int colt = u.pn * BM; if (split_cols) colt %= split_cols;
        const int tid = (wr * 4 + wc) * 64 + fq * 16 + fr;
        const unsigned wo = (unsigned)((wr * 64 + fr) * 128 + (((wc * 2 + (fq >> 1)) ^ (fr & 7)) * 16) + 8 * (fq & 1));
        const unsigned ro = (unsigned)((tid >> 3) * 128 + (((tid & 7) ^ ((tid >> 3) & 7)) * 16));
        const unsigned go = (unsigned)(u.pm * BM + (tid >> 3)) * (unsigned)ldc + (unsigned)(colt + (tid & 7) * 16);
#pragma unroll
        for (int bj = 0; bj < 2; ++bj) {
            f32x4 b0 = (f32x4){0.f, 0.f, 0.f, 0.f}, b1 = b0;
            if (HAS_BIAS) { const PG8_LAS float* lb_ = lbias + u.idx * BM + wc * 32 + 8 * fq + bj * HALF; b0 = *(const PG8_LAS f32x4*)lb_; b1 = *(const PG8_LAS f32x4*)(lb_ + 4); }
#pragma unroll
            for (int ai = 0; ai < 2; ++ai) {
#pragma unroll
                for (int m = 0; m < 4; ++m) { const f32x4 v0 = acc[ai][bj][m][0] * scale + b0, v1 = acc[ai][bj][m][1] * scale + b1;
                    typedef unsigned u32x2_t __attribute__((ext_vector_type(2))); u32x2_t w; w.x = pk4_fp8(v0[0], v0[1], v0[2], v0[3]); w.y = pk4_fp8(v1[0], v1[1], v1[2], v1[3]);
                    *(PG8_LAS u32x2_t*)(stg + wo + m * 16 * 128) = w; }
                __builtin_amdgcn_s_waitcnt(0xc07f); __builtin_amdgcn_s_barrier();
                const u32x4 x0 = *(const PG8_LAS u32x4*)(stg + ro), x1 = *(const PG8_LAS u32x4*)(stg + ro + 64 * 128);
                { unsigned char* q0 = O + (go + (unsigned)(ai * HALF * ldc + bj * HALF)); unsigned char* q1 = O + (go + (unsigned)((ai * HALF + 64) * ldc + bj * HALF));
                  asm volatile("global_store_dwordx4 %0, %1, off sc1\n\ts_nop 1" :: "v"(q0), "v"(x0) : "memory"); asm volatile("global_store_dwordx4 %0, %1, off sc1\n\ts_nop 1" :: "v"(q1), "v"(x1) : "memory"); }
                if (!(bj == 1 && ai == 1)) { __builtin_amdgcn_s_waitcnt(0xc07f); __builtin_amdgcn_s_barrier(); }
            }
        }
    }
};
struct EpiSwiglu {
    static constexpr bool PERM = true, AFTER_DRAIN = false; __device__ __forceinline__ static int perm(int rho) { return perm32(rho); }
    bf16_t* O; int ldc; const float* bias; int ncols;
    __device__ __forceinline__ static float sw(float g, float l, float lim, float alpha) {
        g = fminf(g, lim); l = fminf(fmaxf(l, -lim), lim); return g * __builtin_amdgcn_rcpf(1.0f + __expf(-alpha * g)) * (l + 1.0f); }
    __device__ __forceinline__ void operator()(const f32x4 (&acc)[2][2][4][2], const Unit& u, int wr, int wc, int fr, int fq) const {
        const int row0 = u.pm * BM + wr * 64 + fr; const int bcol0 = u.pn * BM + wc * 32 + 8 * fq; const int col0 = (u.pn * BM) % ncols + wc * 32 + 8 * fq;
        bf16_t* p0 = O + (size_t)row0 * ldc + (col0 >> 1);
#pragma unroll
        for (int bj = 0; bj < 2; ++bj) {
            const f32x4 b0 = *(const f32x4*)(bias + bcol0 + bj * HALF), b1 = *(const f32x4*)(bias + bcol0 + bj * HALF + 4);
#pragma unroll
            for (int ai = 0; ai < 2; ++ai)
#pragma unroll
                for (int m = 0; m < 4; ++m) { const f32x4 v0 = acc[ai][bj][m][0] + b0, v1 = acc[ai][bj][m][1] + b1;
                    const float a0 = sw(v0[0], v0[1], 7.0f, 1.702f), a1 = sw(v0[2], v0[3], 7.0f, 1.702f), a2 = sw(v1[0], v1[1], 7.0f, 1.702f), a3 = sw(v1[2], v1[3], 7.0f, 1.702f);
                    uint2 w; w.x = cvt_pk_bf16(a0, a1); w.y = cvt_pk_bf16(a2, a3);
                    *(uint2*)(p0 + (size_t)(ai * HALF + m * 16) * ldc + bj * (HALF / 2)) = w; }
        }
    }
};
struct EpiSwiglu8 {
    static constexpr bool PERM = true, AFTER_DRAIN = false; __device__ __forceinline__ static int perm(int rho) { return perm32sw(rho); }
    unsigned char* O; int ldc; const PG8_LAS bf16_t* lbias; int ncols; float scale; PG8_LAS unsigned char* stg;
    __device__ __forceinline__ void operator()(const f32x4 (&acc)[2][2][4][2], const Unit& u, int wr, int wc, int fr, int fq) const {
        const int tid = (wr * 4 + wc) * 64 + fq * 16 + fr;
        const unsigned wo = (unsigned)((wr * 64 + fr) * 64 + ((wc ^ ((fr >> 1) & 3)) * 16) + 4 * fq);
        const unsigned ro = (unsigned)((tid >> 2) * 64 + (((tid & 3) ^ ((tid >> 3) & 3)) * 16));
        const unsigned go = (unsigned)(u.pm * BM + (tid >> 2)) * (unsigned)ldc + (unsigned)(((u.pn * BM) % ncols) / 2 + (tid & 3) * 16);
#pragma unroll
        for (int bj = 0; bj < 2; ++bj) {
            const u32x4 bw = *(const PG8_LAS u32x4*)(lbias + u.idx * BM + wc * 32 + 8 * fq + bj * HALF);
            f32x4 bg, bl;
#pragma unroll
            for (int e = 0; e < 4; ++e) { bg[e] = __builtin_bit_cast(float, bw[e] << 16); bl[e] = __builtin_bit_cast(float, bw[e] & 0xffff0000u); }
#pragma unroll
            for (int ai = 0; ai < 2; ++ai)
#pragma unroll
                for (int m = 0; m < 4; ++m) { f32x4 g = acc[ai][bj][m][0] * scale + bg, l = acc[ai][bj][m][1] * scale + bl, t, r;
#pragma unroll
                    for (int e = 0; e < 4; ++e) { g[e] = fminf(g[e], 7.0f); l[e] = __builtin_amdgcn_fmed3f(l[e], -7.0f, 7.0f); }
                    t = g * (-1.702f * 1.44269504089f);
#pragma unroll
                    for (int e = 0; e < 4; ++e) t[e] = __builtin_amdgcn_exp2f(t[e]);
                    t = t + 1.0f;
#pragma unroll
                    for (int e = 0; e < 4; ++e) r[e] = __builtin_amdgcn_rcpf(t[e]);
                    const f32x4 a = (g * r) * (l + 1.0f);
                    *(PG8_LAS unsigned*)(stg + wo + (ai * HALF + m * 16) * 64) = pk4_fp8(a[0], a[1], a[2], a[3]); }
            __builtin_amdgcn_s_waitcnt(0xc07f); __builtin_amdgcn_s_barrier();
            const u32x4 v0 = *(const PG8_LAS u32x4*)(stg + ro), v1 = *(const PG8_LAS u32x4*)(stg + ro + 128 * 64);
            { unsigned char* q0 = O + (go + (unsigned)(bj * 64)); unsigned char* q1 = O + (go + (unsigned)(128 * ldc + bj * 64));
              asm volatile("global_store_dwordx4 %0, %1, off sc1\n\ts_nop 1" :: "v"(q0), "v"(v0) : "memory"); asm volatile("global_store_dwordx4 %0, %1, off sc1\n\ts_nop 1" :: "v"(q1), "v"(v1) : "memory"); }
            if (bj == 0) { __builtin_amdgcn_s_waitcnt(0xc07f); __builtin_amdgcn_s_barrier(); }
        }
    }
};
struct MoeOrder {
    int nN, total, G, c, evec;
    __device__ __forceinline__ int rb_of(int i, int& tn) const {
        if (G % 8 != 0) { const int L = i * G + c; tn = L % nN; return L / nN; }
        const int x = c % 8, q = c / 8, per = G / 8; const int U = i * per + q; tn = U % nN; return (U / nN) * 8 + x; }
    __device__ __forceinline__ void init(const int* blke, int nblk, int nN_, int G_, int c_) { nN = nN_; total = nblk * nN_; G = G_; c = c_;
        const int lane = (int)__builtin_amdgcn_mbcnt_hi(~0u, __builtin_amdgcn_mbcnt_lo(~0u, 0u)); int tn; const int rb = rb_of(lane, tn); evec = rb * nN < total ? blke[rb] : 0; }
    __device__ __forceinline__ bool next(int i, Unit& u) const {
        int tn; const int rb = rb_of(i, tn); if (rb * nN >= total || i >= 64) return false;
        u.pm = rb; u.pn = __builtin_amdgcn_readlane(evec, i) * nN + tn; u.idx = i; return true;
    }
    __device__ __forceinline__ void a_ready(const Unit&) const {}
    __device__ __forceinline__ void done(const Unit&) const {}
};
template <class Epi, class Sched, bool ALIGN_EPI = false, bool SP2 = false, bool GATHER = false, bool FP8 = false>
__device__ __forceinline__ void gemm_phase(PG8_LAS unsigned char* lds, const Gemm g, const Sched& S, const Epi& E) {
    int tid_ = threadIdx.x; asm volatile("" : "+v"(tid_));
    const int tid = tid_, wid = __builtin_amdgcn_readfirstlane(tid >> 6), lane = tid & 63, wr = wid >> 2, wc = wid & 3, fr = lane & 15, fq = lane >> 4;
    const int K = g.K, nt = K / BK;
    unsigned voffA[2], voffB[2]; int gR[2], gC[2];
#pragma unroll
    for (int i = 0; i < 2; ++i) { int R, C; stage_rc(tid * 16 + i * 8192, R, C); const int Rb = Epi::PERM ? ((R & ~31) + Epi::perm(R & 31)) : R;
        voffA[i] = (unsigned)(R * K + C) * 2u; voffB[i] = (unsigned)(Rb * K + C) * 2u; gR[i] = R & 15; gC[i] = C; }
    static_assert(!GATHER || SP2, "the gathered A operand is wired into the SP2 loop only");
    unsigned gc[2][2], gn[2][2]; typedef int i32x16 __attribute__((ext_vector_type(16)));
#define PG8_LOADOFF(o, PM) do { _Pragma("unroll") for (int _h = 0; _h < 2; ++_h) _Pragma("unroll") for (int _i = 0; _i < 2; ++_i) { \
        const int* _tb = g.rowtok + (size_t)(PM) * BM + _h * HALF + 16 * ((wid + 8 * _i) >> 1); int _tok = 0; i32x16 _t; \
        asm volatile("s_load_dwordx16 %0, %1, 0x0\n\ts_waitcnt lgkmcnt(0)" : "=s"(_t) : "s"(_tb) : "memory");     \
        _Pragma("unroll") for (int _k = 0; _k < 16; ++_k) _tok = (gR[_i] == _k) ? _t[_k] : _tok; \
        o[_h][_i] = (unsigned)(_tok * K + gC[_i]) * 2u; } } while (0)
#define PG8_STAGE_A(bufoff, ptr, H, NXT, kbytes) do { if constexpr (GATHER) { if (NXT) PG8_STAGE_G(bufoff, (const char*)g.A + (kbytes), gn[H]); else PG8_STAGE_G(bufoff, (const char*)g.A + (kbytes), gc[H]); } \
        else PG8_STAGE(bufoff, ptr, voffA); } while (0)
    const size_t kstep = (size_t)(BK * 2);
    const size_t rstep64 = (size_t)64 * K * 2;
    const size_t hstep = (size_t)HALF * K * 2;
    const size_t tstep = 2 * hstep;
    const unsigned ldsw = (unsigned)wid * 1024u;
    const int aoff = lds_byte(wr * 64 + fr, fq * 8), boff = lds_byte(wc * 32 + fr, fq * 8);
    const int aoff0 = aoff, aoff1 = aoff + 1024;
    const int boff0 = boff, boff1 = boff + 1024;
    typedef int i32x4_t __attribute__((ext_vector_type(4))); typedef int i32x8_t __attribute__((ext_vector_type(8)));
    const PG8_LAS unsigned char* ldsA = lds + aoff0; const PG8_LAS unsigned char* ldsB = lds + 4 * HTB + boff0;
#define PG8_SA(b, h) (((b) * 2 + (h)) * HTB)
#define PG8_SB(b, h) ((4 + (b) * 2 + (h)) * HTB)
#define PG8_STAGE(bufoff, gbase, voff) do { _Pragma("unroll") for (int _i = 0; _i < 2; ++_i) \
        __builtin_amdgcn_global_load_lds((const unsigned*)((const char*)(gbase) + (size_t)_i * rstep64 + (voff)[0]), (PG8_LAS unsigned*)(lds + (bufoff) + ldsw + _i * 8192), 16, 0, 0); } while (0)
#define PG8_STAGE_G(bufoff, gbase, voff) do { _Pragma("unroll") for (int _i = 0; _i < 2; ++_i) \
        __builtin_amdgcn_global_load_lds((const unsigned*)((const char*)(gbase) + (voff)[_i]), (PG8_LAS unsigned*)(lds + (bufoff) + ldsw + _i * 8192), 16, 0, 0); } while (0)
#define PG8_LDA(dst, b, h) do { _Pragma("unroll") for (int m = 0; m < 4; ++m) _Pragma("unroll") for (int k = 0; k < 2; ++k) dst[m][k] = *(const PG8_LAS bf16x8*)(ldsA + (PG8_SA(b, h) + (k ? aoff1 - aoff0 : 0) + m * 2048)); } while (0)
#define PG8_LDB(dst, b, h) do { _Pragma("unroll") for (int n = 0; n < 2; ++n) _Pragma("unroll") for (int k = 0; k < 2; ++k) dst[n][k] = *(const PG8_LAS bf16x8*)(ldsB + (PG8_SB(b, h) - 4 * HTB + (k ? boff1 - boff0 : 0) + n * 2048)); } while (0)
#define PG8_CAT8(x) __builtin_shufflevector(__builtin_bit_cast(i32x4_t, (x)[0]), __builtin_bit_cast(i32x4_t, (x)[1]), 0, 1, 2, 3, 4, 5, 6, 7)
#define PG8_MMA(ai, bj, At, Bt) do { __builtin_amdgcn_s_setprio(1); if constexpr (FP8) { _Pragma("unroll") for (int m = 0; m < 4; ++m) _Pragma("unroll") for (int n = 0; n < 2; ++n) \
        acc[ai][bj][m][n] = __builtin_amdgcn_mfma_scale_f32_16x16x128_f8f6f4(PG8_CAT8(Bt[n]), PG8_CAT8(At[m]), acc[ai][bj][m][n], 0, 0, 0, 127, 0, 127); } else { \
        _Pragma("unroll") for (int m = 0; m < 4; ++m) _Pragma("unroll") for (int n = 0; n < 2; ++n) _Pragma("unroll") for (int k = 0; k < 2; ++k) \
        acc[ai][bj][m][n] = __builtin_amdgcn_mfma_f32_16x16x32_bf16(Bt[n][k], At[m][k], acc[ai][bj][m][n], 0, 0, 0); } __builtin_amdgcn_s_setprio(0); } while (0)
#define PG8_WAIT_V(n) asm volatile("s_waitcnt vmcnt(" #n ")" ::: "memory")
#define PG8_WAIT_L(n) asm volatile("s_waitcnt lgkmcnt(" #n ")" ::: "memory")
#define PG8_BAR __builtin_amdgcn_s_barrier()
#define PG8_SCHED __builtin_amdgcn_sched_barrier(0)
    Unit cur, nxt; int ui = 0;
    if (!S.next(0, cur)) return;
    f32x4 acc[2][2][4][2];
#pragma unroll
    for (int a = 0; a < 2; ++a)
#pragma unroll
        for (int b = 0; b < 2; ++b)
#pragma unroll
            for (int m = 0; m < 4; ++m)
#pragma unroll
                for (int n = 0; n < 2; ++n) acc[a][b][m][n] = (f32x4){0.f, 0.f, 0.f, 0.f};
    bf16x8 At[4][2], B0[2][2], B1[2][2];
    const char* cA = (const char*)g.A + (size_t)cur.pm * tstep; const char* cB = (const char*)g.Bt + (size_t)cur.pn * tstep;
    S.a_ready(cur);
    if constexpr (GATHER) PG8_LOADOFF(gc, cur.pm);
    if constexpr (SP2) {
        PG8_STAGE(PG8_SB(0, 0), cB, voffB); PG8_STAGE(PG8_SB(0, 1), cB + hstep, voffB); PG8_STAGE_A(PG8_SA(0, 0), cA, 0, false, (size_t)0); PG8_STAGE_A(PG8_SA(0, 1), cA + hstep, 1, false, (size_t)0);
        if (wr == 1) PG8_BAR;
        PG8_WAIT_V(2); PG8_BAR;
        PG8_STAGE(PG8_SB(1, 0), cB + kstep, voffB); PG8_STAGE_A(PG8_SA(1, 0), cA + kstep, 0, false, kstep); PG8_STAGE(PG8_SB(1, 1), cB + hstep + kstep, voffB);
        PG8_WAIT_V(6); PG8_BAR;
    } else {
        PG8_STAGE(PG8_SB(0, 0), cB, voffB); PG8_STAGE(PG8_SA(0, 0), cA, voffA); PG8_STAGE(PG8_SB(0, 1), cB + hstep, voffB); PG8_STAGE(PG8_SA(0, 1), cA + hstep, voffA);
        if (wr == 1) PG8_BAR;
        PG8_WAIT_V(4); PG8_BAR;
        PG8_STAGE(PG8_SB(1, 0), cB + kstep, voffB); PG8_STAGE(PG8_SA(1, 0), cA + kstep, voffA); PG8_STAGE(PG8_SB(1, 1), cB + hstep + kstep, voffB);
        PG8_WAIT_V(6); PG8_BAR;
    }
    for (;;) {
        const bool has_next = S.next(ui + 1, nxt);
        if constexpr (GATHER) { if (has_next) PG8_LOADOFF(gn, nxt.pm); else { _Pragma("unroll") for (int _h = 0; _h < 2; ++_h) _Pragma("unroll") for (int _i = 0; _i < 2; ++_i) gn[_h][_i] = gc[_h][_i]; } }
        const char* nA = has_next ? (const char*)g.A + (size_t)nxt.pm * tstep : cA; const char* nB = has_next ? (const char*)g.Bt + (size_t)nxt.pn * tstep : cB;
#pragma unroll 1
        for (int t = 0; t < nt; t += 2) {
            const bool last = (t == nt - 2);
            const char* a1 = cA + (size_t)(t + 1) * kstep;
            const char* a2 = last ? nA : cA + (size_t)(t + 2) * kstep; const char* b2 = last ? nB : cB + (size_t)(t + 2) * kstep;
            const char* a3 = a2 + kstep; const char* b3 = b2 + kstep;
            const size_t gk1 = (size_t)(t + 1) * kstep, gk2 = last ? (size_t)0 : (size_t)(t + 2) * kstep;
            if (last && has_next) S.a_ready(nxt);
            if constexpr (SP2) {
            PG8_STAGE_A(PG8_SA(1, 1), a1 + hstep, 1, false, gk1); PG8_SCHED; PG8_LDB(B0, 0, 0); PG8_LDB(B1, 0, 1); PG8_SCHED; PG8_LDA(At, 0, 0);
            PG8_WAIT_V(8); PG8_WAIT_L(0); PG8_BAR; PG8_MMA(0, 0, At, B0); PG8_MMA(0, 1, At, B1); PG8_BAR; PG8_SCHED;
            PG8_STAGE(PG8_SB(0, 0), b2, voffB); PG8_STAGE(PG8_SB(0, 1), b2 + hstep, voffB); PG8_STAGE_A(PG8_SA(0, 0), a2, 0, last, gk2); PG8_SCHED; PG8_LDA(At, 0, 1);
            PG8_WAIT_V(8); PG8_WAIT_L(0); PG8_BAR; PG8_MMA(1, 0, At, B0); PG8_MMA(1, 1, At, B1); PG8_BAR; PG8_SCHED;
            PG8_STAGE_A(PG8_SA(0, 1), a2 + hstep, 1, last, gk2); PG8_SCHED; PG8_LDB(B0, 1, 0); PG8_LDB(B1, 1, 1); PG8_SCHED; PG8_LDA(At, 1, 0);
            PG8_WAIT_V(8); PG8_WAIT_L(0); PG8_BAR; PG8_MMA(0, 0, At, B0); PG8_MMA(0, 1, At, B1); PG8_BAR; PG8_SCHED;
            PG8_STAGE(PG8_SB(1, 0), b3, voffB); PG8_STAGE(PG8_SB(1, 1), b3 + hstep, voffB); PG8_STAGE_A(PG8_SA(1, 0), a3, 0, last, gk2 + kstep); PG8_SCHED; PG8_LDA(At, 1, 1);
            PG8_WAIT_V(8); PG8_WAIT_L(0); PG8_BAR; PG8_MMA(1, 0, At, B0); PG8_MMA(1, 1, At, B1); PG8_BAR; PG8_SCHED;
            } else {
            PG8_LDB(B0, 0, 0); PG8_SCHED; PG8_LDA(At, 0, 0); PG8_STAGE(PG8_SA(1, 1), a1 + hstep, voffA);
            PG8_WAIT_L(8); PG8_BAR; PG8_WAIT_L(0); PG8_MMA(0, 0, At, B0); PG8_BAR; PG8_SCHED;
            PG8_LDB(B1, 0, 1); PG8_STAGE(PG8_SB(0, 0), b2, voffB);
            PG8_BAR; PG8_WAIT_L(0); PG8_MMA(0, 1, At, B1); PG8_BAR;
            PG8_LDA(At, 0, 1); PG8_STAGE(PG8_SA(0, 0), a2, voffA);
            PG8_BAR; PG8_WAIT_L(0); PG8_MMA(1, 0, At, B0); PG8_BAR; PG8_SCHED;
            PG8_STAGE(PG8_SB(0, 1), b2 + hstep, voffB);
            PG8_WAIT_V(6); PG8_BAR; PG8_MMA(1, 1, At, B1); PG8_BAR;
            PG8_LDB(B0, 1, 0); PG8_SCHED; PG8_LDA(At, 1, 0); PG8_STAGE(PG8_SA(0, 1), a2 + hstep, voffA);
            PG8_WAIT_L(8); PG8_BAR; PG8_WAIT_L(0); PG8_MMA(0, 0, At, B0); PG8_BAR; PG8_SCHED;
            PG8_LDB(B1, 1, 1); PG8_STAGE(PG8_SB(1, 0), b3, voffB);
            PG8_BAR; PG8_WAIT_L(0); PG8_MMA(0, 1, At, B1); PG8_BAR;
            PG8_LDA(At, 1, 1); PG8_STAGE(PG8_SA(1, 0), a3, voffA);
            PG8_BAR; PG8_WAIT_L(0); PG8_MMA(1, 0, At, B0); PG8_BAR; PG8_SCHED;
            PG8_STAGE(PG8_SB(1, 1), b3 + hstep, voffB);
            PG8_WAIT_V(6); PG8_BAR; PG8_MMA(1, 1, At, B1); PG8_BAR;
            }
        }
        if constexpr (ALIGN_EPI) { if (wr == 0) PG8_BAR; }
        if constexpr (!Epi::AFTER_DRAIN) { int ln_ = (int)__builtin_amdgcn_mbcnt_hi(~0u, __builtin_amdgcn_mbcnt_lo(~0u, 0u)); asm volatile("" : "+v"(ln_));
            E(acc, cur, wr, wc, ln_ & 15, ln_ >> 4); S.done(cur); }
        if (!has_next) break;
#pragma unroll
        for (int a = 0; a < 2; ++a)
#pragma unroll
            for (int b = 0; b < 2; ++b)
#pragma unroll
                for (int m = 0; m < 4; ++m)
#pragma unroll
                    for (int n = 0; n < 2; ++n) acc[a][b][m][n] = (f32x4){0.f, 0.f, 0.f, 0.f};
        cur = nxt; cA = nA; cB = nB; ++ui;
        if constexpr (GATHER) { _Pragma("unroll") for (int _h = 0; _h < 2; ++_h) _Pragma("unroll") for (int _i = 0; _i < 2; ++_i) gc[_h][_i] = gn[_h][_i]; }
        if constexpr (ALIGN_EPI) { if (wr == 1) PG8_BAR; }
    }
    PG8_WAIT_V(0);
    if constexpr (!ALIGN_EPI) { if (wr == 0) PG8_BAR; }
    PG8_BAR;
    if constexpr (Epi::AFTER_DRAIN) { E.fused(acc, cur, wr, wc, fr, fq, lds, wid, lane); S.done(cur); }
#undef PG8_SA
#undef PG8_SB
#undef PG8_STAGE
#undef PG8_STAGE_G
#undef PG8_STAGE_A
#undef PG8_LOADOFF
#undef PG8_LDA
#undef PG8_LDB
#undef PG8_MMA
#undef PG8_CAT8
#undef PG8_WAIT_V
#undef PG8_WAIT_L
#undef PG8_BAR
#undef PG8_SCHED
}
}
#define GAS __attribute__((address_space(1)))
typedef unsigned v4u __attribute__((ext_vector_type(4)));
#define LDS_WAIT() asm volatile("s_waitcnt lgkmcnt(0)" ::: "memory")
#define VM_WAIT() asm volatile("s_waitcnt vmcnt(0)" ::: "memory")
__device__ __forceinline__ unsigned pk2(float lo, float hi) { return cvt_pk_bf16(lo, hi); }
#define XB_TMO      128
#define XB_XCNT(j)  (256  + 64 * (j))
#define XB_XSUB(j)  (1280 + 64 * (j))
#define XB_XGEN(j)  (2304 + 64 * (j))
#define XB_TOP      3328
#define XB_TOPGEN   3392
#define XCD_BAR_WORDS 3456
#define XB_SPIN_CAP (1u << 18)
__device__ __forceinline__ unsigned xb_ld(unsigned* p)              { return __hip_atomic_load(p, __ATOMIC_RELAXED, __HIP_MEMORY_SCOPE_AGENT); }
__device__ __forceinline__ unsigned xb_add(unsigned* p, unsigned v) { return __hip_atomic_fetch_add(p, v, __ATOMIC_RELAXED, __HIP_MEMORY_SCOPE_AGENT); }
__device__ __forceinline__ unsigned xb_xcc_id() { return (unsigned)__builtin_amdgcn_s_getreg((3 << 11) | 20) & 0xFu; }
#define XB_SPIN(cond, bar) do { unsigned _sp = 0; while (cond) { __builtin_amdgcn_s_sleep(1); \
    if ((++_sp & 255u) == 0u) { if (xb_ld(&(bar)[XB_TMO])) break; if (_sp > XB_SPIN_CAP) { atomicAdd(&(bar)[XB_TMO], 1u); break; } } } } while (0)

struct XcdBarrier {
    unsigned* bar; unsigned x;
    volatile LAS unsigned* st;
};

__device__ __forceinline__ XcdBarrier xcd_barrier_post(unsigned* bar, volatile LAS unsigned* st) {
    XcdBarrier b; b.bar = bar; b.x = xb_xcc_id(); b.st = st;
    if (threadIdx.x == 0) (void)xb_add(&bar[XB_XCNT(b.x)], 1u);
    return b;
}
__device__ __forceinline__ void xcd_barrier_complete(unsigned* bar, unsigned x, unsigned& nloc, unsigned& nx) {
    const unsigned G = gridDim.x * gridDim.y * gridDim.z;
    unsigned sum, cnt, mine, sp = 0u;
    for (;;) {
        sum = 0u; cnt = 0u; mine = 0u;
#pragma unroll
        for (unsigned j = 0; j < 16; ++j) { const unsigned c = xb_ld(&bar[XB_XCNT(j)]); sum += c; cnt += (c > 0u) ? 1u : 0u; mine = (j == x) ? c : mine; }
        if (sum == G) break;
        __builtin_amdgcn_s_sleep(1);
        if ((++sp & 255u) == 0u) { if (xb_ld(&bar[XB_TMO])) break; if (sp > XB_SPIN_CAP) { atomicAdd(&bar[XB_TMO], 1u); break; } }
    }
    nloc = mine > 0u ? mine : 1u; nx = cnt > 0u ? cnt : 1u;
}

__device__ __forceinline__ void xcd_barrier(const XcdBarrier& b) {
    asm volatile("s_waitcnt vmcnt(0)" ::: "memory");
    __syncthreads();
    if (threadIdx.x == 0) {
        unsigned* bar = b.bar;
        __builtin_amdgcn_s_waitcnt(0);
        unsigned nloc = b.st[0], nx = b.st[1];
        if (nloc == 0u) { xcd_barrier_complete(bar, b.x, nloc, nx); b.st[0] = nloc; b.st[1] = nx; }
        const unsigned old = xb_add(&bar[XB_XSUB(b.x)], 1u);
        const unsigned gen = old / nloc;
        if (old + 1u == (gen + 1u) * nloc) {
            __builtin_amdgcn_fence(__ATOMIC_RELEASE, "agent");
            asm volatile("s_waitcnt vmcnt(0)" ::: "memory");
            const unsigned og = xb_add(&bar[XB_TOP], 1u);
            const unsigned tg = og / nx;
            if (og + 1u == (tg + 1u) * nx) xb_add(&bar[XB_TOPGEN], 1u);
            else XB_SPIN(xb_ld(&bar[XB_TOPGEN]) == tg, bar);
            __builtin_amdgcn_fence(__ATOMIC_ACQUIRE, "agent");
            xb_add(&bar[XB_XGEN(b.x)], 1u);
            asm volatile("s_waitcnt vmcnt(0)" ::: "memory");
        } else {
            XB_SPIN(xb_ld(&bar[XB_XGEN(b.x)]) == gen, bar);
            __builtin_amdgcn_fence(__ATOMIC_ACQUIRE, "agent");
            asm volatile("s_waitcnt vmcnt(0)" ::: "memory");
        }
    }
    __syncthreads();
}


constexpr int NWAVES = 8, NT = NWAVES * 64;
constexpr int RING_OFF = 0, RING_BYTES = 147456;
constexpr int LDSCTL_OFF = RING_BYTES, MISC_OFF = LDSCTL_OFF + 320;
constexpr int BIAS_OFF = 148480, LDS_BYTES = 163840;
static_assert(MISC_OFF + 128 <= LDS_BYTES && NWV * WAVE_LDS <= RING_BYTES, "LDS map");

struct Args { const float* in[20]; float* out; unsigned char* ws; int ph_lo, ph_hi; };
struct Env { LAS unsigned char* lds; XcdBarrier bar; int lo, hi; };
typedef const __attribute__((address_space(4))) Args* KArgs;
__device__ __forceinline__ void load_p(P& p) {
    KArgs ka = (KArgs)__builtin_amdgcn_kernarg_segment_ptr(); asm volatile("" : "+s"(ka));
    p.x = ka->in[0]; p.c = ka->in[1]; p.ctx = ka->in[2]; p.c_ctx = ka->in[3]; p.w_mod = ka->in[4]; p.b_mod = ka->in[5]; p.w_in = ka->in[6]; p.pool_w = ka->in[7]; p.pool_scale = ka->in[8]; p.attn_sink = ka->in[9];
    p.ret_decay = ka->in[10]; p.w_out = ka->in[11]; p.ln_g = ka->in[12]; p.ln_b = ka->in[13]; p.router_w = ka->in[14]; p.router_b = ka->in[15]; p.exp_w1 = ka->in[16]; p.exp_b1 = ka->in[17]; p.exp_w2 = ka->in[18]; p.exp_b2 = ka->in[19];
    p.out = ka->out; p.ws = ka->ws; fill_views(p);
}
#define PH_LOAD() P p; load_p(p)
#define SIMPLE(n, CALL) do { const long _n = (long)(n); int _t = threadIdx.x; asm volatile("" : "+v"(_t)); for (long gid = (long)blockIdx.x * NT + _t; gid < _n; gid += (long)gridDim.x * NT) { CALL; } } while (0)
#define SEAM(k) do { if (env.lo <= (k) && (k) + 1 < env.hi) xcd_barrier(env.bar); } while (0)
#define LDSP (env.lds + RING_OFF)
#define BLOCKPHASE(CALL) do { CALL; } while (0)

__device__ __forceinline__ void p0_transpose_item(const float* W, int K, int N, bf16* WT, LAS float* scr, int item, int lane) {
    const int nblk = N / 32, kb = item / nblk, nb = item % nblk, k0 = 64 * kb, n0 = 32 * nb;
    float wv[32];
#pragma unroll
    for (int i = 0; i < 32; ++i) wv[i] = __builtin_nontemporal_load(W + (size_t)(k0 + 2 * i + (lane >> 5)) * N + n0 + (lane & 31));
#pragma unroll
    for (int i = 0; i < 32; ++i) scr[(2 * i + (lane >> 5)) * 33 + (lane & 31)] = wv[i];
    LDS_WAIT(); asm volatile("" ::: "memory");
    const int c = lane & 7;
#pragma unroll
    for (int j = 0; j < 4; ++j) { const int n = (lane >> 3) + 8 * j; const LAS float* s = scr + (8 * c) * 33 + n;
        v4u o; o.x = pk2(s[0 * 33], s[1 * 33]); o.y = pk2(s[2 * 33], s[3 * 33]); o.z = pk2(s[4 * 33], s[5 * 33]); o.w = pk2(s[6 * 33], s[7 * 33]);
        *(GAS v4u*)(WT + (size_t)(n0 + n) * K + k0 + 8 * c) = o; }
    LDS_WAIT(); asm volatile("" ::: "memory");
}
#define TRANSPOSE(Wp, nmat, K_, N_, WTp) do { int _t = threadIdx.x; asm volatile("" : "+v"(_t)); const int _wave = __builtin_amdgcn_readfirstlane(_t >> 6), _lane = _t & 63; LAS float* scr = (LAS float*)(env.lds + RING_OFF + _wave * 18432); const int per = ((K_) / 64) * ((N_) / 32); \
    for (long it = (long)blockIdx.x * NWAVES + _wave; it < (long)(nmat) * per; it += (long)gridDim.x * NWAVES) { const int mi = (int)(it / per), r = (int)(it % per); \
        p0_transpose_item((Wp) + (size_t)mi * (K_) * (N_), (K_), (N_), (WTp) + (size_t)mi * (K_) * (N_), scr, r, _lane); } } while (0)
#define GEMM_PLAIN(Ap, Btp, M_, N_, K_, Op, ldc_, biasp, splitc, splits) do { pg8::Gemm g{(Ap), (Btp), (M_), (N_), (K_)}; pg8::StaticOrder S; S.init((M_), (N_), (int)gridDim.x, (int)blockIdx.x); \
    pg8::EpiOut<false> E{(Op), (ldc_), nullptr, (splitc), (size_t)(splits), 1.0f, env.lds + RING_OFF + 131072}; pg8::gemm_phase<pg8::EpiOut<false>, pg8::StaticOrder, true, true>(env.lds + RING_OFF, g, S, E); } while (0)
#define GEMM_PLAIN8(Ap, Btp, M_, N_, K_, Op, ldc_) do { pg8::Gemm g{(const pg8::bf16_t*)(Ap), (const pg8::bf16_t*)(Btp), (M_), (N_), (K_) / 2}; pg8::StaticOrder S; S.init((M_), (N_), (int)gridDim.x, (int)blockIdx.x); \
    pg8::EpiOut<false> E{(Op), (ldc_), nullptr, 0, (size_t)0, 1.0f / W8_SCALE, env.lds + RING_OFF + 131072}; pg8::gemm_phase<pg8::EpiOut<false>, pg8::StaticOrder, true, true, false, true>(env.lds + RING_OFF, g, S, E); } while (0)
#define GEMM_MOE_SW(Ap, Btp, nN_, K_, Op, ldc_, biasp, ncols_) do { pg8::Gemm g{(const pg8::bf16_t*)(Ap), (const pg8::bf16_t*)(Btp), 0, 0, (K_) / 2}; pg8::MoeOrder S; S.init(p.blke, p.blke[NBLKMAX], (nN_), (int)gridDim.x, (int)blockIdx.x); \
    static_assert((NBLKMAX / 8 + 1) * 8 / 32 + 2 <= (LDS_BYTES - BIAS_OFF) / 512, "bf16 bias rows of a workgroup's GEMM1 units fit the LDS bias area"); \
    { int t_ = threadIdx.x; asm volatile("" : "+v"(t_)); LAS pg8::bf16_t* lb_ = (LAS pg8::bf16_t*)(env.lds + BIAS_OFF); pg8::Unit u_; \
      for (int i_ = __builtin_amdgcn_readfirstlane(t_ >> 8); S.next(i_, u_); i_ += 2) lb_[i_ * 256 + (t_ & 255)] = (pg8::bf16_t)f2bf((biasp)[(size_t)u_.pn * 256 + (t_ & 255)]); __syncthreads(); } \
    pg8::EpiSwiglu8 E{(Op), (ldc_), (const LAS pg8::bf16_t*)(env.lds + BIAS_OFF), (ncols_), 1.0f / W8_SCALE, env.lds + RING_OFF + 131072}; static_assert(131072 + 256 * 64 <= RING_BYTES, "SwiGLU staging fits above the stage ring"); pg8::gemm_phase<pg8::EpiSwiglu8, pg8::MoeOrder, true, true, false, true>(env.lds + RING_OFF, g, S, E); } while (0)
#define GEMM_MOE(Ap, Btp, nN_, K_, Op, ldc_, biasp, splitc) do { pg8::Gemm g{(const pg8::bf16_t*)(Ap), (const pg8::bf16_t*)(Btp), 0, 0, (K_) / 2}; pg8::MoeOrder S; S.init(p.blke, p.blke[NBLKMAX], (nN_), (int)gridDim.x, (int)blockIdx.x); \
    static_assert((NBLKMAX / 8 + 1) * 4 / 32 + 2 <= (LDS_BYTES - BIAS_OFF) / 1024, "f32 bias rows of a workgroup's GEMM2 units fit the LDS bias area"); \
    { int t_ = threadIdx.x; asm volatile("" : "+v"(t_)); LAS float* lb_ = (LAS float*)(env.lds + BIAS_OFF); pg8::Unit u_; \
      for (int i_ = __builtin_amdgcn_readfirstlane(t_ >> 8); S.next(i_, u_); i_ += 2) lb_[i_ * 256 + (t_ & 255)] = (biasp)[(size_t)u_.pn * 256 + (t_ & 255)]; __syncthreads(); } \
    pg8::EpiOut8<true> E{(Op), (ldc_), (const LAS float*)(env.lds + BIAS_OFF), (splitc), 1.0f / W8_SCALE, env.lds + RING_OFF + 131072}; pg8::gemm_phase<pg8::EpiOut8<true>, pg8::MoeOrder, true, true, false, true>(env.lds + RING_OFF, g, S, E); } while (0)
__device__ __forceinline__ void t8_load(float (&wv)[64], const float* W, int N, int item, int lane) {
    const int nblk = N / 32, kb = item / nblk, nb = item % nblk, k0 = 128 * kb, n0 = 32 * nb;
    typedef float f4_t __attribute__((ext_vector_type(4)));
#pragma unroll
    for (int i = 0; i < 16; ++i) { const f4_t v = __builtin_nontemporal_load((const f4_t*)(W + (size_t)(k0 + 8 * i + (lane >> 3)) * N + n0 + 4 * (lane & 7)));
        wv[4 * i] = v[0]; wv[4 * i + 1] = v[1]; wv[4 * i + 2] = v[2]; wv[4 * i + 3] = v[3]; }
}
__device__ __forceinline__ void t8_pack(const float (&wv)[64], int K, int N, unsigned char* WT, LAS float* scr, int item, int lane) {
    const int nblk = N / 32, kb = item / nblk, nb = item % nblk, k0 = 128 * kb, n0 = 32 * nb;
#pragma unroll
    for (int i = 0; i < 16; ++i)
#pragma unroll
        for (int q = 0; q < 4; ++q) scr[(8 * i + (lane >> 3)) * 33 + 4 * (lane & 7) + q] = wv[4 * i + q] * W8_SCALE;
    LDS_WAIT(); asm volatile("" ::: "memory");
    const int n = lane & 31, hf = lane >> 5; const LAS float* sp = scr + (64 * hf) * 33 + n;
    GAS v4u* dst = (GAS v4u*)(WT + (size_t)(n0 + n) * K + k0 + 64 * hf);
#pragma unroll
    for (int c = 0; c < 4; ++c) { v4u o;
#pragma unroll
        for (int q = 0; q < 4; ++q) o[q] = pk4_fp8(sp[(16 * c + 4 * q) * 33], sp[(16 * c + 4 * q + 1) * 33], sp[(16 * c + 4 * q + 2) * 33], sp[(16 * c + 4 * q + 3) * 33]);
        dst[c] = o; }
    LDS_WAIT(); asm volatile("" ::: "memory");
}
__device__ __forceinline__ void transpose8_stream(const float* Wp, int nmat, int K, int N, unsigned char* WTp, LAS unsigned char* lds) {
    int _t = threadIdx.x; asm volatile("" : "+v"(_t)); const int wave = __builtin_amdgcn_readfirstlane(_t >> 6), lane = _t & 63; LAS float* scr = (LAS float*)(lds + wave * 18432);
    static_assert(128 * 33 * 4 <= 18432 && NWAVES * 18432 <= RING_BYTES, "transpose tile fits the per-wave slice");
    const int per = (K / 128) * (N / 32); const long total = (long)nmat * per, stride = (long)gridDim.x * NWAVES;
    long it = (long)blockIdx.x * NWAVES + wave; if (it >= total) return;
    float wa[64], wb[64];
    t8_load(wa, Wp + (size_t)(it / per) * K * N, N, (int)(it % per), lane);
    for (;;) {
        const long n1 = it + stride; const bool h1 = n1 < total;
        if (h1) t8_load(wb, Wp + (size_t)(n1 / per) * K * N, N, (int)(n1 % per), lane);
        t8_pack(wa, K, N, WTp + (size_t)(it / per) * K * N, scr, (int)(it % per), lane);
        if (!h1) break;
        const long n2 = n1 + stride; const bool h2 = n2 < total;
        if (h2) t8_load(wa, Wp + (size_t)(n2 / per) * K * N, N, (int)(n2 % per), lane);
        t8_pack(wb, K, N, WTp + (size_t)(n1 / per) * K * N, scr, (int)(n1 % per), lane);
        if (!h2) break;
        it = n2;
    }
}
#define TRANSPOSE8(Wp, nmat, K_, N_, WTp) transpose8_stream((Wp), (nmat), (K_), (N_), (WTp), env.lds + RING_OFF)
#define DUMP(name, ptr, rows, cols, isbf)
#else
struct Env { int lo, hi; std::string dir; };
static P g_P;
#define PH_LOAD() const P& p = g_P
#define SIMPLE(n, CALL) do { const long _n = (long)(n); for (long gid = 0; gid < _n; ++gid) { CALL; } } while (0)
#define SEAM(k)
#define LDSP (emu::g_lds)
#ifndef EMU_GRID
#define EMU_GRID 3
#endif
#define BLOCKPHASE(CALL) do { for (int _b = 0; _b < EMU_GRID; ++_b) emu::run_block(_b, EMU_GRID, 512, [&]() { CALL; }); } while (0)
#define TRANSPOSE(Wp, nmat, K_, N_, WTp) do { for (int mi = 0; mi < (nmat); ++mi) for (int k = 0; k < (K_); ++k) for (int n = 0; n < (N_); ++n) \
    (WTp)[(size_t)mi * (K_) * (N_) + (size_t)n * (K_) + k] = (bf16)f2bf((Wp)[(size_t)mi * (K_) * (N_) + (size_t)k * (N_) + n]); } while (0)
static void cpu_gemm_rows(const bf16* A, const bf16* Bt, int r0, int r1, int N, int K, int bcol_off, bf16* O, int ldc, const float* bias, int splitc, size_t splits, int swiglu) {
    std::vector<float> Bf((size_t)N * K);
    for (int n = 0; n < N; ++n) for (int k = 0; k < K; ++k) Bf[(size_t)n * K + k] = bf2f(Bt[(size_t)(bcol_off + n) * K + k]);
#pragma omp parallel for schedule(static)
    for (int r = r0; r < r1; ++r) {
        std::vector<float> u(N), a(K);
        for (int k = 0; k < K; ++k) a[k] = bf2f(A[(size_t)r * K + k]);
        for (int n = 0; n < N; ++n) { float acc = 0.f; const float* b = &Bf[(size_t)n * K]; for (int k = 0; k < K; ++k) acc += a[k] * b[k];
            u[n] = acc + (bias ? bias[bcol_off + n] : 0.f); }
        if (swiglu) { for (int n = 0; n < N / 2; ++n) { float g = fminf(u[2 * n], SW_LIMIT), l = fminf(fmaxf(u[2 * n + 1], -SW_LIMIT), SW_LIMIT); O[(size_t)r * ldc + n] = (bf16)f2bf(g * (1.0f / (1.0f + expf(-SW_ALPHA * g))) * (l + 1.0f)); } }
        else for (int n = 0; n < N; ++n) { int col = n; bf16* base = O; if (splitc) { const int t = col / splitc; base += (size_t)t * splits; col -= t * splitc; } base[(size_t)r * ldc + col] = (bf16)f2bf(u[n]); }
    }
}
#define GEMM_PLAIN(Ap, Btp, M_, N_, K_, Op, ldc_, biasp, splitc, splits) cpu_gemm_rows((Ap), (Btp), 0, (M_), (N_), (K_), 0, (Op), (ldc_), (biasp), (splitc), (size_t)(splits), 0)
static void cpu_gemm_rows8(const unsigned char* A, const unsigned char* Bt, int r0, int r1, int N, int K, int bcol_off, void* Ov, int ldc, const float* bias, int swiglu) {
    std::vector<float> Bf((size_t)N * K);
    for (int n = 0; n < N; ++n) for (int k = 0; k < K; ++k) Bf[(size_t)n * K + k] = fp8_to_f32(Bt[(size_t)(bcol_off + n) * K + k]);
#pragma omp parallel for schedule(static)
    for (int r = r0; r < r1; ++r) {
        std::vector<float> u(N), a(K);
        for (int k = 0; k < K; ++k) a[k] = fp8_to_f32(A[(size_t)r * K + k]);
        for (int n = 0; n < N; ++n) { float acc = 0.f; const float* b = &Bf[(size_t)n * K]; for (int k = 0; k < K; ++k) acc += a[k] * b[k]; u[n] = acc * (1.0f / W8_SCALE) + bias[bcol_off + n]; }
        if (swiglu) { unsigned char* O = (unsigned char*)Ov; for (int n = 0; n < N / 2; ++n) { float g = fminf(u[2 * n], SW_LIMIT), l = fminf(fmaxf(u[2 * n + 1], -SW_LIMIT), SW_LIMIT); O[(size_t)r * ldc + n] = (unsigned char)f32_to_fp8_sw(g * (1.0f / (1.0f + expf(-SW_ALPHA * g))) * (l + 1.0f)); } }
        else { unsigned char* O = (unsigned char*)Ov; for (int n = 0; n < N; ++n) O[(size_t)r * ldc + n] = (unsigned char)f32_to_fp8_sw(u[n]); }
    }
}
static void cpu_gemm_plain8(const unsigned char* A, const unsigned char* Bt, int M, int N, int K, bf16* O, int ldc) {
    std::vector<float> Bf((size_t)N * K); for (size_t i = 0; i < (size_t)N * K; ++i) Bf[i] = fp8_to_f32(Bt[i]);
#pragma omp parallel for schedule(static)
    for (int r = 0; r < M; ++r) { std::vector<float> a(K); for (int k = 0; k < K; ++k) a[k] = fp8_to_f32(A[(size_t)r * K + k]);
        for (int n = 0; n < N; ++n) { float acc = 0.f; const float* b = &Bf[(size_t)n * K]; for (int k = 0; k < K; ++k) acc += a[k] * b[k]; O[(size_t)r * ldc + n] = (bf16)f2bf(acc * (1.0f / W8_SCALE)); } }
}
#define GEMM_PLAIN8(Ap, Btp, M_, N_, K_, Op, ldc_) cpu_gemm_plain8((Ap), (Btp), (M_), (N_), (K_), (Op), (ldc_))
#define GEMM_MOE_SW(Ap, Btp, nN_, K_, Op, ldc_, biasp, ncols_) do { const int nblk = p.blke[NBLKMAX]; for (int rb = 0; rb < nblk; ++rb) { const int e = p.blke[rb]; \
    cpu_gemm_rows8((Ap), (Btp), rb * MOEB, (rb + 1) * MOEB, (ncols_), (K_), e * (ncols_), (Op), (ldc_), (biasp), 1); } } while (0)
#define GEMM_MOE(Ap, Btp, nN_, K_, Op, ldc_, biasp, splitc) do { const int nblk = p.blke[NBLKMAX]; for (int rb = 0; rb < nblk; ++rb) { const int e = p.blke[rb]; \
    cpu_gemm_rows8((Ap), (Btp), rb * MOEB, (rb + 1) * MOEB, (splitc), (K_), e * (splitc), (Op), (ldc_), (biasp), 0); } } while (0)
#define TRANSPOSE8(Wp, nmat, K_, N_, WTp) do { for (int mi = 0; mi < (nmat); ++mi) for (int k = 0; k < (K_); ++k) for (int n = 0; n < (N_); ++n) \
    (WTp)[(size_t)mi * (K_) * (N_) + (size_t)n * (K_) + k] = (unsigned char)f32_to_fp8_sw((Wp)[(size_t)mi * (K_) * (N_) + (size_t)k * (N_) + n] * W8_SCALE); } while (0)
static void dump_buf(const std::string& dir, const char* name, int l, const void* ptr, long rows, long cols, int isbf) {
    std::vector<float> v((size_t)rows * cols);
    for (long i = 0; i < rows * cols; ++i) v[i] = isbf == 1 ? bf2f(((const bf16*)ptr)[i]) : isbf == 2 ? (float)((const int*)ptr)[i] : ((const float*)ptr)[i];
    char fn[512]; snprintf(fn, sizeof fn, "%s/c_L%d_%s.bin", dir.c_str(), l, name); FILE* f = fopen(fn, "wb"); fwrite(v.data(), 4, v.size(), f); fclose(f);
}
#define DUMP(name, ptr, rows, cols, isbf) dump_buf(env.dir, name, l, ptr, rows, cols, isbf)
#endif
constexpr int NPL = 14, NPHASE = 1 + NPL * DEPTH;
#define IN(k) (env.lo <= (k) && (k) < env.hi)
#ifndef PROBE_MASK
#define PROBE_MASK 0
#endif
#define REP(bit) for (int _rep = 0; _rep < (((PROBE_MASK) >> (bit)) & 1 ? 2 : 1); ++_rep)
#define QB() const_cast<P&>(p).qbank = _rep
template <int L> HD void layer_phases(Env& env) {
        constexpr int l = L;
        const int pb = 1 + NPL * l;
        const bool last = (l == DEPTH - 1);
        const int tlo = last ? TC : 0;
        if (IN(pb + 0)) { PH_LOAD(); if (l == 0) { REP(10) BLOCKPHASE(ph_rows_ln0(p, LDSP));
            REP(9) {
            TRANSPOSE8(p.w_in, DEPTH, D, INW, (unsigned char*)p.WinT);
            TRANSPOSE(p.w_out, DEPTH, D, D, p.WoutT);
            TRANSPOSE8(p.exp_w1, DEPTH * NE, D, 2 * DE, p.W1T8);
            TRANSPOSE8(p.exp_w2, DEPTH * NE, DE, D, p.W2T8);
            }
            SEAM(pb + 0); }  }
        if (IN(pb + 1)) { PH_LOAD(); REP(0) GEMM_PLAIN8(p.hb8, (const unsigned char*)p.WinT + (size_t)l * INW * D, T, INW, D, p.pj, INW); DUMP("pj", p.pj, T, INW, 1); SEAM(pb + 1); }
        if (IN(pb + 2)) { PH_LOAD(); REP(1) { QB();
            if (!last) SIMPLE((long)TC * QW, ph_fch(p, gid));
            BLOCKPHASE(ph_krope(p, LDSP));
            BLOCKPHASE(ph_vtrans(p, LDSP));
            BLOCKPHASE(ph_fftA(p, l, LDSP));
            BLOCKPHASE(ph_retA(p, l, LDSP)); }
            SEAM(pb + 2);
        }
        if (IN(pb + 3)) { PH_LOAD();
            SIMPLE((long)2 * NB * RH * RDK * RDK / 2, ph_retscan(p, l, gid));
            REP(2) { QB(); BLOCKPHASE(ph_attn_wave(p, l, LDSP, !last)); }
            REP(3) { QB();
            BLOCKPHASE(ph_pool_wave(p, l, LDSP, !last));
            if (!last) SIMPLE((long)TC * QW, ph_fctx(p, gid));
            BLOCKPHASE(ph_fftB(p, l, LDSP)); }
            SEAM(pb + 3);
        }
        if (IN(pb + 4)) { PH_LOAD(); REP(4) { QB(); BLOCKPHASE(ph_retC(p, l, LDSP, !last)); } DUMP("mix", p.mix, T, D, 1); SEAM(pb + 4); }
        if (IN(pb + 5)) { PH_LOAD(); REP(5) { if (last) GEMM_PLAIN(p.mix + (size_t)TC * D, p.WoutT + (size_t)l * D * D, TL, D, D, p.y + (size_t)TC * D, D, (const float*)nullptr, 0, 0);
                                        else GEMM_PLAIN(p.mix, p.WoutT + (size_t)l * D * D, T, D, D, p.y, D, (const float*)nullptr, 0, 0); } DUMP("y", p.y, T, D, 1); SEAM(pb + 5); }
        if (IN(pb + 6)) { PH_LOAD(); BLOCKPHASE(ph_rows_res1(p, l, tlo, LDSP)); DUMP("x1", p.xs, T, D, 1); DUMP("logits", p.logits, T, NE, 0); DUMP("topi", p.topi, T, TOPK, 2); SEAM(pb + 6); }
        if (IN(pb + 9)) { PH_LOAD(); REP(6) BLOCKPHASE(ph_dispatch(p, l, tlo, LDSP)); SEAM(pb + 9); }
        if (IN(pb + 11)) { PH_LOAD(); REP(7) GEMM_MOE_SW(p.as8, p.W1T8 + (size_t)l * NE * 2 * DE * D, 2 * DE / 256, D, p.act8, DE, p.exp_b1 + (size_t)l * NE * 2 * DE, 2 * DE); SEAM(pb + 11); }
        if (IN(pb + 12)) { PH_LOAD(); REP(8) GEMM_MOE(p.act8, p.W2T8 + (size_t)l * NE * D * DE, D / 256, DE, p.ym8, D, p.exp_b2 + (size_t)l * NE * D, D); SEAM(pb + 12); }
        if (IN(pb + 13)) { PH_LOAD(); if (last) { REP(12) BLOCKPHASE(ph_rows_res2(p, l, tlo, LDSP)); } else BLOCKPHASE(ph_rows_res2(p, l, tlo, LDSP)); SEAM(pb + 13); }
}
HD void program(Env& env) {
    if (IN(0)) { PH_LOAD();
        REP(11) BLOCKPHASE(ph_mod_block(p, LDSP));
        SIMPLE((long)2 * 64 * 64 + 2 * FN1 * FN1, ph_ftab(p, gid));
        SIMPLE((long)DEPTH * 4 * PGW * PGW, ph_pwt(p, gid));
        SIMPLE((long)128 * 16, ph_rtab(p, gid));
        SIMPLE((long)LCTX, ph_ctab(p, gid));
        SEAM(0);
    }
    layer_phases<0>(env);
    layer_phases<1>(env);
    static_assert(DEPTH == 2, "two layers");
}
#ifndef CPU_TEST
#ifndef MK_ONE_LAUNCH
#define MK_ONE_LAUNCH 1
#endif
__global__ void __launch_bounds__(NT, 2) hpg_fwd(Args a) {
    extern __shared__ __attribute__((aligned(16))) unsigned char lds[];
    Env env; env.lds = (LAS unsigned char*)lds; env.lo = a.ph_lo; env.hi = a.ph_hi;
    for (int u = threadIdx.x; u < (LDS_BYTES - LDSCTL_OFF) / 4; u += NT) ((LAS unsigned*)(env.lds + LDSCTL_OFF))[u] = 0u;
    __syncthreads();
    volatile LAS unsigned* MISC = (volatile LAS unsigned*)(env.lds + MISC_OFF);
    env.bar = xcd_barrier_post((unsigned*)(a.ws + WS_CTL) + CW_BAR, MISC + 8);
    program(env);
}

extern "C" void kernel_launch(void* const* d_in, const int* in_sizes, int n_in, void* d_out, int out_size, void* d_ws, size_t ws_size, hipStream_t stream) {
    static int grid = 0;
    if (grid == 0) {
        if (n_in != 20 || in_sizes[0] != TL * D || out_size != TL * D || ws_size < WS_TOTAL) {
            fprintf(stderr, "kernel_launch: built for 20 inputs, x/out of %d floats, >= %zu bytes of workspace; got n_in %d, in0 %d, out %d, ws %zu; nothing launched\n", TL * D, (size_t)WS_TOTAL, n_in, n_in > 0 ? in_sizes[0] : -1, out_size, ws_size);
            grid = -1; return; }
        int dev = 0, cus = 0, per_cu = 0;
        if (hipGetDevice(&dev) != hipSuccess || hipDeviceGetAttribute(&cus, hipDeviceAttributeMultiprocessorCount, dev) != hipSuccess) { fprintf(stderr, "kernel_launch: device query failed\n"); grid = -1; return; }
        if (hipFuncSetAttribute((const void*)hpg_fwd, hipFuncAttributeMaxDynamicSharedMemorySize, LDS_BYTES) != hipSuccess) { fprintf(stderr, "kernel_launch: hipFuncSetAttribute failed\n"); grid = -1; return; }
        if (hipOccupancyMaxActiveBlocksPerMultiprocessor(&per_cu, (const void*)hpg_fwd, NT, LDS_BYTES) != hipSuccess || per_cu < 1)
            fprintf(stderr, "kernel_launch: note: occupancy query reports %d workgroups per CU\n", per_cu);
        (void)hipGetLastError();
        grid = cus;
    }
    if (grid < 0) return;
    if (hipMemsetAsync((char*)d_ws + WS_CTL, 0, CTL_ZERO_BYTES, stream) != hipSuccess) { fprintf(stderr, "kernel_launch: memset failed\n"); return; }
    Args a{};
    for (int i = 0; i < 20; ++i) a.in[i] = (const float*)d_in[i];
    a.out = (float*)d_out; a.ws = (unsigned char*)d_ws;
#if MK_ONE_LAUNCH
    a.ph_lo = 0; a.ph_hi = NPHASE;
    hipLaunchKernelGGL(hpg_fwd, dim3(grid), dim3(NT), LDS_BYTES, stream, a);
#else
    for (int k = 0; k < NPHASE; ++k) { a.ph_lo = k; a.ph_hi = k + 1; hipLaunchKernelGGL(hpg_fwd, dim3(grid), dim3(NT), LDS_BYTES, stream, a); }
#endif
    const hipError_t le = hipPeekAtLastError();
    if (le != hipSuccess) fprintf(stderr, "kernel_launch: launch failed: %s\n", hipGetErrorName(le));
}
#else
int main(int argc, char** argv) {
    std::string dir = argc > 1 ? argv[1] : "t";
    const size_t sizes[20] = {(size_t)TL * D, (size_t)NB * D, (size_t)TC * D, (size_t)D, (size_t)DEPTH * D * 6 * D, (size_t)DEPTH * 6 * D, (size_t)DEPTH * D * INW, (size_t)DEPTH * 4 * PGW * PGW, (size_t)DEPTH * QW,
        (size_t)DEPTH * NH, (size_t)DEPTH * 2 * RH, (size_t)DEPTH * D * D, (size_t)DEPTH * 2 * D, (size_t)DEPTH * 2 * D, (size_t)DEPTH * D * NE, (size_t)DEPTH * NE, (size_t)DEPTH * NE * D * 2 * DE, (size_t)DEPTH * NE * 2 * DE,
        (size_t)DEPTH * NE * DE * D, (size_t)DEPTH * NE * D};
    std::vector<std::vector<float>> in(20);
    FILE* f = fopen((dir + "/inputs.bin").c_str(), "rb"); if (!f) { printf("no inputs\n"); return 1; }
    for (int i = 0; i < 20; ++i) { in[i].resize(sizes[i]); if (fread(in[i].data(), 4, sizes[i], f) != sizes[i]) { printf("short read %d\n", i); return 1; } }
    fclose(f);
    std::vector<unsigned char> ws(WS_TOTAL, 0xCD); memset(ws.data(), 0, CTL_ZERO_BYTES);
    std::vector<float> out((size_t)TL * D, 0.f);
    P& p = g_P; const float** pp = (const float**)&p.x; for (int i = 0; i < 20; ++i) pp[i] = in[i].data();
    p.out = out.data(); p.ws = ws.data(); fill_views(p);
    Env env; env.lo = 0; env.hi = NPHASE; env.dir = dir;
    program(env);
    f = fopen((dir + "/c_out.bin").c_str(), "wb"); fwrite(out.data(), 4, out.size(), f); fclose(f);
    printf("cpu test done, T=%d PMAX=%d nblk(last)=%d\n", T, PMAX, p.blke[NBLKMAX]);
    return 0;
}
#endif
```

```cpp
#ifndef CPU_TEST
#include <hip/hip_runtime.h>
#include <cstdio>
#include <cstdint>
#define HD __device__ __forceinline__
#define OPAQUE_V(x) asm volatile("" : "+v"(x))
#else
#define OPAQUE_V(x)
#include <cstdio>
#include <cstdint>
#include <cstdlib>
#include <cstring>
#include <cmath>
#include <vector>
#include <string>
#include "emu.h"
#define HD static inline
static inline int atomicAdd(int* p, int v) { int o = *p; *p = o + v; return o; }
static inline float cospif(float x) { return (float)cos(M_PI * (double)x); }
static inline float sinpif(float x) { return (float)sin(M_PI * (double)x); }
struct uint4 { unsigned x, y, z, w; };
#endif

#ifndef CFG_D
#define CFG_D 1024
#define CFG_NB 4
#define CFG_SEQ 8192
#define CFG_LCTX 256
#define CFG_GW 64
#define CFG_HDIM 64
#define CFG_WIN 128
#define CFG_NE 32
#endif
constexpr int D = CFG_D, NB = CFG_NB, SEQ = CFG_SEQ, LCTX = CFG_LCTX, GW = CFG_GW, HDIM = CFG_HDIM, WIN = CFG_WIN, NE = CFG_NE;
constexpr int DEPTH = 2, TOPK = 4, DE = D;
constexpr int QW = D / 4;
constexpr int NH = QW / HDIM, NKV = 2, GQ = NH / NKV;
constexpr int RH = 4, RDK = QW / RH;
constexpr int FG = 4, FC = QW / FG;
constexpr int PGW = QW / 4;
constexpr int INW = 2 * D;
constexpr int A_OFF = 0, B_OFF = QW, Q_OFF = 2 * QW, K_OFF = 3 * QW, V_OFF = 3 * QW + QW / 2, RQ_OFF = 4 * QW, RK_OFF = 5 * QW, RV_OFF = 6 * QW, RG_OFF = 7 * QW;
constexpr int TC = NB * LCTX, TL = NB * SEQ, T = TC + TL;
constexpr int MOEB = 256;
constexpr int PMAX = T * TOPK + NE * MOEB, NBLKMAX = PMAX / MOEB;
constexpr float LN_EPS = 1e-6f, SW_LIMIT = 7.0f, SW_ALPHA = 1.702f;
constexpr float DN_ALPHA = 1.41421356237309515f;
constexpr float ROPE_BASE = 10000.0f;
static_assert(NH * HDIM == QW && RH * RDK == QW && FG * FC == QW && GQ * NKV == NH, "shape algebra");

typedef unsigned short bf16;
#ifndef CPU_TEST
typedef float cvt_f32x2_t __attribute__((ext_vector_type(2))); typedef __bf16 cvt_bf16x2_t __attribute__((ext_vector_type(2)));
HD unsigned cvt_pk_bf16(float lo, float hi) { const cvt_f32x2_t v = {lo, hi}; return __builtin_bit_cast(unsigned, __builtin_convertvector(v, cvt_bf16x2_t)); }
HD unsigned f2bf(float f) { return cvt_pk_bf16(f, f) & 0xffffu; }
#else
HD unsigned f2bf(float f) { unsigned u; __builtin_memcpy(&u, &f, 4); return (u + 0x7fffu + ((u >> 16) & 1u)) >> 16; }
HD unsigned cvt_pk_bf16(float lo, float hi) { return f2bf(lo) | (f2bf(hi) << 16); }
#endif
HD float bf2f(bf16 h) { unsigned u = (unsigned)h << 16; float f; __builtin_memcpy(&f, &u, 4); return f; }
#ifndef CPU_TEST
HD float rcp_f(float x) { return __builtin_amdgcn_rcpf(x); }
#define ST_WT16(ptr, v) asm volatile("global_store_dwordx4 %0, %1, off sc1\n\ts_nop 1" :: "v"(ptr), "v"(v) : "memory")
HD float exp2_f(float x) { return __builtin_amdgcn_exp2f(x); }
HD void sincos_rev(float rev, float& c, float& s) { c = __builtin_amdgcn_cosf(rev); s = __builtin_amdgcn_sinf(rev); }
HD float rsq_f(float x) { return __builtin_amdgcn_rsqf(x); }
HD float silu_f(float x) { return x * __builtin_amdgcn_rcpf(1.0f + __expf(-x)); }
#else
HD float rcp_f(float x) { return 1.0f / x; }
#define ST_WT16(ptr, v) (*(u32x4*)(ptr) = (v))
HD float exp2_f(float x) { return exp2f(x); }
HD void sincos_rev(float rev, float& c, float& s) { c = cospif(2.0f * rev); s = sinpif(2.0f * rev); }
HD float rsq_f(float x) { return 1.0f / sqrtf(x); }
HD float silu_f(float x) { return x / (1.0f + expf(-x)); }
#endif
constexpr float W8_SCALE = 32.0f;
HD float fp8_to_f32(unsigned c) { const unsigned sg = (c >> 7) & 1u, e = (c >> 3) & 15u, m = c & 7u; float v = e == 0 ? (float)m * 0.001953125f : ldexpf(1.0f + (float)m * 0.125f, (int)e - 7); return sg ? -v : v; }
HD unsigned f32_to_fp8_sw(float f) {
    const unsigned sg = f < 0.f ? 0x80u : 0u; float a = fabsf(f); if (!(a == a)) return 0x7Fu; if (a > 448.0f) a = 448.0f;
    if (a < 0.015625f) { const int q = (int)nearbyintf(a * 512.0f); return sg | (unsigned)q; }
    int ex; const float fr = frexpf(a, &ex); int e = ex - 1; int q = (int)nearbyintf((fr * 2.0f - 1.0f) * 8.0f); if (q == 8) { q = 0; ++e; }
    if (e > 8 || (e == 8 && q == 7)) { e = 8; q = 6; }
    return sg | (unsigned)((e + 7) << 3) | (unsigned)q;
}
#ifndef CPU_TEST
typedef float f32x4_h __attribute__((ext_vector_type(4))); typedef float f32x2_h __attribute__((ext_vector_type(2)));
HD f32x4_h unpk4_fp8(unsigned w) { const f32x2_h lo = __builtin_amdgcn_cvt_pk_f32_fp8((int)w, false), hi = __builtin_amdgcn_cvt_pk_f32_fp8((int)w, true); return (f32x4_h){lo[0], lo[1], hi[0], hi[1]}; }
HD unsigned pk4_fp8(float a, float b, float c, float d) { int w = 0; w = __builtin_amdgcn_cvt_pk_fp8_f32(a, b, w, false); w = __builtin_amdgcn_cvt_pk_fp8_f32(c, d, w, true); return (unsigned)w; }
#else
typedef float f32x4_h __attribute__((ext_vector_type(4)));
HD f32x4_h unpk4_fp8(unsigned w) { return (f32x4_h){fp8_to_f32(w & 255u), fp8_to_f32((w >> 8) & 255u), fp8_to_f32((w >> 16) & 255u), fp8_to_f32(w >> 24)}; }
HD unsigned pk4_fp8(float a, float b, float c, float d) { return f32_to_fp8_sw(a) | (f32_to_fp8_sw(b) << 8) | (f32_to_fp8_sw(c) << 16) | (f32_to_fp8_sw(d) << 24); }
#endif

constexpr size_t al256(size_t x) { return (x + 255) & ~(size_t)255; }
constexpr size_t WS_CTL = 0, CTL_ZERO_BYTES = 1u << 20;
constexpr int CW_BAR = 4096;
constexpr int CW_CNT = 16384;
constexpr size_t WS_MOD = CTL_ZERO_BYTES;
constexpr size_t WS_WIN = al256(WS_MOD + (size_t)DEPTH * (NB + 1) * 6 * D * 4);
constexpr size_t WS_WOUT = al256(WS_WIN + (size_t)DEPTH * INW * D * 2);
constexpr size_t WS_W1 = al256(WS_WOUT + (size_t)DEPTH * D * D * 2);
constexpr size_t WS_W2 = al256(WS_W1 + (size_t)DEPTH * NE * 2 * DE * D * 2);
constexpr size_t WS_WDFT = al256(WS_W2 + (size_t)DEPTH * NE * D * DE * 2);
constexpr size_t WS_XS = al256(WS_WDFT + (size_t)(4u << 20));
constexpr size_t WS_HB = al256(WS_XS + (size_t)T * D * 4);
constexpr size_t WS_LOG = al256(WS_HB + (size_t)T * D * 2);
constexpr size_t WS_TOPI = al256(WS_LOG + (size_t)T * NE * 4);
constexpr size_t WS_GATE = al256(WS_TOPI + (size_t)T * TOPK * 4);
constexpr size_t WS_RANK = al256(WS_GATE + (size_t)T * TOPK * 4);
constexpr size_t WS_POS = al256(WS_RANK + (size_t)T * TOPK * 4);
constexpr size_t WS_BLKE = al256(WS_POS + (size_t)T * TOPK * 4);
constexpr size_t WS_BLKCNT = al256(WS_BLKE + (size_t)(NBLKMAX + 64) * 4);
constexpr size_t WS_HB8 = al256(WS_BLKCNT + (size_t)DEPTH * 1024 * NE * 4);
constexpr size_t WS_ARENA = al256(WS_HB8 + (size_t)T * D);
constexpr size_t WS_PJ = WS_ARENA;
constexpr size_t WS_QR = al256(WS_PJ + (size_t)T * INW * 2);
constexpr size_t WS_KR = al256(WS_QR + (size_t)T * QW * 2);
constexpr size_t WS_ZT = al256(WS_KR + (size_t)T * (QW / 2) * 2);
constexpr size_t WS_ZC = al256(WS_ZT + (size_t)NB * QW * 2 * SEQ * 2);
constexpr size_t WS_OF = al256(WS_ZC + (size_t)TC * 2 * QW * 4);
constexpr size_t WS_MIX = al256(WS_OF + (size_t)2 * T * QW * 4);
constexpr size_t WS_Y = al256(WS_MIX + (size_t)T * D * 2);
constexpr size_t WS_MIXER_END = al256(WS_Y + (size_t)T * D * 2);
constexpr size_t WS_AS = WS_ARENA;
constexpr size_t WS_ACT = al256(WS_AS + (size_t)PMAX * D * 2);
constexpr size_t WS_YM = al256(WS_ACT + (size_t)PMAX * DE * 2);
constexpr size_t WS_MOE_END = al256(WS_YM + (size_t)PMAX * D * 2);
constexpr size_t WS_TOTAL = WS_MIXER_END > WS_MOE_END ? WS_MIXER_END : WS_MOE_END;

struct P {
    const float *x, *c, *ctx, *c_ctx, *w_mod, *b_mod, *w_in, *pool_w, *pool_scale, *attn_sink, *ret_decay, *w_out, *ln_g, *ln_b, *router_w, *router_b, *exp_w1, *exp_b1, *exp_w2, *exp_b2;
    float* out;
    unsigned char* ws; int qbank;
    float* mod; bf16 *WinT, *WoutT, *W1T, *W2T, *Wdft; bf16* xs; bf16* hb; float* logits; int* topi; float* gate; int* rank; int* pos; int* blke; int* cnt; int* blkcnt; int* rowtok; unsigned char *hb8, *W1T8, *W2T8, *as8, *act8, *ym8;
    bf16 *pj, *qr, *kr, *zt; float* zc; float* of; float* rs; bf16* rs16; bf16 *ft64, *ft128, *ct, *pwt; float* rtab; float* ctab; bf16 *mix, *y; bf16 *as, *act, *ym;
};
HD void fill_views(P& p) {
    unsigned char* ws = p.ws; p.qbank = 0;
    p.mod = (float*)(ws + WS_MOD); p.WinT = (bf16*)(ws + WS_WIN); p.WoutT = (bf16*)(ws + WS_WOUT); p.W1T = (bf16*)(ws + WS_W1); p.W2T = (bf16*)(ws + WS_W2); p.Wdft = (bf16*)(ws + WS_WDFT);
    p.xs = (bf16*)(ws + WS_XS); p.hb = (bf16*)(ws + WS_HB); p.logits = (float*)(ws + WS_LOG); p.topi = (int*)(ws + WS_TOPI); p.gate = (float*)(ws + WS_GATE); p.rank = (int*)(ws + WS_RANK);
    p.pos = (int*)(ws + WS_POS); p.blke = (int*)(ws + WS_BLKE); p.cnt = (int*)(ws + WS_CTL) + CW_CNT; p.blkcnt = (int*)(ws + WS_BLKCNT); p.rowtok = (int*)(ws + WS_AS); p.hb8 = ws + WS_HB8; p.W1T8 = ws + WS_W1; p.W2T8 = ws + WS_W2; p.as8 = ws + WS_AS; p.act8 = ws + WS_ACT; p.ym8 = ws + WS_YM;
    p.pj = (bf16*)(ws + WS_PJ); p.qr = (bf16*)(ws + WS_QR); p.kr = (bf16*)(ws + WS_KR); p.zt = (bf16*)(ws + WS_ZT); p.zc = (float*)(ws + WS_ZC); p.of = (float*)(ws + WS_OF); p.rs = (float*)(ws + WS_OF); p.rs16 = (bf16*)(ws + WS_OF); p.ft64 = (bf16*)(ws + WS_WDFT); p.ft128 = (bf16*)(ws + WS_WDFT + 65536); p.ct = (bf16*)(ws + WS_ZT); p.pwt = (bf16*)(ws + WS_WDFT + 262144); p.rtab = (float*)(ws + WS_WDFT + 524288); p.ctab = (float*)(ws + WS_WDFT + 786432);
    p.mix = (bf16*)(ws + WS_MIX); p.y = (bf16*)(ws + WS_Y); p.as = (bf16*)(ws + WS_AS); p.act = (bf16*)(ws + WS_ACT); p.ym = (bf16*)(ws + WS_YM);
}
HD int row_slot(int t) { return t < TC ? NB : (t - TC) / SEQ; }
HD void row_seq(int t, int& n, int& N, int& t0) { if (t < TC) { n = t % LCTX; N = LCTX; t0 = t - n; } else { n = (t - TC) % SEQ; N = SEQ; t0 = t - n; } }
HD const float* modp(const P& p, int l, int slot, int which) { return p.mod + ((size_t)(l * (NB + 1) + slot) * 6 + which) * D; }
HD void ph_fch(const P& p, long gid) {
    const int gc = (int)(gid % QW), t = (int)(gid / QW); const int g = gc / FC, cp = gc % FC;
    const bf16* a = p.pj + (size_t)t * INW + A_OFF + g * FC;
    float br = 0.f, bs = 0.f;
    for (int c = 0; c < FC; ++c) { float cs, sn; sincos_rev((float)((c * cp) % FC) * (1.0f / (float)FC), cs, sn); const float v = bf2f(a[c]); br += v * cs; bs += v * sn; }
    { const float s = 1.0f / sqrtf((float)LCTX * FC); p.zc[(size_t)t * 2 * QW + gc] = br * s; p.zc[(size_t)t * 2 * QW + QW + gc] = -bs * s; }
}
HD void ph_ctab(const P& p, long gid) { const float a = 2.0f * (float)gid / (float)LCTX; p.ctab[2 * gid] = cospif(a); p.ctab[2 * gid + 1] = sinpif(a); }
HD void ph_fctx(const P& p, long gid) {
    const int gc = (int)(gid % QW), t = (int)(gid / QW); const int k = t % LCTX, t0 = t - k;
    float acc = 0.f;
    for (int n0 = 0; n0 < LCTX; n0 += 16) {
        float zr[16], zi[16];
#pragma unroll
        for (int u = 0; u < 16; ++u) { const float* z = p.zc + (size_t)(t0 + n0 + u) * 2 * QW; zr[u] = z[gc]; zi[u] = z[QW + gc]; }
#pragma unroll
        for (int u = 0; u < 16; ++u) { const int m = ((n0 + u) * k) % LCTX; acc += p.ctab[2 * m] * zr[u] + p.ctab[2 * m + 1] * zi[u]; }
    }
    p.mix[(size_t)t * D + gc] = (bf16)f2bf(acc);
}
HD void ph_pwt(const P& p, long gid) { const int c = (int)(gid % PGW), d = (int)(gid / PGW) % PGW; const long lg = gid / (PGW * PGW); p.pwt[gid] = (bf16)f2bf(p.pool_w[(lg * PGW + c) * PGW + d]); }
#ifndef CPU_TEST
#define LAS __attribute__((address_space(3)))
typedef short bf16x8 __attribute__((ext_vector_type(8)));
typedef float f32x4 __attribute__((ext_vector_type(4)));
typedef float f32x16 __attribute__((ext_vector_type(16)));
typedef unsigned u32x4 __attribute__((ext_vector_type(4)));
typedef unsigned u32x2 __attribute__((ext_vector_type(2)));
typedef _Float16 half8 __attribute__((ext_vector_type(8)));
#define WAVE_LDS_FENCE() asm volatile("s_waitcnt lgkmcnt(0)" ::: "memory")
#define SCHED_FENCE() __builtin_amdgcn_sched_barrier(0)
#else
#define LAS
#define WAVE_LDS_FENCE() emu::wave_sync()
#define SCHED_FENCE()
#endif
constexpr int NWV = 8;
constexpr int TS = 72;
constexpr int TILE_B = 64 * TS * 2;
constexpr int WAVE_LDS = 2 * TILE_B;
HD unsigned pk2f(float lo, float hi) { return cvt_pk_bf16(lo, hi); }
template <int CTRL, int BANK = 0xF> HD float dpp_mov(float old, float v) { return __builtin_bit_cast(float, __builtin_amdgcn_update_dpp(__builtin_bit_cast(int, old), __builtin_bit_cast(int, v), CTRL, 0xF, BANK, false)); }
template <int M> HD float xchg_xor(float v) {
    if constexpr (M == 1) return dpp_mov<0xB1>(v, v);
    else if constexpr (M == 2) return dpp_mov<0x4E>(v, v);
    else if constexpr (M == 4) { float r = dpp_mov<0x104, 0x5>(v, v); return dpp_mov<0x114, 0xA>(r, v); }
    else if constexpr (M == 8) return dpp_mov<0x128>(v, v);
    else return __shfl_xor(v, M);
}
#ifndef CPU_TEST
HD float row16_sum(float v) { v += dpp_mov<0x128>(v, v);
    asm volatile("s_nop 1\n\tv_add_f32_dpp %0, %0, %0 row_ror:4 row_mask:0xf bank_mask:0xf\n\ts_nop 1\n\tv_add_f32_dpp %0, %0, %0 quad_perm:[2,3,0,1] row_mask:0xf bank_mask:0xf\n\t"
                 "s_nop 1\n\tv_add_f32_dpp %0, %0, %0 quad_perm:[1,0,3,2] row_mask:0xf bank_mask:0xf\n\ts_nop 1" : "+v"(v));
    return v; }
HD float row16_max(float v) { v = fmaxf(v, dpp_mov<0x128>(v, v));
    asm volatile("s_nop 1\n\tv_max_f32_dpp %0, %0, %0 row_ror:4 row_mask:0xf bank_mask:0xf\n\ts_nop 1\n\tv_max_f32_dpp %0, %0, %0 quad_perm:[2,3,0,1] row_mask:0xf bank_mask:0xf\n\t"
                 "s_nop 1\n\tv_max_f32_dpp %0, %0, %0 quad_perm:[1,0,3,2] row_mask:0xf bank_mask:0xf\n\ts_nop 1" : "+v"(v));
    return v; }
#else
HD float row16_sum(float v) { v += dpp_mov<0x128>(v, v); v += dpp_mov<0x124>(v, v); v += dpp_mov<0x4E>(v, v); v += dpp_mov<0xB1>(v, v); return v; }
HD float row16_max(float v) { v = fmaxf(v, dpp_mov<0x128>(v, v)); v = fmaxf(v, dpp_mov<0x124>(v, v)); v = fmaxf(v, dpp_mov<0x4E>(v, v)); v = fmaxf(v, dpp_mov<0xB1>(v, v)); return v; }
#endif
#ifndef CPU_TEST
#define R16_STEP4(op, ctl) op " %0, %0, %0 " ctl " row_mask:0xf bank_mask:0xf\n\t" op " %1, %1, %1 " ctl " row_mask:0xf bank_mask:0xf\n\t" op " %2, %2, %2 " ctl " row_mask:0xf bank_mask:0xf\n\t" op " %3, %3, %3 " ctl " row_mask:0xf bank_mask:0xf\n\t"
HD void row16_sum4(float (&v)[4]) {
    asm("s_nop 1\n\t" R16_STEP4("v_add_f32_dpp", "row_ror:8") R16_STEP4("v_add_f32_dpp", "row_ror:4") R16_STEP4("v_add_f32_dpp", "quad_perm:[2,3,0,1]") R16_STEP4("v_add_f32_dpp", "quad_perm:[1,0,3,2]") "s_nop 1"
        : "+v"(v[0]), "+v"(v[1]), "+v"(v[2]), "+v"(v[3])); }
HD void row16_max4(float (&v)[4]) {
    asm("s_nop 1\n\t" R16_STEP4("v_max_f32_dpp", "row_ror:8") R16_STEP4("v_max_f32_dpp", "row_ror:4") R16_STEP4("v_max_f32_dpp", "quad_perm:[2,3,0,1]") R16_STEP4("v_max_f32_dpp", "quad_perm:[1,0,3,2]") "s_nop 1"
        : "+v"(v[0]), "+v"(v[1]), "+v"(v[2]), "+v"(v[3])); }
#else
HD void row16_sum4(float (&v)[4]) { for (int j = 0; j < 4; ++j) v[j] = row16_sum(v[j]); }
HD void row16_max4(float (&v)[4]) { for (int j = 0; j < 4; ++j) v[j] = row16_max(v[j]); }
#endif
HD float rdlane(float v, int l) { return __builtin_bit_cast(float, __builtin_amdgcn_readlane(__builtin_bit_cast(int, v), l)); }
HD bf16x8 ldfrag(const LAS bf16* tile, int row, int k) { return *(const LAS bf16x8*)(tile + row * TS + k); }
HD void stage_tile_ld(u32x4 (&v)[8], const bf16* src, size_t gs, int lane) {
#pragma unroll
    for (int it = 0; it < 8; ++it) { const int r = it * 8 + (lane >> 3), cc = lane & 7; v[it] = *(const u32x4*)(src + (size_t)r * gs + cc * 8); }
}
HD void stage_tile_ld_nt(u32x4 (&v)[8], const bf16* src, size_t gs, int lane) {
#pragma unroll
    for (int it = 0; it < 8; ++it) { const int r = it * 8 + (lane >> 3), cc = lane & 7; v[it] = __builtin_nontemporal_load((const u32x4*)(src + (size_t)r * gs + cc * 8)); }
}
HD void stage_tile_st(LAS bf16* dst, const u32x4 (&v)[8], int lane) {
#pragma unroll
    for (int it = 0; it < 8; ++it) { const int r = it * 8 + (lane >> 3), cc = lane & 7; *(LAS u32x4*)(dst + r * TS + cc * 8) = v[it]; }
}
HD void stage_tile(LAS bf16* dst, const bf16* src, size_t gs, int lane) {
#pragma unroll 4
    for (int it = 0; it < 8; ++it) { const int r = it * 8 + (lane >> 3), cc = lane & 7; const u32x4 v = *(const u32x4*)(src + (size_t)r * gs + cc * 8); *(LAS u32x4*)(dst + r * TS + cc * 8) = v; }
}
HD void stage_tile_T_ld(u32x4 (&v)[8], const bf16* src, size_t gs, int lane) {
#pragma unroll
    for (int cc = 0; cc < 8; ++cc) v[cc] = *(const u32x4*)(src + (size_t)lane * gs + cc * 8);
}
HD void stage_tile_T_st(LAS bf16* dst, const u32x4 (&v)[8], int lane, float lg, int mode, float s) {
    const int r = lane; const float w = mode == 0 ? s : s * __expf(lg * (float)(mode == 1 ? 63 - r : r));
#pragma unroll
    for (int cc = 0; cc < 8; ++cc)
#pragma unroll
        for (int e = 0; e < 4; ++e) { const unsigned u = v[cc][e];
            if (mode == 0 && s == 1.0f) { dst[(cc * 8 + 2 * e) * TS + r] = (bf16)(u & 0xffffu); dst[(cc * 8 + 2 * e + 1) * TS + r] = (bf16)(u >> 16); }
            else { dst[(cc * 8 + 2 * e) * TS + r] = (bf16)f2bf(bf2f((bf16)(u & 0xffffu)) * w); dst[(cc * 8 + 2 * e + 1) * TS + r] = (bf16)f2bf(bf2f((bf16)(u >> 16)) * w); } }
}
HD void stage_tile_T(LAS bf16* dst, const bf16* src, size_t gs, int lane, float lg, int mode, float s) { u32x4 v[8]; stage_tile_T_ld(v, src, gs, lane); stage_tile_T_st(dst, v, lane, lg, mode, s); }
HD void stage_tile_f32(LAS bf16* dst, const float* src, int lane) {
#pragma unroll 8
    for (int it = 0; it < 16; ++it) { const int r = it * 4 + (lane >> 4), c4 = lane & 15; const f32x4 v = *(const f32x4*)(src + r * 64 + c4 * 4);
        u32x2 o; o.x = pk2f(v[0], v[1]); o.y = pk2f(v[2], v[3]); *(LAS u32x2*)(dst + r * TS + c4 * 4) = o; }
}

#ifndef CPU_TEST
HD int q_pop_wave(int* ctr, int lane) { int v = 0; if (lane == 0) v = __hip_atomic_fetch_add(ctr, 1, __ATOMIC_RELAXED, __HIP_MEMORY_SCOPE_AGENT); return __builtin_amdgcn_readfirstlane(v); }
#else
HD int q_pop_wave(int* ctr, int lane) { const int base = emu::g_cur & ~63; emu::wave_sync(); if (lane == 0) emu::g_xi[base] = (*ctr)++; emu::wave_sync(); const int v = emu::g_xi[base]; emu::wave_sync(); return v; }
#endif
HD int static_task(int qiter, int ntask, int gw, int nw) {
    if (qiter == 0) return gw;
    const int rem = ntask - qiter * nw; if (rem <= 0) return 0x7fffffff;
    if (rem >= nw) return qiter * nw + gw;
    const int stride = nw / rem, r = nw - 1 - gw;
    return (r % stride == 0 && r / stride < rem) ? qiter * nw + r / stride : 0x7fffffff;
}
HD int* q_ctr(const P& p, int l, int k) { return p.cnt + 1024 + ((p.qbank * DEPTH + l) * 8 + k) * 64; }
constexpr int RCH = 64, NCH = (LCTX + SEQ) / RCH, NCHC = LCTX / RCH;
HD int ret_row0(int b, int c) { return c < NCHC ? b * LCTX + c * RCH : TC + b * SEQ + (c - NCHC) * RCH; }
HD size_t rs_off(int dir, int b, int h, int c) { return ((((size_t)dir * NB + b) * RH + h) * NCH + c) * (size_t)(RDK * RDK); }
HD void ph_retA(const P& p, int l, LAS unsigned char* lds) {
    static_assert(RDK == 64 && LCTX % RCH == 0 && SEQ % RCH == 0, "retention wave kernels are written for dk = dv = 64");
    int tid = threadIdx.x; OPAQUE_V(tid); const int wave = __builtin_amdgcn_readfirstlane(tid >> 6);
    LAS bf16* buf0 = (LAS bf16*)(lds + wave * WAVE_LDS); LAS bf16* buf1 = buf0 + 64 * TS;
    const float ksc = 1.0f / sqrtf((float)RDK);
    int qiter = 0;
    for (;;) {
        int lane = tid & 63; OPAQUE_V(lane);
        const int task = static_task(qiter++, NB * RH * NCH, (int)blockIdx.x * NWV + wave, (int)gridDim.x * NWV); if (task >= NB * RH * NCH) break;
        const int fr = lane & 15, fq = lane >> 4;
        const int c = task % NCH, h = (task / NCH) % RH, b = task / (NCH * RH);
        const bf16* base = p.pj + (size_t)ret_row0(b, c) * INW + h * RDK;
        WAVE_LDS_FENCE();
        u32x4 vv[8];
        { u32x4 kv[8]; stage_tile_T_ld(kv, base + RK_OFF, INW, lane); stage_tile_T_ld(vv, base + RV_OFF, INW, lane);
          stage_tile_T_st(buf1, kv, lane, 0.f, 0, 1.0f); }
        for (int dir = 0; dir < 2; ++dir) {
            const float lg = -expf(p.ret_decay[(l * 2 + dir) * RH + h]);
            WAVE_LDS_FENCE();
            stage_tile_T_st(buf0, vv, lane, lg, dir == 0 ? 1 : 2, ksc);
            WAVE_LDS_FENCE();
            f32x4 acc[4][4];
#pragma unroll
            for (int a = 0; a < 4; ++a)
#pragma unroll
                for (int bb = 0; bb < 4; ++bb) acc[a][bb] = (f32x4){0.f, 0.f, 0.f, 0.f};
#pragma unroll
            for (int ks = 0; ks < 2; ++ks) {
                bf16x8 af[4], bfr[4];
#pragma unroll
                for (int a = 0; a < 4; ++a) { af[a] = ldfrag(buf0, 16 * a + fr, 32 * ks + 8 * fq); bfr[a] = ldfrag(buf1, 16 * a + fr, 32 * ks + 8 * fq); }
#pragma unroll
                for (int a = 0; a < 4; ++a)
#pragma unroll
                    for (int bb = 0; bb < 4; ++bb) acc[a][bb] = __builtin_amdgcn_mfma_f32_16x16x32_bf16(af[a], bfr[bb], acc[a][bb], 0, 0, 0);
            }
            WAVE_LDS_FENCE();
#pragma unroll
            for (int a = 0; a < 4; ++a)
#pragma unroll
                for (int bb = 0; bb < 4; ++bb)
#pragma unroll
                    for (int j = 0; j < 4; ++j) buf0[(16 * a + 4 * fq + j) * TS + 16 * bb + fr] = (bf16)f2bf(acc[a][bb][j]);
            WAVE_LDS_FENCE();
            { bf16* out = p.rs16 + rs_off(dir, b, h, c);
#pragma unroll 4
              for (int it = 0; it < 8; ++it) { const int r = it * 8 + (lane >> 3), cc = lane & 7; { const u32x4 sv_ = *(const LAS u32x4*)(buf0 + r * TS + cc * 8); ST_WT16(out + r * RDK + cc * 8, sv_); } } }
        }
    }
}
HD void ph_retscan(const P& p, int l, long gid) {
    const int e2 = (int)(gid % (RDK * RDK / 2)); int r = (int)(gid / (RDK * RDK / 2)); const int h = r % RH; r /= RH; const int b = r % NB, dir = r / NB;
    const float lg = -expf(p.ret_decay[(l * 2 + dir) * RH + h]); const float dec = expf(lg * (float)RCH);
    float c0 = 0.f, c1 = 0.f;
    constexpr int SB = 44; static_assert(NCH % SB == 0, "scan batches");
#define RSC_PTR(step_) ((unsigned*)(p.rs16 + rs_off(dir, b, h, dir == 0 ? (step_) : ((step_) < NCHC ? NCHC - 1 - (step_) : NCH - 1 - ((step_) - NCHC)))) + e2)
    unsigned tv0[SB], tv1[SB];
#pragma unroll
    for (int u = 0; u < SB; ++u) tv0[u] = __builtin_nontemporal_load(RSC_PTR(u));
    for (int s0 = 0; s0 < NCH; s0 += SB) {
        if (s0 + SB < NCH) {
#pragma unroll
            for (int u = 0; u < SB; ++u) tv1[u] = __builtin_nontemporal_load(RSC_PTR(s0 + SB + u)); }
#pragma unroll
        for (int u = 0; u < SB; ++u) { *RSC_PTR(s0 + u) = pk2f(c0, c1); c0 = dec * c0 + bf2f((bf16)(tv0[u] & 0xffffu)); c1 = dec * c1 + bf2f((bf16)(tv0[u] >> 16)); }
#pragma unroll
        for (int u = 0; u < SB; ++u) tv0[u] = tv1[u];
    }
#undef RSC_PTR
}
HD void ph_retC(const P& p, int l, LAS unsigned char* lds, bool with_ctx) {
    int tid = threadIdx.x; OPAQUE_V(tid); const int wave = __builtin_amdgcn_readfirstlane(tid >> 6);
    LAS bf16* buf0 = (LAS bf16*)(lds + wave * WAVE_LDS); LAS bf16* buf1 = buf0 + 64 * TS;
    const float ksc = 1.0f / sqrtf((float)RDK);
    const int nch = with_ctx ? NCH : NCH - NCHC;
    int qiter = 0;
    for (;;) {
        int lane = tid & 63; OPAQUE_V(lane);
        const int task = static_task(qiter++, NB * RH * nch, (int)blockIdx.x * NWV + wave, (int)gridDim.x * NWV); if (task >= NB * RH * nch) break;
        const int fr = lane & 15, fq = lane >> 4;
        const int c = task % nch + (NCH - nch), h = (task / nch) % RH, b = task / (nch * RH);
        const int row0 = ret_row0(b, c);
        const bf16* base = p.pj + (size_t)row0 * INW + h * RDK;
        const float lgf = -expf(p.ret_decay[(l * 2 + 0) * RH + h]), lgb = -expf(p.ret_decay[(l * 2 + 1) * RH + h]);
        WAVE_LDS_FENCE();
        u32x4 rpre[8];
        { u32x4 qv[8], kv[8]; stage_tile_ld_nt(qv, base + RQ_OFF, INW, lane); stage_tile_ld(kv, base + RK_OFF, INW, lane); stage_tile_ld_nt(rpre, p.rs16 + rs_off(0, b, h, c), RDK, lane);
          stage_tile_st(buf0, qv, lane); stage_tile_st(buf1, kv, lane); }
        WAVE_LDS_FENCE();
        bf16x8 qa[4][2];
#pragma unroll
        for (int a = 0; a < 4; ++a)
#pragma unroll
            for (int ks = 0; ks < 2; ++ks) qa[a][ks] = ldfrag(buf0, 16 * a + fr, 32 * ks + 8 * fq);
        f32x4 O[4][4];
#pragma unroll
        for (int a = 0; a < 4; ++a)
#pragma unroll
            for (int bb = 0; bb < 4; ++bb) O[a][bb] = (f32x4){0.f, 0.f, 0.f, 0.f};
        u32x4 vpre[8];
#pragma unroll
        for (int dir = 0; dir < 2; ++dir) {
            WAVE_LDS_FENCE();
            stage_tile_st(buf0, rpre, lane);
            if (dir == 0) stage_tile_ld_nt(rpre, p.rs16 + rs_off(1, b, h, c), RDK, lane); else stage_tile_T_ld(vpre, base + RV_OFF, INW, lane);
            WAVE_LDS_FENCE();
            const float lgd = dir == 0 ? lgf : lgb;
#pragma unroll
            for (int bb = 0; bb < 4; ++bb) {
                f32x4 tmp[4];
#pragma unroll
                for (int a = 0; a < 4; ++a) tmp[a] = (f32x4){0.f, 0.f, 0.f, 0.f};
#pragma unroll
                for (int ks = 0; ks < 2; ++ks) { const bf16x8 rb = ldfrag(buf0, 16 * bb + fr, 32 * ks + 8 * fq);
#pragma unroll
                    for (int a = 0; a < 4; ++a) tmp[a] = __builtin_amdgcn_mfma_f32_16x16x32_bf16(qa[a][ks], rb, tmp[a], 0, 0, 0); }
#pragma unroll
                for (int a = 0; a < 4; ++a)
#pragma unroll
                    for (int j = 0; j < 4; ++j) { const int i = 16 * a + 4 * fq + j; const float xi = __expf(lgd * (float)(dir == 0 ? i + 1 : RCH - i)); O[a][bb][j] += xi * tmp[a][j]; }
                SCHED_FENCE();
            }
        }
        u32x4 gpre[8]; stage_tile_ld_nt(gpre, base + RG_OFF, INW, lane);
        WAVE_LDS_FENCE();
#pragma unroll
        for (int bb = 0; bb < 4; ++bb) {
            f32x4 S4[4];
#pragma unroll
            for (int a = 0; a < 4; ++a) S4[a] = (f32x4){0.f, 0.f, 0.f, 0.f};
#pragma unroll
            for (int ks = 0; ks < 2; ++ks) { const bf16x8 kb = ldfrag(buf1, 16 * bb + fr, 32 * ks + 8 * fq);
#pragma unroll
                for (int a = 0; a < 4; ++a) S4[a] = __builtin_amdgcn_mfma_f32_16x16x32_bf16(qa[a][ks], kb, S4[a], 0, 0, 0); }
#pragma unroll
            for (int a = 0; a < 4; ++a)
#pragma unroll
                for (int j = 0; j < 4; ++j) { const int i = 16 * a + 4 * fq + j, jj = 16 * bb + fr;
                    const float m = (i >= jj ? __expf(lgf * (float)(i - jj)) : 0.f) + (jj >= i ? __expf(lgb * (float)(jj - i)) : 0.f);
                    buf0[i * TS + jj] = (bf16)f2bf(S4[a][j] * m * ksc); }
            SCHED_FENCE();
        }
        WAVE_LDS_FENCE();
        stage_tile_T_st(buf1, vpre, lane, 0.f, 0, 1.0f);
        WAVE_LDS_FENCE();
#pragma unroll
        for (int ks = 0; ks < 2; ++ks) {
            bf16x8 pa[4], vb[4];
#pragma unroll
            for (int a = 0; a < 4; ++a) { pa[a] = ldfrag(buf0, 16 * a + fr, 32 * ks + 8 * fq); vb[a] = ldfrag(buf1, 16 * a + fr, 32 * ks + 8 * fq); }
#pragma unroll
            for (int a = 0; a < 4; ++a)
#pragma unroll
                for (int bb = 0; bb < 4; ++bb) O[a][bb] = __builtin_amdgcn_mfma_f32_16x16x32_bf16(pa[a], vb[bb], O[a][bb], 0, 0, 0);
        }
        WAVE_LDS_FENCE();
        stage_tile_st(buf1, gpre, lane);
        WAVE_LDS_FENCE();
#pragma unroll
        for (int a = 0; a < 4; ++a) {
            float s4[4], q4[4];
#pragma unroll
            for (int j = 0; j < 4; ++j) s4[j] = (O[a][0][j] + O[a][1][j]) + (O[a][2][j] + O[a][3][j]);
            row16_sum4(s4);
#pragma unroll
            for (int j = 0; j < 4; ++j) { const float mu = s4[j] * (1.0f / RDK); s4[j] = mu; float q = 0.f;
#pragma unroll
                for (int bb = 0; bb < 4; ++bb) { const float d = O[a][bb][j] - mu; q += d * d; }
                q4[j] = q; }
            row16_sum4(q4);
#pragma unroll
            for (int j = 0; j < 4; ++j) {
                const float mu = s4[j], rstd = rsq_f(q4[j] * (1.0f / RDK) + LN_EPS);
                const int i = 16 * a + 4 * fq + j;
#pragma unroll
                for (int bb = 0; bb < 4; ++bb) { const int v = 16 * bb + fr; const float g = bf2f(buf1[i * TS + v]);
                    buf0[i * TS + v] = (bf16)f2bf(silu_f(g) * (O[a][bb][j] - mu) * rstd); }
            }
            SCHED_FENCE();
        }
        WAVE_LDS_FENCE();
        { bf16* orow = p.mix + (size_t)row0 * D + 3 * QW + h * RDK;
#pragma unroll 2
          for (int it = 0; it < 8; ++it) { const int r = it * 8 + (lane >> 3), cc = lane & 7; { const u32x4 sv_ = *(const LAS u32x4*)(buf0 + r * TS + cc * 8); ST_WT16(orow + (size_t)r * D + cc * 8, sv_); } } }
    }
}

constexpr int NJ = D / 256;
HD float wave_sum(float v) { v = row16_sum(v); return (rdlane(v, 0) + rdlane(v, 16)) + (rdlane(v, 32) + rdlane(v, 48)); }
HD void row_stats(const f32x4 (&v)[NJ], float& mu, float& rstd) {
    float s = 0.f;
#pragma unroll
    for (int j = 0; j < NJ; ++j) s += (v[j][0] + v[j][1]) + (v[j][2] + v[j][3]);
    mu = wave_sum(s) * (1.0f / D); float q = 0.f;
#pragma unroll
    for (int j = 0; j < NJ; ++j) { const f32x4 d = v[j] - mu; q += (d[0] * d[0] + d[1] * d[1]) + (d[2] * d[2] + d[3] * d[3]); }
    rstd = rsq_f(wave_sum(q) * (1.0f / D) + LN_EPS);
}
HD f32x4 ld4(const float* p) { return *(const f32x4*)p; }
HD f32x4 ld4bf(const bf16* p) { const u32x2 u = *(const u32x2*)p; f32x4 r; r[0] = bf2f((bf16)(u.x & 0xffffu)); r[1] = bf2f((bf16)(u.x >> 16)); r[2] = bf2f((bf16)(u.y & 0xffffu)); r[3] = bf2f((bf16)(u.y >> 16)); return r; }
HD void st4bf(bf16* p, f32x4 v) { u32x2 o; o.x = pk2f(v[0], v[1]); o.y = pk2f(v[2], v[3]); *(u32x2*)p = o; }
HD void row_lnmod_store(const P& p, int l, int which, int t, const f32x4 (&v)[NJ], int lane, f32x4 (*keep)[NJ], bool as_fp8 = false) {
    float mu, rstd; row_stats(v, mu, rstd);
    const int slot = row_slot(t); const float* sh = modp(p, l, slot, which); const float* sc = modp(p, l, slot, which + 1);
#pragma unroll
    for (int j = 0; j < NJ; ++j) { const int c = 4 * lane + 256 * j; const f32x4 h = (v[j] - mu) * rstd * (ld4(sc + c) + 1.0f) + ld4(sh + c);
        if (as_fp8) *(unsigned*)(p.hb8 + (size_t)t * D + c) = pk4_fp8(h[0], h[1], h[2], h[3]); else st4bf(p.hb + (size_t)t * D + c, h);
        if (keep) (*keep)[j] = h; }
}
HD void ph_mod_block(const P& p, LAS unsigned char* lds) {
    int tid = threadIdx.x; OPAQUE_V(tid);
    LAS float* sl = (LAS float*)lds;
    LAS float* red = sl + (NB + 1) * D;
    static_assert(((NB + 1) * D + 8 * (NB + 1) * 64) * 4 <= 147456 && D % 256 == 0 && (NB + 1) * 64 <= NWV * 64, "mod GEMV LDS / shape");
    { static_assert(((NB + 1) * D) % (NWV * 64) == 0, "mod input staging"); constexpr int NI = (NB + 1) * D / (NWV * 64); float cv[NI];
#pragma unroll
      for (int u = 0; u < NI; ++u) { const int i = tid + u * NWV * 64; const int slot = i / D, k = i % D; cv[u] = slot < NB ? p.c[(size_t)slot * D + k] : p.c_ctx[k]; }
#pragma unroll
      for (int u = 0; u < NI; ++u) sl[tid + u * NWV * 64] = silu_f(cv[u]); }
    __syncthreads();
    constexpr int GPL = 6 * D / 64, KP = D / 8;
    for (int grp = blockIdx.x; grp < DEPTH * GPL; grp += gridDim.x) {
        const int l = grp / GPL, j0 = (grp % GPL) * 64, col = tid & 63, kp = tid >> 6;
        const float* w = p.w_mod + ((size_t)l * D + (size_t)kp * KP) * 6 * D + j0 + col;
        float acc[NB + 1];
#pragma unroll
        for (int sidx = 0; sidx <= NB; ++sidx) acc[sidx] = 0.f;
        for (int k0 = 0; k0 < KP; k0 += 32) {
            float wv[32];
#pragma unroll
            for (int u = 0; u < 32; ++u) wv[u] = w[(size_t)(k0 + u) * 6 * D];
#pragma unroll
            for (int u = 0; u < 32; ++u)
#pragma unroll
                for (int sidx = 0; sidx <= NB; ++sidx) acc[sidx] += sl[sidx * D + kp * KP + k0 + u] * wv[u];
        }
#pragma unroll
        for (int sidx = 0; sidx <= NB; ++sidx) red[(kp * (NB + 1) + sidx) * 64 + col] = acc[sidx];
        __syncthreads();
        if (tid < (NB + 1) * 64) { const int sidx = tid >> 6; float t = p.b_mod[(size_t)l * 6 * D + j0 + col];
#pragma unroll
            for (int q = 0; q < 8; ++q) t += red[(q * (NB + 1) + sidx) * 64 + col];
            p.mod[((size_t)l * (NB + 1) + sidx) * 6 * D + j0 + col] = t; }
        __syncthreads();
    }
}
HD void ln0_row(const P& p, int t, bool live, int lane) {
    const float* src = t < TC ? p.ctx + (size_t)t * D : p.x + (size_t)(t - TC) * D;
    f32x4 v[NJ];
#pragma unroll
    for (int j = 0; j < NJ; ++j) v[j] = ld4(src + 4 * lane + 256 * j);
    float mu, rstd; row_stats(v, mu, rstd);
    const int slot = row_slot(t); const float* sh = modp(p, 0, slot, 0); const float* sc = modp(p, 0, slot, 1);
    if (live) {
#pragma unroll
        for (int j = 0; j < NJ; ++j) { const int c = 4 * lane + 256 * j; { const f32x4 h = (v[j] - mu) * rstd * (ld4(sc + c) + 1.0f) + ld4(sh + c); *(unsigned*)(p.hb8 + (size_t)t * D + c) = pk4_fp8(h[0], h[1], h[2], h[3]); } } }
}
HD void ph_rows_ln0(const P& p, LAS unsigned char* lds) {
    int tid = threadIdx.x; OPAQUE_V(tid); const int wave = __builtin_amdgcn_readfirstlane(tid >> 6);
    int lane = tid & 63; OPAQUE_V(lane);
    const int S = (int)gridDim.x * NWV; int t = (int)blockIdx.x * NWV + wave; if (t >= T) return;
#define LN0_LD(t_, x_, sh_, sc_, prev_, shp_, scp_) do { const float* src_ = (t_) < TC ? p.ctx + (size_t)(t_) * D : p.x + (size_t)((t_) - TC) * D; const int slot_ = row_slot(t_); \
        _Pragma("unroll") for (int j_ = 0; j_ < NJ; ++j_) x_[j_] = __builtin_nontemporal_load((const f32x4*)(src_ + 4 * lane + 256 * j_)); \
        if (slot_ != (prev_)) { _Pragma("unroll") for (int j_ = 0; j_ < NJ; ++j_) { const int c_ = 4 * lane + 256 * j_; sh_[j_] = ld4(modp(p, 0, slot_, 0) + c_); sc_[j_] = ld4(modp(p, 0, slot_, 1) + c_); } } \
        else { _Pragma("unroll") for (int j_ = 0; j_ < NJ; ++j_) { sh_[j_] = shp_[j_]; sc_[j_] = scp_[j_]; } } } while (0)
    f32x4 x0[NJ], x1[NJ], sh0[NJ], sh1[NJ], sc0[NJ], sc1[NJ];
    LN0_LD(t, x0, sh0, sc0, -1, sh0, sc0);
    for (; t < T; t += S) {
        if (t + S < T) LN0_LD(t + S, x1, sh1, sc1, row_slot(t), sh0, sc0);
        float mu, rstd; row_stats(x0, mu, rstd);
#pragma unroll
        for (int j = 0; j < NJ; ++j) { const int c = 4 * lane + 256 * j; const f32x4 h = (x0[j] - mu) * rstd * (sc0[j] + 1.0f) + sh0[j]; *(unsigned*)(p.hb8 + (size_t)t * D + c) = pk4_fp8(h[0], h[1], h[2], h[3]); }
#pragma unroll
        for (int j = 0; j < NJ; ++j) { x0[j] = x1[j]; sh0[j] = sh1[j]; sc0[j] = sc1[j]; }
    }
#undef LN0_LD
}
#ifndef CPU_TEST
#define LDS_ATOMIC_INC(ptr) __hip_atomic_fetch_add((ptr), 1, __ATOMIC_RELAXED, __HIP_MEMORY_SCOPE_WORKGROUP)
#else
#define LDS_ATOMIC_INC(ptr) ((*(ptr))++)
#endif
HD int rows_per_block(int tlo) { return (T - tlo + (int)gridDim.x - 1) / (int)gridDim.x; }
template <bool L0> HD void rows_res1_impl(const P& p, int l, int tlo, LAS unsigned char* lds) {
    int tid = threadIdx.x; OPAQUE_V(tid); const int wave = __builtin_amdgcn_readfirstlane(tid >> 6);
    constexpr int WS_ = D + 8, NT = (NE + 15) / 16;
    LAS _Float16* wt = (LAS _Float16*)lds;
    LAS _Float16* ht = wt + NE * WS_ + wave * (4 * WS_);
    LAS int* hist = (LAS int*)(lds + (NE * WS_ + NWV * 4 * WS_) * 2);
    static_assert((NE * WS_ + NWV * 4 * WS_) * 2 + NE * 4 <= 147456 && NE <= 32 && D % 256 == 0, "router LDS");
    const int lane0 = tid & 63;
    { const float* rw = p.router_w + (size_t)l * D * NE;
      static_assert((D * NE) % (NWV * 64 * 4 * 16) == 0 && NE % 4 == 0, "router staging");
#pragma unroll 1
      for (int base = 0; base < D * NE; base += NWV * 64 * 4 * 16) { f32x4 rv[16];
#pragma unroll
          for (int u = 0; u < 16; ++u) rv[u] = ld4(rw + base + (u * NWV * 64 + tid) * 4);
#pragma unroll
          for (int u = 0; u < 16; ++u) { const int idx = base + (u * NWV * 64 + tid) * 4; const int i = idx / NE, e = idx % NE;
#pragma unroll
              for (int q = 0; q < 4; ++q) wt[(e + q) * WS_ + i] = (_Float16)rv[u][q]; } } }
    if (wave == 0) hist[lane0 % NE] = 0;
    __syncthreads();
    const int R = rows_per_block(tlo); const int rbeg = tlo + (int)blockIdx.x * R; const int rend = rbeg + R < T ? rbeg + R : T;
    const int nrows = rend - rbeg; const int nfull = (nrows / 32) * 8;
    const int nbatch = nfull + (nrows - nfull * 4);
    int lanep = tid & 63; OPAQUE_V(lanep);
    f32x4 lgv[NJ], lbv[NJ];
    { const float* lg = p.ln_g + (size_t)(l * 2 + 0) * D; const float* lb = p.ln_b + (size_t)(l * 2 + 0) * D;
#pragma unroll
      for (int j = 0; j < NJ; ++j) { lgv[j] = ld4(lg + 4 * lanep + 256 * j); lbv[j] = ld4(lb + 4 * lanep + 256 * j); } }
    typedef typename std::conditional<L0, f32x4, u32x2>::type xr_t;
#define R1_ROW0(bi_) ((bi_) < nfull ? rbeg + 4 * (bi_) : rbeg + 4 * nfull + ((bi_) - nfull))
#define R1_LD(t_, xr_, yv_, g1_, sh_, sc_, prev_, g1p_, shp_, scp_) do { const int slot_ = row_slot(t_); \
        _Pragma("unroll") for (int j_ = 0; j_ < NJ; ++j_) { const int c_ = 4 * lanep + 256 * j_; \
            if constexpr (L0) xr_[j_] = __builtin_nontemporal_load((const f32x4*)(((t_) < TC ? p.ctx + (size_t)(t_) * D : p.x + (size_t)((t_) - TC) * D) + c_)); else xr_[j_] = __builtin_nontemporal_load((const u32x2*)(p.xs + (size_t)(t_) * D + c_)); \
            yv_[j_] = __builtin_nontemporal_load((const u32x2*)(p.y + (size_t)(t_) * D + c_)); } \
        if (slot_ != (prev_)) { _Pragma("unroll") for (int j_ = 0; j_ < NJ; ++j_) { const int c_ = 4 * lanep + 256 * j_; g1_[j_] = ld4(modp(p, l, slot_, 2) + c_); sh_[j_] = ld4(modp(p, l, slot_, 3) + c_); sc_[j_] = ld4(modp(p, l, slot_, 4) + c_); } } \
        else { _Pragma("unroll") for (int j_ = 0; j_ < NJ; ++j_) { g1_[j_] = g1p_[j_]; sh_[j_] = shp_[j_]; sc_[j_] = scp_[j_]; } } } while (0)
    xr_t xr0[NJ], xr1[NJ]; u32x2 yv0[NJ], yv1[NJ]; f32x4 g10[NJ], g11[NJ], sh0[NJ], sh1[NJ], sc0[NJ], sc1[NJ];
    if (wave < nbatch) { const int tf = R1_ROW0(wave); R1_LD(tf, xr0, yv0, g10, sh0, sc0, -1, g10, sh0, sc0); }
    for (int bi = wave; bi < nbatch; bi += NWV) {
        int lane = tid & 63; OPAQUE_V(lane);
        const int fr = lane & 15, fq = lane >> 4;
        const int t0 = R1_ROW0(bi); const int nr = bi < nfull ? 4 : 1;
        WAVE_LDS_FENCE();
#pragma unroll 1
        for (int r = 0; r < nr; ++r) {
            const int t = t0 + r;
            { const bool more = r + 1 < nr; const int bn = bi + NWV; const bool any = more || bn < nbatch; const int tn = more ? t + 1 : (bn < nbatch ? R1_ROW0(bn) : t);
              if (any) R1_LD(tn, xr1, yv1, g11, sh1, sc1, row_slot(t), g10, sh0, sc0); }
            f32x4 v[NJ];
#pragma unroll
            for (int j = 0; j < NJ; ++j) {
                f32x4 xr; if constexpr (L0) xr = xr0[j]; else { xr[0] = bf2f((bf16)(xr0[j].x & 0xffffu)); xr[1] = bf2f((bf16)(xr0[j].x >> 16)); xr[2] = bf2f((bf16)(xr0[j].y & 0xffffu)); xr[3] = bf2f((bf16)(xr0[j].y >> 16)); }
                f32x4 yr; yr[0] = bf2f((bf16)(yv0[j].x & 0xffffu)); yr[1] = bf2f((bf16)(yv0[j].x >> 16)); yr[2] = bf2f((bf16)(yv0[j].y & 0xffffu)); yr[3] = bf2f((bf16)(yv0[j].y >> 16));
                v[j] = xr * DN_ALPHA + g10[j] * yr; }
            float mu, rstd; row_stats(v, mu, rstd);
#pragma unroll
            for (int j = 0; j < NJ; ++j) { const int c = 4 * lane + 256 * j; v[j] = (v[j] - mu) * rstd * lgv[j] + lbv[j]; st4bf(p.xs + (size_t)t * D + c, v[j]); }
            float mu2, rstd2; row_stats(v, mu2, rstd2);
#pragma unroll
            for (int j = 0; j < NJ; ++j) { const int c = 4 * lane + 256 * j; const f32x4 h = (v[j] - mu2) * rstd2 * (sc0[j] + 1.0f) + sh0[j];
                *(unsigned*)(p.hb8 + (size_t)t * D + c) = pk4_fp8(h[0], h[1], h[2], h[3]);
                typedef _Float16 half4 __attribute__((ext_vector_type(4))); const half4 o = {(_Float16)h[0], (_Float16)h[1], (_Float16)h[2], (_Float16)h[3]}; *(LAS half4*)(ht + r * WS_ + c) = o; }
#pragma unroll
            for (int j = 0; j < NJ; ++j) { xr0[j] = xr1[j]; yv0[j] = yv1[j]; g10[j] = g11[j]; sh0[j] = sh1[j]; sc0[j] = sc1[j]; }
        }
        WAVE_LDS_FENCE();
        f32x4 acc[NT];
#pragma unroll
        for (int nt = 0; nt < NT; ++nt) acc[nt] = (f32x4){0.f, 0.f, 0.f, 0.f};
        { const int arow = nr == 4 ? (fr & 3) : 0;
#pragma unroll 4
          for (int ks = 0; ks < D / 32; ++ks) { const half8 a = *(const LAS half8*)(ht + arow * WS_ + 32 * ks + 8 * fq);
#pragma unroll
              for (int nt = 0; nt < NT; ++nt) { const int e = 16 * nt + fr; const half8 bw = *(const LAS half8*)(wt + (e < NE ? e : NE - 1) * WS_ + 32 * ks + 8 * fq);
                  acc[nt] = __builtin_amdgcn_mfma_f32_16x16x32_f16(a, bw, acc[nt], 0, 0, 0); } } }
        float lo = fq == 0 ? acc[0][0] : fq == 1 ? acc[0][1] : fq == 2 ? acc[0][2] : acc[0][3];
        float hi = -3.0e38f;
        if constexpr (NT > 1) hi = fq == 0 ? acc[NT - 1][0] : fq == 1 ? acc[NT - 1][1] : fq == 2 ? acc[NT - 1][2] : acc[NT - 1][3];
        lo = fr < NE ? lo + p.router_b[l * NE + fr] : -3.0e38f;
        if constexpr (NT > 1) hi = 16 + fr < NE ? hi + p.router_b[l * NE + (16 + fr < NE ? 16 + fr : 0)] : -3.0e38f;
        const bool rowlive = fq < nr; const int t = t0 + (rowlive ? fq : 0);
#ifdef CPU_TEST
        if (rowlive) { if (fr < NE) p.logits[(size_t)t * NE + fr] = lo; if (16 + fr < NE) p.logits[(size_t)t * NE + 16 + fr] = hi; }
#endif
        float tv0 = 0.f, tv1 = 0.f, tv2 = 0.f, tv3 = 0.f; int te0 = 0, te1 = 0, te2 = 0, te3 = 0;
#pragma unroll
        for (int k = 0; k < TOPK; ++k) {
            const float mx = row16_max(fmaxf(lo, hi));
            const unsigned blo = (unsigned)(__ballot(lo == mx) >> (16 * fq)) & 0xffffu, bhi = (unsigned)(__ballot(hi == mx) >> (16 * fq)) & 0xffffu;
            const int we = blo ? __builtin_ctz(blo) : 16 + __builtin_ctz(bhi | 0x10000u);
            if (k == 0) { tv0 = mx; te0 = we; } else if (k == 1) { tv1 = mx; te1 = we; } else if (k == 2) { tv2 = mx; te2 = we; } else { tv3 = mx; te3 = we; }
            if (we == fr) lo = -3.0e38f; if (we == 16 + fr) hi = -3.0e38f;
        }
        if (rowlive && fr < TOPK) { const float e1 = __expf(tv1 - tv0), e2 = __expf(tv2 - tv0), e3 = __expf(tv3 - tv0); const float rs = 1.0f / (1.0f + e1 + e2 + e3);
            const int ek = fr == 0 ? te0 : fr == 1 ? te1 : fr == 2 ? te2 : te3; const float gk = (fr == 0 ? 1.0f : fr == 1 ? e1 : fr == 2 ? e2 : e3) * rs;
            p.topi[(size_t)t * TOPK + fr] = ek; p.gate[(size_t)t * TOPK + fr] = gk; LDS_ATOMIC_INC(hist + ek); }
    }
    __syncthreads();
    if (wave == 0) p.blkcnt[((size_t)l * 1024 + blockIdx.x) * NE + lane0 % NE] = hist[lane0 % NE];
    __syncthreads();
}
#undef R1_LD
#undef R1_ROW0
HD void ph_rows_res1(const P& p, int l, int tlo, LAS unsigned char* lds) { if (l == 0) rows_res1_impl<true>(p, l, tlo, lds); else rows_res1_impl<false>(p, l, tlo, lds); }
HD void ph_dispatch(const P& p, int l, int tlo, LAS unsigned char* lds) {
    int tid = threadIdx.x; OPAQUE_V(tid); const int wave = __builtin_amdgcn_readfirstlane(tid >> 6), lane = tid & 63;
    LAS int* part = (LAS int*)lds;
    LAS int* tot = part + 16 * 2 * NE;
    LAS int* cur = tot + NE;
    LAS int* pst = cur + NE;
    LAS int* posl = pst + NE + 8;
    const int G = (int)gridDim.x, me = (int)blockIdx.x;
    { const int e = tid % NE, pt = tid / NE;
      const int pq = pt % 16; int st = 0, sb = 0;
#pragma unroll 1
      for (int b0 = pq; b0 < G; b0 += 16 * 16) { int cv[16];
#pragma unroll
          for (int u = 0; u < 16; ++u) { const int b = b0 + 16 * u; cv[u] = b < G ? p.blkcnt[((size_t)l * 1024 + b) * NE + e] : 0; }
#pragma unroll
          for (int u = 0; u < 16; ++u) { const int b = b0 + 16 * u; st += cv[u]; sb += b < me ? cv[u] : 0; } }
      part[(pq * 2 + 0) * NE + e] = st; part[(pq * 2 + 1) * NE + e] = sb; }
    __syncthreads();
    if (wave == 0) { const int e = lane % NE; int st = 0, sb = 0; for (int pt = 0; pt < 16; ++pt) { st += part[(pt * 2 + 0) * NE + e]; sb += part[(pt * 2 + 1) * NE + e]; } tot[e] = st; cur[e] = sb; }
    __syncthreads();
    if (wave == 0) { const int e = lane % NE; int s = 0, all = 0;
#pragma unroll
        for (int k = 0; k < NE; ++k) { const int pk = (tot[k] + MOEB - 1) / MOEB * MOEB; s += k < e ? pk : 0; all += pk; }
        const int ce = cur[e]; WAVE_LDS_FENCE(); pst[e] = s; cur[e] = ce + s; pst[NE] = all; }
    __syncthreads();
    if (me == 0) {
        const int nblk = pst[NE] / MOEB;
        for (int rb = tid; rb < nblk; rb += NWV * 64) { int e = 0;
#pragma unroll
            for (int k = 1; k < NE; ++k) e += pst[k] <= rb * MOEB ? 1 : 0;
            p.blke[rb] = e; }
        if (tid == 0) p.blke[NBLKMAX] = nblk;
    }
    const int R = rows_per_block(tlo); const int rbeg = tlo + me * R; const int rend = rbeg + R < T ? rbeg + R : T; const int na = (rend - rbeg) * TOPK;
    for (int a0 = tid; a0 < na; a0 += 4 * NWV * 64) { int ev[4];
#pragma unroll
        for (int q = 0; q < 4; ++q) { const int a = a0 + q * NWV * 64; ev[q] = a < na ? p.topi[(size_t)rbeg * TOPK + a] : 0; }
#pragma unroll
        for (int q = 0; q < 4; ++q) { const int a = a0 + q * NWV * 64; if (a < na) { const int ps = LDS_ATOMIC_INC(cur + ev[q]); posl[a] = ps; p.pos[(size_t)rbeg * TOPK + a] = ps; } } }
    __syncthreads();
    static_assert(D == 1024, "a gathered fp8 row is 64 lanes x 16 bytes");
#define DSP_LD(a0_, v_, ps_) do { static_assert(TOPK == 4, "four assignments share a token row"); _Pragma("unroll") for (int q_ = 0; q_ < 8; ++q_) { const int a_ = (a0_) + q_ < na ? (a0_) + q_ : na - 1; ps_[q_] = posl[a_]; \
        if ((q_ & 3) == 0) { const int t_ = rbeg + a_ / TOPK; v_[q_] = __builtin_nontemporal_load((const u32x4*)(p.hb8 + (size_t)t_ * D + lane * 16)); } else v_[q_] = v_[q_ & ~3]; } } while (0)
    { u32x4 v0[8], v1[8]; int ps0[8], ps1[8];
      if (wave * 8 < na) DSP_LD(wave * 8, v0, ps0);
      for (int a0 = wave * 8; a0 < na; a0 += NWV * 8) {
        if (a0 + NWV * 8 < na) DSP_LD(a0 + NWV * 8, v1, ps1);
#pragma unroll
        for (int q = 0; q < 8; ++q) *(u32x4*)(p.as8 + (size_t)ps0[q] * D + lane * 16) = v0[q];
#pragma unroll
        for (int q = 0; q < 8; ++q) { v0[q] = v1[q]; ps0[q] = ps1[q]; }
      } }
#undef DSP_LD
    for (int i = me * NWV + wave; i < NE * MOEB; i += G * NWV) { const int e = i / MOEB, r = i % MOEB; const int row = pst[e] + tot[e] + r;
        if (row < pst[e + 1]) { unsigned zz = 0u; OPAQUE_V(zz); const u32x4 z = {zz, zz, zz, zz}; *(u32x4*)(p.as8 + (size_t)row * D + lane * 16) = z; } }
    __syncthreads();
}
HD void res2_row(const P& p, int l, int t, bool live, int lane, const float* lg, const float* lb) {
    const int slot = row_slot(t); const float* g2 = modp(p, l, slot, 5);
    const int* ps = p.pos + (size_t)t * TOPK; const float* ga = p.gate + (size_t)t * TOPK;
    const unsigned char* y0 = p.ym8 + (size_t)ps[0] * D; const unsigned char* y1 = p.ym8 + (size_t)ps[1] * D; const unsigned char* y2 = p.ym8 + (size_t)ps[2] * D; const unsigned char* y3 = p.ym8 + (size_t)ps[3] * D;
    const float a0 = ga[0], a1 = ga[1], a2 = ga[2], a3 = ga[3];
    f32x4 v[NJ];
#pragma unroll
    for (int j = 0; j < NJ; ++j) { const int c = 4 * lane + 256 * j;
        const f32x4 f = unpk4_fp8(*(const unsigned*)(y0 + c)) * a0 + unpk4_fp8(*(const unsigned*)(y1 + c)) * a1 + unpk4_fp8(*(const unsigned*)(y2 + c)) * a2 + unpk4_fp8(*(const unsigned*)(y3 + c)) * a3;
        v[j] = ld4bf(p.xs + (size_t)t * D + c) * DN_ALPHA + ld4(g2 + c) * f; }
    float mu, rstd; row_stats(v, mu, rstd);
#pragma unroll
    for (int j = 0; j < NJ; ++j) { const int c = 4 * lane + 256 * j; v[j] = (v[j] - mu) * rstd * ld4(lg + c) + ld4(lb + c); }
    if (l == DEPTH - 1) {
        if (live) {
#pragma unroll
            for (int j = 0; j < NJ; ++j) *(f32x4*)(p.out + (size_t)(t - TC) * D + 4 * lane + 256 * j) = v[j]; }
    } else {
        float mu2, rstd2; row_stats(v, mu2, rstd2);
        const float* sh = modp(p, l + 1, slot, 0); const float* sc = modp(p, l + 1, slot, 1);
        if (live) {
#pragma unroll
            for (int j = 0; j < NJ; ++j) { const int c = 4 * lane + 256 * j; st4bf(p.xs + (size_t)t * D + c, v[j]); const f32x4 h = (v[j] - mu2) * rstd2 * (ld4(sc + c) + 1.0f) + ld4(sh + c); *(unsigned*)(p.hb8 + (size_t)t * D + c) = pk4_fp8(h[0], h[1], h[2], h[3]); } }
    }
}
template <bool LASTL> HD void rows_res2_pipe(const P& p, int l, int tlo) {
    static_assert(TOPK == 4, "four gathered rows");
    typedef int i32x4 __attribute__((ext_vector_type(4)));
    int tid = threadIdx.x; OPAQUE_V(tid); const int wave = __builtin_amdgcn_readfirstlane(tid >> 6);
    int lane = tid & 63; OPAQUE_V(lane);
    const int S = (int)gridDim.x * NWV; int t = tlo + (int)blockIdx.x * NWV + wave; if (t >= T) return;
    f32x4 lgv[NJ], lbv[NJ];
    { const float* lg = p.ln_g + (size_t)(l * 2 + 1) * D; const float* lb = p.ln_b + (size_t)(l * 2 + 1) * D;
#pragma unroll
      for (int j = 0; j < NJ; ++j) { lgv[j] = ld4(lg + 4 * lane + 256 * j); lbv[j] = ld4(lb + 4 * lane + 256 * j); } }
#define R2_LD1(t_, ps_, ga_) do { ps_ = *(const i32x4*)(p.pos + (size_t)(t_) * TOPK); ga_ = *(const f32x4*)(p.gate + (size_t)(t_) * TOPK); } while (0)
#define R2_LD2(t_, ps_, ym_, xs_, g2_, sh_, sc_, prev_, g2p2_, shp_, scp_) do { const int slot_ = row_slot(t_); const float* g2p_ = modp(p, l, slot_, 5); \
        _Pragma("unroll") for (int e_ = 0; e_ < 4; ++e_) { const unsigned char* y_ = p.ym8 + (size_t)ps_[e_] * D + 4 * lane; _Pragma("unroll") for (int j_ = 0; j_ < NJ; ++j_) ym_[e_][j_] = __builtin_nontemporal_load((const unsigned*)(y_ + 256 * j_)); } \
        _Pragma("unroll") for (int j_ = 0; j_ < NJ; ++j_) xs_[j_] = __builtin_nontemporal_load((const u32x2*)(p.xs + (size_t)(t_) * D + 4 * lane + 256 * j_)); \
        if (slot_ != (prev_)) { _Pragma("unroll") for (int j_ = 0; j_ < NJ; ++j_) { const int c_ = 4 * lane + 256 * j_; g2_[j_] = ld4(g2p_ + c_); \
            if (!LASTL) { sh_[j_] = ld4(modp(p, l + 1, slot_, 0) + c_); sc_[j_] = ld4(modp(p, l + 1, slot_, 1) + c_); } } } \
        else { _Pragma("unroll") for (int j_ = 0; j_ < NJ; ++j_) { g2_[j_] = g2p2_[j_]; if (!LASTL) { sh_[j_] = shp_[j_]; sc_[j_] = scp_[j_]; } } } } while (0)
    i32x4 ps0, ps1; f32x4 ga0, ga1;
    unsigned ym0[4][NJ], ym1[4][NJ]; u32x2 xs0[NJ], xs1[NJ]; f32x4 g20[NJ], g21[NJ], sh0[NJ], sh1[NJ], sc0[NJ], sc1[NJ];
    R2_LD1(t, ps0, ga0); ps1 = ps0; ga1 = ga0; if (t + S < T) R2_LD1(t + S, ps1, ga1);
    R2_LD2(t, ps0, ym0, xs0, g20, sh0, sc0, -1, g20, sh0, sc0);
    for (; t < T; t += S) {
        i32x4 ps2 = ps1; f32x4 ga2 = ga1;
        if (t + 2 * S < T) R2_LD1(t + 2 * S, ps2, ga2);
        if (t + S < T) R2_LD2(t + S, ps1, ym1, xs1, g21, sh1, sc1, row_slot(t), g20, sh0, sc0);
        f32x4 v[NJ];
#pragma unroll
        for (int j = 0; j < NJ; ++j) {
            const f32x4 f = unpk4_fp8(ym0[0][j]) * ga0[0] + unpk4_fp8(ym0[1][j]) * ga0[1] + unpk4_fp8(ym0[2][j]) * ga0[2] + unpk4_fp8(ym0[3][j]) * ga0[3];
            f32x4 xr; xr[0] = bf2f((bf16)(xs0[j].x & 0xffffu)); xr[1] = bf2f((bf16)(xs0[j].x >> 16)); xr[2] = bf2f((bf16)(xs0[j].y & 0xffffu)); xr[3] = bf2f((bf16)(xs0[j].y >> 16));
            v[j] = xr * DN_ALPHA + g20[j] * f; }
        float mu, rstd; row_stats(v, mu, rstd);
#pragma unroll
        for (int j = 0; j < NJ; ++j) v[j] = (v[j] - mu) * rstd * lgv[j] + lbv[j];
        if (LASTL) {
#pragma unroll
            for (int j = 0; j < NJ; ++j) *(f32x4*)(p.out + (size_t)(t - TC) * D + 4 * lane + 256 * j) = v[j];
        } else {
            float mu2, rstd2; row_stats(v, mu2, rstd2);
#pragma unroll
            for (int j = 0; j < NJ; ++j) { const int c = 4 * lane + 256 * j; st4bf(p.xs + (size_t)t * D + c, v[j]); const f32x4 h = (v[j] - mu2) * rstd2 * (sc0[j] + 1.0f) + sh0[j];
                *(unsigned*)(p.hb8 + (size_t)t * D + c) = pk4_fp8(h[0], h[1], h[2], h[3]); }
        }
        ps0 = ps1; ga0 = ga1; ps1 = ps2; ga1 = ga2;
#pragma unroll
        for (int j = 0; j < NJ; ++j) { xs0[j] = xs1[j]; g20[j] = g21[j]; sh0[j] = sh1[j]; sc0[j] = sc1[j];
#pragma unroll
            for (int e = 0; e < 4; ++e) ym0[e][j] = ym1[e][j]; }
    }
#undef R2_LD1
#undef R2_LD2
}
HD void ph_rows_res2(const P& p, int l, int tlo, LAS unsigned char* lds) {
    if (l == DEPTH - 1) rows_res2_pipe<true>(p, l, tlo); else rows_res2_pipe<false>(p, l, tlo);
}
HD void ph_rtab(const P& p, long gid) { const int j = (int)(gid % 16), pos = (int)(gid / 16); const float inv = powf(ROPE_BASE, -(float)(2 * j) / 32.0f); const float a = (float)pos * inv; p.rtab[2 * gid] = cosf(a); p.rtab[2 * gid + 1] = sinf(a); }
HD void stage_tile_rope_ld(u32x4 (&v)[8], const bf16* src, size_t gs, int lane) {
    const int q = lane & 3, hf = q >> 1, sc = q & 1; const int c1 = 32 * hf + 8 * sc;
#pragma unroll
    for (int it = 0; it < 4; ++it) { const int r = it * 16 + (lane >> 2); v[2 * it] = *(const u32x4*)(src + (size_t)r * gs + c1); v[2 * it + 1] = *(const u32x4*)(src + (size_t)r * gs + c1 + 16); }
}
HD void stage_tile_rope_st(LAS bf16* dst, const u32x4 (&v)[8], int lane, int n0, const float* rtab) {
    static_assert(GW == 64 || GW == 32 || GW == 16, "grid width");
    const int q = lane & 3, hf = q >> 1, sc = q & 1; const int c1 = 32 * hf + 8 * sc;
#pragma unroll
    for (int it = 0; it < 4; ++it) { const int r = it * 16 + (lane >> 2); const int n = n0 + r; const int pos = hf == 0 ? n / GW : n % GW;
        const u32x4 a = v[2 * it], b = v[2 * it + 1];
        const f32x4* tp = (const f32x4*)(rtab + (size_t)(pos * 16 + 8 * sc) * 2);
        u32x4 oa, ob;
#pragma unroll
        for (int e = 0; e < 4; ++e) { const f32x4 t = tp[e];
            const float x1l = bf2f((bf16)(a[e] & 0xffffu)), x1h = bf2f((bf16)(a[e] >> 16)), x2l = bf2f((bf16)(b[e] & 0xffffu)), x2h = bf2f((bf16)(b[e] >> 16));
            oa[e] = pk2f(x1l * t[0] - x2l * t[1], x1h * t[2] - x2h * t[3]); ob[e] = pk2f(x2l * t[0] + x1l * t[1], x2h * t[2] + x1h * t[3]); }
        *(LAS u32x4*)(dst + r * TS + c1) = oa; *(LAS u32x4*)(dst + r * TS + c1 + 16) = ob; }
}
HD void stage_tile_rope(LAS bf16* dst, const bf16* src, size_t gs, int lane, int n0, const float* rtab) {
    const int q = lane & 3, hf = q >> 1, sc = q & 1; const int c1 = 32 * hf + 8 * sc;
#pragma unroll 2
    for (int it = 0; it < 4; ++it) { const int r = it * 16 + (lane >> 2); const int n = n0 + r; const int pos = hf == 0 ? n / GW : n % GW;
        const u32x4 a = *(const u32x4*)(src + (size_t)r * gs + c1), b = *(const u32x4*)(src + (size_t)r * gs + c1 + 16);
        const f32x4* tp = (const f32x4*)(rtab + (size_t)(pos * 16 + 8 * sc) * 2);
        u32x4 oa, ob;
#pragma unroll
        for (int e = 0; e < 4; ++e) { const f32x4 t = tp[e];
            const float x1l = bf2f((bf16)(a[e] & 0xffffu)), x1h = bf2f((bf16)(a[e] >> 16)), x2l = bf2f((bf16)(b[e] & 0xffffu)), x2h = bf2f((bf16)(b[e] >> 16));
            oa[e] = pk2f(x1l * t[0] - x2l * t[1], x1h * t[2] - x2h * t[3]); ob[e] = pk2f(x2l * t[0] + x1l * t[1], x2h * t[2] + x1h * t[3]); }
        *(LAS u32x4*)(dst + r * TS + c1) = oa; *(LAS u32x4*)(dst + r * TS + c1 + 16) = ob; }
}
HD void ph_krope(const P& p, LAS unsigned char* lds) {
    int tid = threadIdx.x; OPAQUE_V(tid); const int wave = __builtin_amdgcn_readfirstlane(tid >> 6);
    LAS bf16* buf = (LAS bf16*)(lds + wave * WAVE_LDS);
    for (int task = blockIdx.x * NWV + wave; task < (TL / 64) * NKV; task += gridDim.x * NWV) {
        int lane = tid & 63; OPAQUE_V(lane);
        const int kvh = task % NKV, rb = task / NKV; const int row0 = TC + rb * 64, n0 = (rb * 64) % SEQ;
        WAVE_LDS_FENCE();
        stage_tile_rope(buf, p.pj + (size_t)row0 * INW + K_OFF + kvh * HDIM, INW, lane, n0, p.rtab);
        WAVE_LDS_FENCE();
        bf16* orow = p.kr + (size_t)row0 * (QW / 2) + kvh * HDIM;
#pragma unroll 2
        for (int it = 0; it < 8; ++it) { const int r = it * 8 + (lane >> 3), cc = lane & 7; { const u32x4 sv_ = *(const LAS u32x4*)(buf + r * TS + cc * 8); ST_WT16(orow + (size_t)r * (QW / 2) + cc * 8, sv_); } }
    }
}
HD void ph_vtrans(const P& p, LAS unsigned char* lds) {
    int tid = threadIdx.x; OPAQUE_V(tid); const int wave = __builtin_amdgcn_readfirstlane(tid >> 6);
    LAS bf16* buf = (LAS bf16*)(lds + wave * WAVE_LDS);
    for (int task = blockIdx.x * NWV + wave; task < (T / 64) * NKV; task += gridDim.x * NWV) {
        int lane = tid & 63; OPAQUE_V(lane);
        const int kvh = task % NKV, row0 = (task / NKV) * 64;
        WAVE_LDS_FENCE();
        stage_tile_T(buf, p.pj + (size_t)row0 * INW + V_OFF + kvh * HDIM, INW, lane, 0.f, 0, 1.0f);
        WAVE_LDS_FENCE();
        bf16* orow = p.qr + (size_t)(kvh * HDIM) * T + row0;
#pragma unroll 2
        for (int it = 0; it < 8; ++it) { const int r = it * 8 + (lane >> 3), cc = lane & 7; { const u32x4 sv_ = *(const LAS u32x4*)(buf + r * TS + cc * 8); ST_WT16(orow + (size_t)r * T + cc * 8, sv_); } }
    }
}

HD void ph_attn_wave(const P& p, int l, LAS unsigned char* lds, bool with_ctx) {
    static_assert(HDIM == 64 && WIN == 128 && SEQ % 64 == 0 && LCTX % 64 == 0, "attention wave kernel is written for head dim 64, window 128");
    int tid = threadIdx.x; OPAQUE_V(tid); const int wave = __builtin_amdgcn_readfirstlane(tid >> 6);
    LAS bf16* buf0 = (LAS bf16*)(lds + wave * WAVE_LDS); LAS bf16* buf1 = buf0 + 64 * TS;
    constexpr int NQB = SEQ / 64, NCB = LCTX / 64, NLAT = NB * NH * NQB;
    const int ntask = NLAT + (with_ctx ? NB * NH * NCB : 0);
    int qiter = 0;
    for (;;) {
        int lane = tid & 63; OPAQUE_V(lane);
        const int task = static_task(qiter++, ntask, (int)blockIdx.x * NWV + wave, (int)gridDim.x * NWV); if (task >= ntask) break;
        const int fr = lane & 15, fq = lane >> 4;
        const bool isctx = task >= NLAT; const int r = isctx ? task - NLAT : task; const int nqb = isctx ? NCB : NQB;
        const int qb = r % nqb, h = (r / nqb) % NH, b = r / (nqb * NH), kvh = h / GQ;
        const int qrow0 = isctx ? b * LCTX + qb * 64 : TC + b * SEQ + qb * 64;
        WAVE_LDS_FENCE();
        if (isctx) stage_tile(buf0, p.pj + (size_t)qrow0 * INW + Q_OFF + h * HDIM, INW, lane);
        else stage_tile_rope(buf0, p.pj + (size_t)qrow0 * INW + Q_OFF + h * HDIM, INW, lane, qb * 64, p.rtab);
        WAVE_LDS_FENCE();
        bf16x8 qa[4][2];
#pragma unroll
        for (int a = 0; a < 4; ++a)
#pragma unroll
            for (int ks = 0; ks < 2; ++ks) qa[a][ks] = ldfrag(buf0, 16 * a + fr, 32 * ks + 8 * fq);
        f32x4 O[4][4]; float m[4][4], ls[4][4];
        const float sink = p.attn_sink[l * NH + h];
#pragma unroll
        for (int a = 0; a < 4; ++a)
#pragma unroll
            for (int j = 0; j < 4; ++j) { m[a][j] = sink * 1.44269504089f; ls[a][j] = 1.0f; O[a][j] = (f32x4){0.f, 0.f, 0.f, 0.f}; }
        const int tlo = isctx ? 0 : (qb >= 2 ? -2 : -qb), thi = isctx ? -1 : (qb + 2 < NQB ? 2 : NQB - 1 - qb); const int nl = thi - tlo + 1, nst = nl + NCB;
#define ATT_SRC(st_, kp, kgs, vp, mt) do { if ((st_) < nl) { const int tt = tlo + (st_); const int krow0 = TC + b * SEQ + qb * 64 + 64 * tt; kp = p.kr + (size_t)krow0 * (QW / 2) + kvh * HDIM; kgs = QW / 2; \
            vp = p.qr + (size_t)(kvh * HDIM) * T + krow0; mt = tt == -2 ? 1 : (tt == 2 ? 2 : 0); } else { const int krow0 = b * LCTX + ((st_) - nl) * 64; kp = p.pj + (size_t)krow0 * INW + K_OFF + kvh * HDIM; kgs = INW; \
            vp = p.qr + (size_t)(kvh * HDIM) * T + krow0; mt = 0; } } while (0)
        u32x4 kpre[8], vpre[8]; int mtype = 0;
        { const bf16* kp; const bf16* vp; size_t kgs; ATT_SRC(0, kp, kgs, vp, mtype); stage_tile_ld(kpre, kp, kgs, lane); stage_tile_ld(vpre, vp, T, lane); }
#pragma unroll 1
        for (int st = 0; st < nst; ++st) {
            const int mcur = mtype; const int sn = st + 1 < nst ? st + 1 : st;
            const bf16* kpn; const bf16* vpn; size_t kgn; ATT_SRC(sn, kpn, kgn, vpn, mtype);
            WAVE_LDS_FENCE();
            stage_tile_st(buf0, kpre, lane); stage_tile_st(buf1, vpre, lane);
            WAVE_LDS_FENCE();
            f32x4 S[4][4];
#pragma unroll
            for (int bb = 0; bb < 4; ++bb) { const bf16x8 kb0 = ldfrag(buf0, 16 * bb + fr, 8 * fq), kb1 = ldfrag(buf0, 16 * bb + fr, 32 + 8 * fq);
#pragma unroll
                for (int a = 0; a < 4; ++a) S[a][bb] = __builtin_amdgcn_mfma_f32_16x16x32_bf16(qa[a][0], kb0, (f32x4){0.f, 0.f, 0.f, 0.f}, 0, 0, 0);
#pragma unroll
                for (int a = 0; a < 4; ++a) S[a][bb] = __builtin_amdgcn_mfma_f32_16x16x32_bf16(qa[a][1], kb1, S[a][bb], 0, 0, 0); }
#pragma unroll
            for (int a = 0; a < 4; ++a)
#pragma unroll
                for (int bb = 0; bb < 4; ++bb) S[a][bb] = S[a][bb] * (0.125f * 1.44269504089f);
            WAVE_LDS_FENCE();
            int frk = fr, fqk = fq; OPAQUE_V(frk); OPAQUE_V(fqk);
#pragma unroll
            for (int a = 0; a < 4; ++a) {
                float mx[4], al[4], rs[4];
#pragma unroll
                for (int j = 0; j < 4; ++j) {
                    const int i = 16 * a + 4 * fqk + j;
                    mx[j] = -3.0e38f;
                    if (mcur != 0) {
#pragma unroll
                        for (int bb = 0; bb < 4; ++bb) { const int jj = 16 * bb + frk; if ((mcur == 1 && jj < i) || (mcur == 2 && jj > i)) S[a][bb][j] = -1.0e30f; } }
#pragma unroll
                    for (int bb = 0; bb < 4; ++bb) mx[j] = fmaxf(mx[j], S[a][bb][j]);
                }
                row16_max4(mx);
#pragma unroll
                for (int j = 0; j < 4; ++j) {
                    const int i = 16 * a + 4 * fqk + j;
                    const float mn = fmaxf(m[a][j], mx[j]); al[j] = exp2_f(m[a][j] - mn); m[a][j] = mn;
                    rs[j] = 0.f;
#pragma unroll
                    for (int bb = 0; bb < 4; ++bb) { const float pe = exp2_f(S[a][bb][j] - mn); rs[j] += pe; buf0[i * TS + 16 * bb + frk] = (bf16)f2bf(pe); }
                }
                row16_sum4(rs);
#pragma unroll
                for (int j = 0; j < 4; ++j) {
                    ls[a][j] = ls[a][j] * al[j] + rs[j];
#pragma unroll
                    for (int vb = 0; vb < 4; ++vb) O[a][vb][j] *= al[j];
                }
                SCHED_FENCE();
                if (a == 2) stage_tile_ld(kpre, kpn, kgn, lane);
                if (a == 3) stage_tile_ld(vpre, vpn, T, lane);
            }
            WAVE_LDS_FENCE();
#pragma unroll
            for (int ks = 0; ks < 2; ++ks) {
                bf16x8 pa[4], vb[4];
#pragma unroll
                for (int a = 0; a < 4; ++a) { pa[a] = ldfrag(buf0, 16 * a + fr, 32 * ks + 8 * fq); vb[a] = ldfrag(buf1, 16 * a + fr, 32 * ks + 8 * fq); }
#pragma unroll
                for (int a = 0; a < 4; ++a)
#pragma unroll
                    for (int bb = 0; bb < 4; ++bb) O[a][bb] = __builtin_amdgcn_mfma_f32_16x16x32_bf16(pa[a], vb[bb], O[a][bb], 0, 0, 0);
            }
        }
        WAVE_LDS_FENCE();
#pragma unroll
        for (int a = 0; a < 4; ++a)
#pragma unroll
            for (int j = 0; j < 4; ++j) { const float rl = rcp_f(ls[a][j]); const int i = 16 * a + 4 * fq + j;
#pragma unroll
                for (int vb = 0; vb < 4; ++vb) buf0[i * TS + 16 * vb + fr] = (bf16)f2bf(O[a][vb][j] * rl); }
        WAVE_LDS_FENCE();
        { bf16* orow = p.mix + (size_t)qrow0 * D + 2 * QW + h * HDIM;
#pragma unroll 2
          for (int it = 0; it < 8; ++it) { const int rr = it * 8 + (lane >> 3), cc = lane & 7; { const u32x4 sv_ = *(const LAS u32x4*)(buf0 + rr * TS + cc * 8); ST_WT16(orow + (size_t)rr * D + cc * 8, sv_); } } }
    }
}
#undef ATT_SRC

constexpr int FN1 = SEQ / 64;
HD void ph_ftab(const P& p, long gid) {
    if (gid < 2 * 64 * 64) { const int s = (int)(gid / 4096), r = (int)(gid % 4096) / 64, k = (int)(gid % 64); const float a = 2.0f * (float)((r * k) % 64) / 64.0f; p.ft64[gid] = (bf16)f2bf(s == 0 ? cospif(a) : sinpif(a)); }
    else { const long g2 = gid - 2 * 64 * 64; const int s = (int)(g2 / (FN1 * FN1)), r = (int)(g2 % (FN1 * FN1)) / FN1, k = (int)(g2 % FN1); const float a = 2.0f * (float)((r * k) % FN1) / (float)FN1; p.ft128[g2] = (bf16)f2bf(s == 0 ? cospif(a) : sinpif(a)); }
}
constexpr int XS = FN1 + 8;
HD void ph_fftA(const P& p, int l, LAS unsigned char* lds) {
    static_assert(FC == 64 && FN1 % 32 == 0 && FN1 <= 16 * NWV && SEQ == 64 * FN1, "FFT stage A is written for 64 channels per group and SEQ = 64 * 128");
    int tid = threadIdx.x; OPAQUE_V(tid); const int wave = __builtin_amdgcn_readfirstlane(tid >> 6);
    constexpr int NRT = FN1 / 16;
    LAS bf16* xt = (LAS bf16*)lds;
    LAS bf16* w64 = xt + 64 * XS;
    LAS bf16* ul = w64 + 2 * 64 * TS + wave * (2 * 16 * TS);
    static_assert((64 * XS + 2 * 64 * TS + NWV * 2 * 16 * TS) * 2 <= 147456, "FFT stage A LDS");
    __syncthreads();
    { static_assert(2 * 64 * 8 == 2 * NWV * 64, "two table pieces per thread"); u32x4 tv[2];
#pragma unroll
      for (int q = 0; q < 2; ++q) { const int i = tid + q * NWV * 64, r = i >> 3, cc = i & 7; tv[q] = *(const u32x4*)(p.ft64 + r * 64 + cc * 8); }
#pragma unroll
      for (int q = 0; q < 2; ++q) { const int i = tid + q * NWV * 64, r = i >> 3, cc = i & 7; *(LAS u32x4*)(w64 + r * TS + cc * 8) = tv[q]; } }
    constexpr int KST = FN1 / 32;
    bf16x8 wc[KST], wsn[KST];
    {
        const int lane0 = tid & 63, fr0 = lane0 & 15, fq0 = lane0 >> 4;
#pragma unroll
        for (int ks = 0; ks < KST; ++ks) {
            const int row = 16 * (wave % NRT) + fr0, k = 32 * ks + 8 * fq0;

            wc[ks] = *(const bf16x8*)(p.ft128 + row * FN1 + k); wsn[ks] = *(const bf16x8*)(p.ft128 + FN1 * FN1 + row * FN1 + k);
        }
    }
    const int ntask = NB * FG * 64;
    static_assert(FN1 * 8 == 2 * NWV * 64, "two X pieces per thread");
    u32x4 xv[2];
#define FFTA_LD(tk) do { const int n2_ = (tk) % 64, g_ = ((tk) / 64) % FG, b_ = (tk) / (64 * FG); _Pragma("unroll") for (int q_ = 0; q_ < 2; ++q_) { const int i_ = tid + q_ * NWV * 64, n1_ = i_ % FN1, cc_ = i_ / FN1; \
        xv[q_] = *(const u32x4*)(p.pj + (size_t)(TC + b_ * SEQ + n1_ * 64 + n2_) * INW + A_OFF + g_ * FC + cc_ * 8); } } while (0)
    if ((int)blockIdx.x < ntask) FFTA_LD((int)blockIdx.x);
    for (int task = blockIdx.x; task < ntask; task += gridDim.x) {
        int lane = tid & 63; OPAQUE_V(lane);
        const int fr = lane & 15, fq = lane >> 4;
        __syncthreads();
        const int n2 = task % 64, g = (task / 64) % FG, b = task / (64 * FG);
#pragma unroll
        for (int q = 0; q < 2; ++q) { const int i = tid + q * NWV * 64, n1 = i % FN1, cc = i / FN1; const u32x4 v = xv[q];
#pragma unroll
            for (int e = 0; e < 4; ++e) { xt[(cc * 8 + 2 * e) * XS + n1] = (bf16)(v[e] & 0xffffu); xt[(cc * 8 + 2 * e + 1) * XS + n1] = (bf16)(v[e] >> 16); } }
        if (task + (int)gridDim.x < ntask) FFTA_LD(task + (int)gridDim.x);
        __syncthreads();
        if (wave < NRT) {
            f32x4 Uc[4], Us[4];
#pragma unroll
            for (int ct = 0; ct < 4; ++ct) { Uc[ct] = (f32x4){0.f, 0.f, 0.f, 0.f}; Us[ct] = (f32x4){0.f, 0.f, 0.f, 0.f}; }
#pragma unroll
            for (int ks = 0; ks < KST; ++ks)
#pragma unroll
                for (int ct = 0; ct < 4; ++ct) { const bf16x8 xb = *(const LAS bf16x8*)(xt + (16 * ct + fr) * XS + 32 * ks + 8 * fq);
                    Uc[ct] = __builtin_amdgcn_mfma_f32_16x16x32_bf16(wc[ks], xb, Uc[ct], 0, 0, 0); Us[ct] = __builtin_amdgcn_mfma_f32_16x16x32_bf16(wsn[ks], xb, Us[ct], 0, 0, 0); }
            WAVE_LDS_FENCE();
#pragma unroll
            for (int ct = 0; ct < 4; ++ct)
#pragma unroll
                for (int j = 0; j < 4; ++j) { ul[(4 * fq + j) * TS + 16 * ct + fr] = (bf16)f2bf(Uc[ct][j]); ul[(16 + 4 * fq + j) * TS + 16 * ct + fr] = (bf16)f2bf(Us[ct][j]); }
            WAVE_LDS_FENCE();
            f32x4 T1[4], T2[4], T3[4];
#pragma unroll
            for (int ct = 0; ct < 4; ++ct) { T1[ct] = (f32x4){0.f, 0.f, 0.f, 0.f}; T2[ct] = (f32x4){0.f, 0.f, 0.f, 0.f}; T3[ct] = (f32x4){0.f, 0.f, 0.f, 0.f}; }
#pragma unroll
            for (int ks = 0; ks < 2; ++ks) { const bf16x8 uc = ldfrag(ul, fr, 32 * ks + 8 * fq), us = ldfrag(ul + 16 * TS, fr, 32 * ks + 8 * fq);
#pragma unroll
                for (int ct = 0; ct < 4; ++ct) { const bf16x8 cb = ldfrag(w64, 16 * ct + fr, 32 * ks + 8 * fq), sb = ldfrag(w64 + 64 * TS, 16 * ct + fr, 32 * ks + 8 * fq);
                    T1[ct] = __builtin_amdgcn_mfma_f32_16x16x32_bf16(uc, cb, T1[ct], 0, 0, 0); T2[ct] = __builtin_amdgcn_mfma_f32_16x16x32_bf16(us, sb, T2[ct], 0, 0, 0);
                    T3[ct] = __builtin_amdgcn_mfma_f32_16x16x32_bf16(uc, sb, T3[ct], 0, 0, 0); T3[ct] = __builtin_amdgcn_mfma_f32_16x16x32_bf16(us, cb, T3[ct], 0, 0, 0); } }
            WAVE_LDS_FENCE();
            LAS bf16* ot = ul;
            static_assert(16 * 136 <= 2 * 16 * TS, "FFT stage A output tile fits the per-wave slice");
#pragma unroll
            for (int j = 0; j < 4; ++j) { const int k1 = 16 * wave + 4 * fq + j;
                float cs, sn; sincos_rev((float)((n2 * k1) % SEQ) * (1.0f / (float)SEQ), cs, sn);
#pragma unroll
                for (int ct = 0; ct < 4; ++ct) { const float cre = T1[ct][j] - T2[ct][j], cim = -T3[ct][j];
                    ot[(4 * fq + j) * 136 + 16 * ct + fr] = (bf16)f2bf(cre * cs + cim * sn); ot[(4 * fq + j) * 136 + 64 + 16 * ct + fr] = (bf16)f2bf(cim * cs - cre * sn); } }
            WAVE_LDS_FENCE();
            { bf16* obase = p.ct + ((size_t)((b * FG + g) * 64 + n2) * FN1 + 16 * wave) * 128;
#pragma unroll
              for (int it = 0; it < 4; ++it) { const int rr = it * 4 + (lane >> 4), cc = lane & 15; { const u32x4 sv_ = *(const LAS u32x4*)(ot + rr * 136 + cc * 8); ST_WT16(obase + (size_t)rr * 128 + cc * 8, sv_); } } }
        }
    }
    __syncthreads();
}
#undef FFTA_LD
HD void ph_fftB(const P& p, int l, LAS unsigned char* lds) {
    int tid = threadIdx.x; OPAQUE_V(tid); const int wave = __builtin_amdgcn_readfirstlane(tid >> 6);
    LAS bf16* buf0 = (LAS bf16*)(lds + wave * WAVE_LDS); LAS bf16* buf1 = buf0 + 64 * TS;
    const float scale = 1.0f / sqrtf((float)SEQ * 64.0f);
    const int ntask = NB * FG * FN1;
    int qiter = 0;
    for (;;) {
        int lane = tid & 63; OPAQUE_V(lane);
        const int task = static_task(qiter++, ntask, (int)blockIdx.x * NWV + wave, (int)gridDim.x * NWV); if (task >= ntask) break;
        const int fr = lane & 15, fq = lane >> 4;
        const int k1 = task % FN1, g = (task / FN1) % FG, b = task / (FN1 * FG);
        const bf16* src = p.ct + ((size_t)((b * FG + g) * 64) * FN1 + k1) * 128;
        WAVE_LDS_FENCE();
        { u32x4 rv[8], iv[8]; stage_tile_T_ld(rv, src, (size_t)FN1 * 128, lane); stage_tile_T_ld(iv, src + 64, (size_t)FN1 * 128, lane);
          stage_tile_T_st(buf0, rv, lane, 0.f, 0, 1.0f);
          stage_tile_T_st(buf1, iv, lane, 0.f, 0, 1.0f); }
        WAVE_LDS_FENCE();
        f32x4 Y[4][4];
#pragma unroll
        for (int a = 0; a < 4; ++a)
#pragma unroll
            for (int bb = 0; bb < 4; ++bb) Y[a][bb] = (f32x4){0.f, 0.f, 0.f, 0.f};
#pragma unroll
        for (int ks = 0; ks < 2; ++ks) {
            bf16x8 ca[4], sa[4];
#pragma unroll
            for (int a = 0; a < 4; ++a) { ca[a] = *(const bf16x8*)(p.ft64 + (16 * a + fr) * 64 + 32 * ks + 8 * fq); sa[a] = *(const bf16x8*)(p.ft64 + 4096 + (16 * a + fr) * 64 + 32 * ks + 8 * fq); }
#pragma unroll
            for (int bb = 0; bb < 4; ++bb) { const bf16x8 rb = ldfrag(buf0, 16 * bb + fr, 32 * ks + 8 * fq), ib = ldfrag(buf1, 16 * bb + fr, 32 * ks + 8 * fq);
#pragma unroll
                for (int a = 0; a < 4; ++a) { Y[a][bb] = __builtin_amdgcn_mfma_f32_16x16x32_bf16(ca[a], rb, Y[a][bb], 0, 0, 0); Y[a][bb] = __builtin_amdgcn_mfma_f32_16x16x32_bf16(sa[a], ib, Y[a][bb], 0, 0, 0); } }
        }
        WAVE_LDS_FENCE();
#pragma unroll
        for (int a = 0; a < 4; ++a)
#pragma unroll
            for (int bb = 0; bb < 4; ++bb)
#pragma unroll
                for (int j = 0; j < 4; ++j) buf0[(16 * a + 4 * fq + j) * TS + 16 * bb + fr] = (bf16)f2bf(Y[a][bb][j] * scale);
        WAVE_LDS_FENCE();
        { bf16* orow = p.mix + (size_t)(TC + b * SEQ + k1) * D + g * FC;
#pragma unroll 2
          for (int it = 0; it < 8; ++it) { const int k2 = it * 8 + (lane >> 3), cc = lane & 7; { const u32x4 sv_ = *(const LAS u32x4*)(buf0 + k2 * TS + cc * 8); ST_WT16(orow + (size_t)k2 * FN1 * D + cc * 8, sv_); } } }
    }
}

template <int HW> HD void pool_frags(bf16x8 (&pa)[4][2], const LAS bf16* hb, int fr, int fq, int n0, int N) {
#pragma unroll
    for (int a = 0; a < 4; ++a) { const int i = 16 * a + fr, n = n0 + i; int lo = n - HW; if (lo < 0) lo = 0; int hi = n + HW; if (hi > N) hi = N; const float rc = rcp_f((float)(hi - lo));
#pragma unroll
        for (int ks = 0; ks < 2; ++ks) {
            float s[8];
#pragma unroll
            for (int e = 0; e < 8; ++e) s[e] = 0.f;
#pragma unroll
            for (int d = 0; d < 2 * HW; ++d) { const u32x4 v = *(const LAS u32x4*)(hb + (i + 8 - HW + d) * TS + 32 * ks + 8 * fq);
#pragma unroll
                for (int e = 0; e < 4; ++e) { s[2 * e] += bf2f((bf16)(v[e] & 0xffffu)); s[2 * e + 1] += bf2f((bf16)(v[e] >> 16)); } }
            const u32x4 sv = *(const LAS u32x4*)(hb + (i + 8) * TS + 32 * ks + 8 * fq);
            u32x4 o;
#pragma unroll
            for (int e = 0; e < 4; ++e) o[e] = pk2f(s[2 * e] * rc - bf2f((bf16)(sv[e] & 0xffffu)), s[2 * e + 1] * rc - bf2f((bf16)(sv[e] >> 16)));
            pa[a][ks] = __builtin_bit_cast(bf16x8, o);
        } }
}

HD void ph_pool_wave(const P& p, int l, LAS unsigned char* lds, bool with_ctx) {
    static_assert(PGW == 64 && LCTX % 64 == 0 && SEQ % 64 == 0 && 80 * TS * 2 <= WAVE_LDS, "pool wave kernel is written for 64-wide groups");
    int tid = threadIdx.x; OPAQUE_V(tid); const int wave = __builtin_amdgcn_readfirstlane(tid >> 6);
    LAS bf16* hb = (LAS bf16*)(lds + wave * WAVE_LDS);
    const int rb0 = with_ctx ? 0 : TC / 64; const int ntask = (T / 64 - rb0) * 4;
    int qiter = 0;
    for (;;) {
        int lane = tid & 63; OPAQUE_V(lane);
        const int task = static_task(qiter++, ntask, (int)blockIdx.x * NWV + wave, (int)gridDim.x * NWV); if (task >= ntask) break;
        const int fr = lane & 15, fq = lane >> 4;
        const int g = 3 - task / (T / 64 - rb0), rb = rb0 + task % (T / 64 - rb0);
        const int r0 = rb * 64; const int hw = 1 << g;
        int n0, N, t0; row_seq(r0, n0, N, t0);
        WAVE_LDS_FENCE();
        { u32x4 hv[10];
#pragma unroll
          for (int it = 0; it < 10; ++it) { const int rr = it * 8 + (lane >> 3), cc = lane & 7; const int n = n0 - 8 + rr;
              const u32x4 z = {0u, 0u, 0u, 0u}; hv[it] = z; if (n >= 0 && n < N) hv[it] = *(const u32x4*)(p.pj + (size_t)(t0 + n) * INW + B_OFF + g * PGW + cc * 8); }
#pragma unroll
          for (int it = 0; it < 10; ++it) { const int rr = it * 8 + (lane >> 3), cc = lane & 7; *(LAS u32x4*)(hb + rr * TS + cc * 8) = hv[it]; } }
        WAVE_LDS_FENCE();
        bf16x8 pa[4][2];
        switch (g) { case 0: pool_frags<1>(pa, hb, fr, fq, n0, N); break; case 1: pool_frags<2>(pa, hb, fr, fq, n0, N); break; case 2: pool_frags<4>(pa, hb, fr, fq, n0, N); break; default: pool_frags<8>(pa, hb, fr, fq, n0, N); break; }
        f32x4 Y[4][4];
#pragma unroll
        for (int a = 0; a < 4; ++a)
#pragma unroll
            for (int dt = 0; dt < 4; ++dt) Y[a][dt] = (f32x4){0.f, 0.f, 0.f, 0.f};
        const bf16* wt = p.pwt + (size_t)(l * 4 + g) * PGW * PGW;
#pragma unroll
        for (int dt = 0; dt < 4; ++dt)
#pragma unroll
            for (int ks = 0; ks < 2; ++ks) { const bf16x8 wb = *(const bf16x8*)(wt + (16 * dt + fr) * PGW + 32 * ks + 8 * fq);
#pragma unroll
                for (int a = 0; a < 4; ++a) Y[a][dt] = __builtin_amdgcn_mfma_f32_16x16x32_bf16(pa[a][ks], wb, Y[a][dt], 0, 0, 0); }
        WAVE_LDS_FENCE();
#pragma unroll
        for (int dt = 0; dt < 4; ++dt) { const float sc = p.pool_scale[(size_t)l * QW + g * PGW + 16 * dt + fr];
#pragma unroll
            for (int a = 0; a < 4; ++a)
#pragma unroll
                for (int j = 0; j < 4; ++j) hb[(16 * a + 4 * fq + j) * TS + 16 * dt + fr] = (bf16)f2bf(Y[a][dt][j] * sc); }
        WAVE_LDS_FENCE();
        { bf16* orow = p.mix + (size_t)r0 * D + QW + g * PGW;
#pragma unroll 2
          for (int it = 0; it < 8; ++it) { const int rr = it * 8 + (lane >> 3), cc = lane & 7; { const u32x4 sv_ = *(const LAS u32x4*)(hb + rr * TS + cc * 8); ST_WT16(orow + (size_t)rr * D + cc * 8, sv_); } } }
    }
}
#ifndef CPU_TEST
namespace pg8 {
#define PG8_LAS __attribute__((address_space(3)))
typedef unsigned short bf16_t;
typedef short bf16x8 __attribute__((ext_vector_type(8)));
typedef float f32x4 __attribute__((ext_vector_type(4)));
typedef unsigned u32x4 __attribute__((ext_vector_type(4)));
constexpr int BM = 256, BK = 64, HALF = 128, HTB = HALF * BK * 2  , STAGE_BYTES = 8 * HTB, NXCD = 8, WGM = 8;

__host__ __device__ __forceinline__ int lds_byte(int r, int c) { const int st = (r >> 4) * 2 + (c >> 5), rr = r & 15, cc = c & 31, ob = rr * 64 + cc * 2; return st * 1024 + (ob ^ (((ob >> 9) & 1) << 5)); }
__host__ __device__ __forceinline__ void stage_rc(int b, int& R, int& C) { const int st = b / 1024, sb = b % 1024, swz = sb ^ (((sb >> 9) & 1) << 5); R = (st >> 1) * 16 + swz / 64; C = (st & 1) * 32 + (swz % 64) / 2; }
__host__ __device__ __forceinline__ int perm32(int rho) { const int n = rho >> 4, i = rho & 15; return 8 * (i >> 2) + 4 * n + (i & 3); }
__host__ __device__ __forceinline__ int perm32sw(int rho) { const int n = rho >> 4, i = rho & 15; return 8 * (i >> 2) + 2 * (i & 3) + n; }

struct Unit { int pm, pn, idx; };
struct Gemm { const bf16_t* A; const bf16_t* Bt; int M, N, K; const int* rowtok; };

struct StaticOrder {
    int nM, nN, nwg, G, c;
    __host__ __device__ void init(int M, int N, int G_, int c_) { nM = M / BM; nN = N / BM; nwg = nM * nN; G = G_; c = c_; }
    __host__ __device__ bool next(int i, Unit& u) const {
        const long L = (long)i * G + c; if (L >= nwg) return false;
        int wgid = (int)L; { const int q = nwg / NXCD, r = nwg % NXCD, xcd = wgid % NXCD, off = wgid / NXCD; wgid = (xcd < r ? xcd * (q + 1) : r * (q + 1) + (xcd - r) * q) + off; }
        const int nig = WGM * nN, gid = wgid / nig, fm = gid * WGM, gsz = (nM - fm) < WGM ? (nM - fm) : WGM;
        u.pm = fm + ((wgid % nig) % gsz); u.pn = (wgid % nig) / gsz; u.idx = i; return true;
    }
    __device__ __forceinline__ void a_ready(const Unit&) const {}
    __device__ __forceinline__ void done(const Unit&) const {}
};

__device__ __forceinline__ unsigned cvt_pk_bf16(float lo, float hi) { unsigned r; asm volatile("v_cvt_pk_bf16_f32 %0, %1, %2" : "=v"(r) : "v"(lo), "v"(hi)); return r; }
typedef float f32x2 __attribute__((ext_vector_type(2)));
__device__ __forceinline__ f32x2 gelu_pk(f32x2 v) {
    const f32x2 av = __builtin_elementwise_abs(v), d = av * 0.2316418882f + 1.0f;
    f32x2 t; t.x = __builtin_amdgcn_rcpf(d.x); t.y = __builtin_amdgcn_rcpf(d.y);
    f32x2 q = t * 0.5307027145f + (-0.7265760135f); q = q * t + 0.7107068705f; q = q * t + (-0.142248368f); q = q * t + 0.127414796f; q = q * t;
    const f32x2 s = (v * v) * (-0.72134752044f);
    f32x2 e; e.x = __builtin_amdgcn_exp2f(s.x); e.y = __builtin_amdgcn_exp2f(s.y);
    const f32x2 m = v * (q * e), r = v - m;
    f32x2 o; o.x = v.x < 0.f ? m.x : r.x; o.y = v.y < 0.f ? m.y : r.y; return o;
}

template <int ACT  > struct EpiBf16 {
    static constexpr bool PERM = true, AFTER_DRAIN = false; __device__ __forceinline__ static int perm(int rho) { return perm32(rho); } static_assert(ACT == 0 || ACT == 1, "EpiBf16: ACT is 0 (none) or 1 (gelu_pk)");
    bf16_t* O; int ldc; const float* bias; int split_cols; size_t split_stride; float scale0;
    __device__ __forceinline__ void operator()(const f32x4 (&acc)[2][2][4][2], const Unit& u, int wr, int wc, int fr, int fq) const {
        const int row0 = u.pm * BM + wr * 64 + fr; int colt = u.pn * BM; bf16_t* base = O;
        float sc = 1.f; if (split_cols) { const int t = colt / split_cols; base += (size_t)t * split_stride; colt -= t * split_cols; if (t == 0) sc = scale0; }
        const int col0 = colt + wc * 32 + 8 * fq, bcol0 = u.pn * BM + wc * 32 + 8 * fq;
        f32x4 bv[2][2];
#pragma unroll
        for (int bj = 0; bj < 2; ++bj)
#pragma unroll
            for (int n = 0; n < 2; ++n) bv[bj][n] = bias ? *(const f32x4*)(bias + bcol0 + bj * HALF + 4 * n) : (f32x4){0.f, 0.f, 0.f, 0.f};
#pragma unroll
        for (int ai = 0; ai < 2; ++ai)
#pragma unroll
            for (int m = 0; m < 4; ++m) { bf16_t* rowp = base + (size_t)(row0 + ai * HALF + m * 16) * ldc + col0;
#pragma unroll
                for (int bj = 0; bj < 2; ++bj) { f32x4 v0 = acc[ai][bj][m][0] + bv[bj][0], v1 = acc[ai][bj][m][1] + bv[bj][1];
                    if (ACT == 1) { f32x2 a = gelu_pk((f32x2){v0[0], v0[1]}), b = gelu_pk((f32x2){v0[2], v0[3]}), c = gelu_pk((f32x2){v1[0], v1[1]}), d = gelu_pk((f32x2){v1[2], v1[3]});
                        v0 = (f32x4){a.x, a.y, b.x, b.y}; v1 = (f32x4){c.x, c.y, d.x, d.y}; }
                    v0 = v0 * sc; v1 = v1 * sc; u32x4 w; w.x = cvt_pk_bf16(v0[0], v0[1]); w.y = cvt_pk_bf16(v0[2], v0[3]); w.z = cvt_pk_bf16(v1[0], v1[1]); w.w = cvt_pk_bf16(v1[2], v1[3]);
                    *(u32x4*)(rowp + bj * HALF) = w; } }
    }
};
template <bool HAS_BIAS> struct EpiOut {
    static constexpr bool PERM = true, AFTER_DRAIN = false; __device__ __forceinline__ static int perm(int rho) { return perm32(rho); }
    bf16_t* O; int ldc; const float* bias; int split_cols; size_t split_stride; float scale; PG8_LAS unsigned char* stg;
    __device__ __forceinline__ void operator()(const f32x4 (&acc)[2][2][4][2], const Unit& u, int wr, int wc, int fr, int fq) const {
        static_assert(!HAS_BIAS, "dense GEMMs of this kernel carry no bias");
        const int tid = (wr * 4 + wc) * 64 + fq * 16 + fr;
        const unsigned wo = (unsigned)((wr * 32 + fr) * 256 + (((wc * 4 + fq) ^ fr) * 16));
        const int rr = tid >> 4;
        const unsigned ro = (unsigned)(rr * 256 + (((tid & 15) ^ (rr & 15)) * 16));
        bf16_t* gp = O + (size_t)(u.pm * BM + (rr & 31)) * ldc + u.pn * BM + (tid & 15) * 8;
#pragma unroll
        for (int bj = 0; bj < 2; ++bj)
#pragma unroll
            for (int ai = 0; ai < 2; ++ai)
#pragma unroll
                for (int mp = 0; mp < 2; ++mp) {
#pragma unroll
                    for (int mm = 0; mm < 2; ++mm) { const int m = 2 * mp + mm; const f32x4 v0 = acc[ai][bj][m][0] * scale, v1 = acc[ai][bj][m][1] * scale;
                        u32x4 w; w.x = cvt_pk_bf16(v0[0], v0[1]); w.y = cvt_pk_bf16(v0[2], v0[3]); w.z = cvt_pk_bf16(v1[0], v1[1]); w.w = cvt_pk_bf16(v1[2], v1[3]);
                        *(PG8_LAS u32x4*)(stg + wo + mm * 16 * 256) = w; }
                    __builtin_amdgcn_s_waitcnt(0xc07f); __builtin_amdgcn_s_barrier();
                    const u32x4 x0 = *(const PG8_LAS u32x4*)(stg + ro), x1 = *(const PG8_LAS u32x4*)(stg + ro + 32 * 256);
                    { bf16_t* q0 = gp + (size_t)(ai * HALF + 32 * mp) * ldc + bj * HALF; bf16_t* q1 = q0 + (size_t)64 * ldc;
                      asm volatile("global_store_dwordx4 %0, %1, off sc1\n\ts_nop 1" :: "v"(q0), "v"(x0) : "memory"); asm volatile("global_store_dwordx4 %0, %1, off sc1\n\ts_nop 1" :: "v"(q1), "v"(x1) : "memory"); }
                    if (!(bj == 1 && ai == 1 && mp == 1)) { __builtin_amdgcn_s_waitcnt(0xc07f); __builtin_amdgcn_s_barrier(); }
                }
    }
};
template <bool HAS_BIAS> struct EpiOut8 {
    static constexpr bool PERM = true, AFTER_DRAIN = false; __device__ __forceinline__ static int perm(int rho) { return perm32(rho); }
    unsigned char* O; int ldc; const PG8_LAS float* lbias; int split_cols; float scale; PG8_LAS unsigned char* stg;
    __device__ __forceinline__ void operator()(const f32x4 (&acc)[2][2][4][2], const Unit& u, int wr, int wc, int fr, int fq) const {
        int colt = u.pn * BM; if (split_cols) colt %= split_cols;
        const int tid = (wr * 4 + wc) * 64 + fq * 16 + fr;
        const unsigned wo = (unsigned)((wr * 64 + fr) * 128 + (((wc * 2 + (fq >> 1)) ^ (fr & 7)) * 16) + 8 * (fq & 1));
        const unsigned ro = (unsigned)((tid >> 3) * 128 + (((tid & 7) ^ ((tid >> 3) & 7)) * 16));
        const unsigned go = (unsigned)(u.pm * BM + (tid >> 3)) * (unsigned)ldc + (unsigned)(colt + (tid & 7) * 16);
#pragma unroll
        for (int bj = 0; bj < 2; ++bj) {
            f32x4 b0 = (f32x4){0.f, 0.f, 0.f, 0.f}, b1 = b0;
            if (HAS_BIAS) { const PG8_LAS float* lb_ = lbias + u.idx * BM + wc * 32 + 8 * fq + bj * HALF; b0 = *(const PG8_LAS f32x4*)lb_; b1 = *(const PG8_LAS f32x4*)(lb_ + 4); }
#pragma unroll
            for (int ai = 0; ai < 2; ++ai) {
#pragma unroll
                for (int m = 0; m < 4; ++m) { const f32x4 v0 = acc[ai][bj][m][0] * scale + b0, v1 = acc[ai][bj][m][1] * scale + b1;
                    typedef unsigned u32x2_t __attribute__((ext_vector_type(2))); u32x2_t w; w.x = pk4_fp8(v0[0], v0[1], v0[2], v0[3]); w.y = pk4_fp8(v1[0], v1[1], v1[2], v1[3]);
                    *(PG8_LAS u32x2_t*)(stg + wo + m * 16 * 128) = w; }
                __builtin_amdgcn_s_waitcnt(0xc07f); __builtin_amdgcn_s_barrier();
                const u32x4 x0 = *(const PG8_LAS u32x4*)(stg + ro), x1 = *(const PG8_LAS u32x4*)(stg + ro + 64 * 128);
                { unsigned char* q0 = O + (go + (unsigned)(ai * HALF * ldc + bj * HALF)); unsigned char* q1 = O + (go + (unsigned)((ai * HALF + 64) * ldc + bj * HALF));
                  asm volatile("global_store_dwordx4 %0, %1, off sc1\n\ts_nop 1" :: "v"(q0), "v"(x0) : "memory"); asm volatile("global_store_dwordx4 %0, %1, off sc1\n\ts_nop 1" :: "v"(q1), "v"(x1) : "memory"); }
                if (!(bj == 1 && ai == 1)) { __builtin_amdgcn_s_waitcnt(0xc07f); __builtin_amdgcn_s_barrier(); }
            }
        }
    }
};
struct EpiSwiglu {
    static constexpr bool PERM = true, AFTER_DRAIN = false; __device__ __forceinline__ static int perm(int rho) { return perm32(rho); }
    bf16_t* O; int ldc; const float* bias; int ncols;
    __device__ __forceinline__ static float sw(float g, float l, float lim, float alpha) {
        g = fminf(g, lim); l = fminf(fmaxf(l, -lim), lim); return g * __builtin_amdgcn_rcpf(1.0f + __expf(-alpha * g)) * (l + 1.0f); }
    __device__ __forceinline__ void operator()(const f32x4 (&acc)[2][2][4][2], const Unit& u, int wr, int wc, int fr, int fq) const {
        const int row0 = u.pm * BM + wr * 64 + fr; const int bcol0 = u.pn * BM + wc * 32 + 8 * fq; const int col0 = (u.pn * BM) % ncols + wc * 32 + 8 * fq;
        bf16_t* p0 = O + (size_t)row0 * ldc + (col0 >> 1);
#pragma unroll
        for (int bj = 0; bj < 2; ++bj) {
            const f32x4 b0 = *(const f32x4*)(bias + bcol0 + bj * HALF), b1 = *(const f32x4*)(bias + bcol0 + bj * HALF + 4);
#pragma unroll
            for (int ai = 0; ai < 2; ++ai)
#pragma unroll
                for (int m = 0; m < 4; ++m) { const f32x4 v0 = acc[ai][bj][m][0] + b0, v1 = acc[ai][bj][m][1] + b1;
                    const float a0 = sw(v0[0], v0[1], 7.0f, 1.702f), a1 = sw(v0[2], v0[3], 7.0f, 1.702f), a2 = sw(v1[0], v1[1], 7.0f, 1.702f), a3 = sw(v1[2], v1[3], 7.0f, 1.702f);
                    uint2 w; w.x = cvt_pk_bf16(a0, a1); w.y = cvt_pk_bf16(a2, a3);
                    *(uint2*)(p0 + (size_t)(ai * HALF + m * 16) * ldc + bj * (HALF / 2)) = w; }
        }
    }
};
struct EpiSwiglu8 {
    static constexpr bool PERM = true, AFTER_DRAIN = false; __device__ __forceinline__ static int perm(int rho) { return perm32sw(rho); }
    unsigned char* O; int ldc; const PG8_LAS bf16_t* lbias; int ncols; float scale; PG8_LAS unsigned char* stg;
    __device__ __forceinline__ void operator()(const f32x4 (&acc)[2][2][4][2], const Unit& u, int wr, int wc, int fr, int fq) const {
        const int tid = (wr * 4 + wc) * 64 + fq * 16 + fr;
        const unsigned wo = (unsigned)((wr * 64 + fr) * 64 + ((wc ^ ((fr >> 1) & 3)) * 16) + 4 * fq);
        const unsigned ro = (unsigned)((tid >> 2) * 64 + (((tid & 3) ^ ((tid >> 3) & 3)) * 16));
        const unsigned go = (unsigned)(u.pm * BM + (tid >> 2)) * (unsigned)ldc + (unsigned)(((u.pn * BM) % ncols) / 2 + (tid & 3) * 16);
#pragma unroll
        for (int bj = 0; bj < 2; ++bj) {
            const u32x4 bw = *(const PG8_LAS u32x4*)(lbias + u.idx * BM + wc * 32 + 8 * fq + bj * HALF);
            f32x4 bg, bl;
#pragma unroll
            for (int e = 0; e < 4; ++e) { bg[e] = __builtin_bit_cast(float, bw[e] << 16); bl[e] = __builtin_bit_cast(float, bw[e] & 0xffff0000u); }
#pragma unroll
            for (int ai = 0; ai < 2; ++ai)
#pragma unroll
                for (int m = 0; m < 4; ++m) { f32x4 g = acc[ai][bj][m][0] * scale + bg, l = acc[ai][bj][m][1] * scale + bl, t, r;
#pragma unroll
                    for (int e = 0; e < 4; ++e) { g[e] = fminf(g[e], 7.0f); l[e] = __builtin_amdgcn_fmed3f(l[e], -7.0f, 7.0f); }
                    t = g * (-1.702f * 1.44269504089f);
#pragma unroll
                    for (int e = 0; e < 4; ++e) t[e] = __builtin_amdgcn_exp2f(t[e]);
                    t = t + 1.0f;
#pragma unroll
                    for (int e = 0; e < 4; ++e) r[e] = __builtin_amdgcn_rcpf(t[e]);
                    const f32x4 a = (g * r) * (l + 1.0f);
                    *(PG8_LAS unsigned*)(stg + wo + (ai * HALF + m * 16) * 64) = pk4_fp8(a[0], a[1], a[2], a[3]); }
            __builtin_amdgcn_s_waitcnt(0xc07f); __builtin_amdgcn_s_barrier();
            const u32x4 v0 = *(const PG8_LAS u32x4*)(stg + ro), v1 = *(const PG8_LAS u32x4*)(stg + ro + 128 * 64);
            { unsigned char* q0 = O + (go + (unsigned)(bj * 64)); unsigned char* q1 = O + (go + (unsigned)(128 * ldc + bj * 64));
              asm volatile("global_store_dwordx4 %0, %1, off sc1\n\ts_nop 1" :: "v"(q0), "v"(v0) : "memory"); asm volatile("global_store_dwordx4 %0, %1, off sc1\n\ts_nop 1" :: "v"(q1), "v"(v1) : "memory"); }
            if (bj == 0) { __builtin_amdgcn_s_waitcnt(0xc07f); __builtin_amdgcn_s_barrier(); }
        }
    }
};
struct MoeOrder {
    int nN, total, G, c, evec;
    __device__ __forceinline__ int rb_of(int i, int& tn) const {
        if (G % 8 != 0) { const int L = i * G + c; tn = L % nN; return L / nN; }
        const int x = c % 8, q = c / 8, per = G / 8; const int U = i * per + q; tn = U % nN; return (U / nN) * 8 + x; }
    __device__ __forceinline__ void init(const int* blke, int nblk, int nN_, int G_, int c_) { nN = nN_; total = nblk * nN_; G = G_; c = c_;
        const int lane = (int)__builtin_amdgcn_mbcnt_hi(~0u, __builtin_amdgcn_mbcnt_lo(~0u, 0u)); int tn; const int rb = rb_of(lane, tn); evec = rb * nN < total ? blke[rb] : 0; }
    __device__ __forceinline__ bool next(int i, Unit& u) const {
        int tn; const int rb = rb_of(i, tn); if (rb * nN >= total || i >= 64) return false;
        u.pm = rb; u.pn = __builtin_amdgcn_readlane(evec, i) * nN + tn; u.idx = i; return true;
    }
    __device__ __forceinline__ void a_ready(const Unit&) const {}
    __device__ __forceinline__ void done(const Unit&) const {}
};
template <class Epi, class Sched, bool ALIGN_EPI = false, bool SP2 = false, bool GATHER = false, bool FP8 = false>
__device__ __forceinline__ void gemm_phase(PG8_LAS unsigned char* lds, const Gemm g, const Sched& S, const Epi& E) {
    int tid_ = threadIdx.x; asm volatile("" : "+v"(tid_));
    const int tid = tid_, wid = __builtin_amdgcn_readfirstlane(tid >> 6), lane = tid & 63, wr = wid >> 2, wc = wid & 3, fr = lane & 15, fq = lane >> 4;
    const int K = g.K, nt = K / BK;
    unsigned voffA[2], voffB[2]; int gR[2], gC[2];
#pragma unroll
    for (int i = 0; i < 2; ++i) { int R, C; stage_rc(tid * 16 + i * 8192, R, C); const int Rb = Epi::PERM ? ((R & ~31) + Epi::perm(R & 31)) : R;
        voffA[i] = (unsigned)(R * K + C) * 2u; voffB[i] = (unsigned)(Rb * K + C) * 2u; gR[i] = R & 15; gC[i] = C; }
    static_assert(!GATHER || SP2, "the gathered A operand is wired into the SP2 loop only");
    unsigned gc[2][2], gn[2][2]; typedef int i32x16 __attribute__((ext_vector_type(16)));
#define PG8_LOADOFF(o, PM) do { _Pragma("unroll") for (int _h = 0; _h < 2; ++_h) _Pragma("unroll") for (int _i = 0; _i < 2; ++_i) { \
        const int* _tb = g.rowtok + (size_t)(PM) * BM + _h * HALF + 16 * ((wid + 8 * _i) >> 1); int _tok = 0; i32x16 _t; \
        asm volatile("s_load_dwordx16 %0, %1, 0x0\n\ts_waitcnt lgkmcnt(0)" : "=s"(_t) : "s"(_tb) : "memory");     \
        _Pragma("unroll") for (int _k = 0; _k < 16; ++_k) _tok = (gR[_i] == _k) ? _t[_k] : _tok; \
        o[_h][_i] = (unsigned)(_tok * K + gC[_i]) * 2u; } } while (0)
#define PG8_STAGE_A(bufoff, ptr, H, NXT, kbytes) do { if constexpr (GATHER) { if (NXT) PG8_STAGE_G(bufoff, (const char*)g.A + (kbytes), gn[H]); else PG8_STAGE_G(bufoff, (const char*)g.A + (kbytes), gc[H]); } \
        else PG8_STAGE(bufoff, ptr, voffA); } while (0)
    const size_t kstep = (size_t)(BK * 2);
    const size_t rstep64 = (size_t)64 * K * 2;
    const size_t hstep = (size_t)HALF * K * 2;
    const size_t tstep = 2 * hstep;
    const unsigned ldsw = (unsigned)wid * 1024u;
    const int aoff = lds_byte(wr * 64 + fr, fq * 8), boff = lds_byte(wc * 32 + fr, fq * 8);
    const int aoff0 = aoff, aoff1 = aoff + 1024;
    const int boff0 = boff, boff1 = boff + 1024;
    typedef int i32x4_t __attribute__((ext_vector_type(4))); typedef int i32x8_t __attribute__((ext_vector_type(8)));
    const PG8_LAS unsigned char* ldsA = lds + aoff0; const PG8_LAS unsigned char* ldsB = lds + 4 * HTB + boff0;
#define PG8_SA(b, h) (((b) * 2 + (h)) * HTB)
#define PG8_SB(b, h) ((4 + (b) * 2 + (h)) * HTB)
#define PG8_STAGE(bufoff, gbase, voff) do { _Pragma("unroll") for (int _i = 0; _i < 2; ++_i) \
        __builtin_amdgcn_global_load_lds((const unsigned*)((const char*)(gbase) + (size_t)_i * rstep64 + (voff)[0]), (PG8_LAS unsigned*)(lds + (bufoff) + ldsw + _i * 8192), 16, 0, 0); } while (0)
#define PG8_STAGE_G(bufoff, gbase, voff) do { _Pragma("unroll") for (int _i = 0; _i < 2; ++_i) \
        __builtin_amdgcn_global_load_lds((const unsigned*)((const char*)(gbase) + (voff)[_i]), (PG8_LAS unsigned*)(lds + (bufoff) + ldsw + _i * 8192), 16, 0, 0); } while (0)
#define PG8_LDA(dst, b, h) do { _Pragma("unroll") for (int m = 0; m < 4; ++m) _Pragma("unroll") for (int k = 0; k < 2; ++k) dst[m][k] = *(const PG8_LAS bf16x8*)(ldsA + (PG8_SA(b, h) + (k ? aoff1 - aoff0 : 0) + m * 2048)); } while (0)
#define PG8_LDB(dst, b, h) do { _Pragma("unroll") for (int n = 0; n < 2; ++n) _Pragma("unroll") for (int k = 0; k < 2; ++k) dst[n][k] = *(const PG8_LAS bf16x8*)(ldsB + (PG8_SB(b, h) - 4 * HTB + (k ? boff1 - boff0 : 0) + n * 2048)); } while (0)
#define PG8_CAT8(x) __builtin_shufflevector(__builtin_bit_cast(i32x4_t, (x)[0]), __builtin_bit_cast(i32x4_t, (x)[1]), 0, 1, 2, 3, 4, 5, 6, 7)
#define PG8_MMA(ai, bj, At, Bt) do { __builtin_amdgcn_s_setprio(1); if constexpr (FP8) { _Pragma("unroll") for (int m = 0; m < 4; ++m) _Pragma("unroll") for (int n = 0; n < 2; ++n) \
        acc[ai][bj][m][n] = __builtin_amdgcn_mfma_scale_f32_16x16x128_f8f6f4(PG8_CAT8(Bt[n]), PG8_CAT8(At[m]), acc[ai][bj][m][n], 0, 0, 0, 127, 0, 127); } else { \
        _Pragma("unroll") for (int m = 0; m < 4; ++m) _Pragma("unroll") for (int n = 0; n < 2; ++n) _Pragma("unroll") for (int k = 0; k < 2; ++k) \
        acc[ai][bj][m][n] = __builtin_amdgcn_mfma_f32_16x16x32_bf16(Bt[n][k], At[m][k], acc[ai][bj][m][n], 0, 0, 0); } __builtin_amdgcn_s_setprio(0); } while (0)
#define PG8_WAIT_V(n) asm volatile("s_waitcnt vmcnt(" #n ")" ::: "memory")
#define PG8_WAIT_L(n) asm volatile("s_waitcnt lgkmcnt(" #n ")" ::: "memory")
#define PG8_BAR __builtin_amdgcn_s_barrier()
#define PG8_SCHED __builtin_amdgcn_sched_barrier(0)
    Unit cur, nxt; int ui = 0;
    if (!S.next(0, cur)) return;
    f32x4 acc[2][2][4][2];
#pragma unroll
    for (int a = 0; a < 2; ++a)
#pragma unroll
        for (int b = 0; b < 2; ++b)
#pragma unroll
            for (int m = 0; m < 4; ++m)
#pragma unroll
                for (int n = 0; n < 2; ++n) acc[a][b][m][n] = (f32x4){0.f, 0.f, 0.f, 0.f};
    bf16x8 At[4][2], B0[2][2], B1[2][2];
    const char* cA = (const char*)g.A + (size_t)cur.pm * tstep; const char* cB = (const char*)g.Bt + (size_t)cur.pn * tstep;
    S.a_ready(cur);
    if constexpr (GATHER) PG8_LOADOFF(gc, cur.pm);
    if constexpr (SP2) {
        PG8_STAGE(PG8_SB(0, 0), cB, voffB); PG8_STAGE(PG8_SB(0, 1), cB + hstep, voffB); PG8_STAGE_A(PG8_SA(0, 0), cA, 0, false, (size_t)0); PG8_STAGE_A(PG8_SA(0, 1), cA + hstep, 1, false, (size_t)0);
        if (wr == 1) PG8_BAR;
        PG8_WAIT_V(2); PG8_BAR;
        PG8_STAGE(PG8_SB(1, 0), cB + kstep, voffB); PG8_STAGE_A(PG8_SA(1, 0), cA + kstep, 0, false, kstep); PG8_STAGE(PG8_SB(1, 1), cB + hstep + kstep, voffB);
        PG8_WAIT_V(6); PG8_BAR;
    } else {
        PG8_STAGE(PG8_SB(0, 0), cB, voffB); PG8_STAGE(PG8_SA(0, 0), cA, voffA); PG8_STAGE(PG8_SB(0, 1), cB + hstep, voffB); PG8_STAGE(PG8_SA(0, 1), cA + hstep, voffA);
        if (wr == 1) PG8_BAR;
        PG8_WAIT_V(4); PG8_BAR;
        PG8_STAGE(PG8_SB(1, 0), cB + kstep, voffB); PG8_STAGE(PG8_SA(1, 0), cA + kstep, voffA); PG8_STAGE(PG8_SB(1, 1), cB + hstep + kstep, voffB);
        PG8_WAIT_V(6); PG8_BAR;
    }
    for (;;) {
        const bool has_next = S.next(ui + 1, nxt);
        if constexpr (GATHER) { if (has_next) PG8_LOADOFF(gn, nxt.pm); else { _Pragma("unroll") for (int _h = 0; _h < 2; ++_h) _Pragma("unroll") for (int _i = 0; _i < 2; ++_i) gn[_h][_i] = gc[_h][_i]; } }
        const char* nA = has_next ? (const char*)g.A + (size_t)nxt.pm * tstep : cA; const char* nB = has_next ? (const char*)g.Bt + (size_t)nxt.pn * tstep : cB;
#pragma unroll 1
        for (int t = 0; t < nt; t += 2) {
            const bool last = (t == nt - 2);
            const char* a1 = cA + (size_t)(t + 1) * kstep;
            const char* a2 = last ? nA : cA + (size_t)(t + 2) * kstep; const char* b2 = last ? nB : cB + (size_t)(t + 2) * kstep;
            const char* a3 = a2 + kstep; const char* b3 = b2 + kstep;
            const size_t gk1 = (size_t)(t + 1) * kstep, gk2 = last ? (size_t)0 : (size_t)(t + 2) * kstep;
            if (last && has_next) S.a_ready(nxt);
            if constexpr (SP2) {
            PG8_STAGE_A(PG8_SA(1, 1), a1 + hstep, 1, false, gk1); PG8_SCHED; PG8_LDB(B0, 0, 0); PG8_LDB(B1, 0, 1); PG8_SCHED; PG8_LDA(At, 0, 0);
            PG8_WAIT_V(8); PG8_WAIT_L(0); PG8_BAR; PG8_MMA(0, 0, At, B0); PG8_MMA(0, 1, At, B1); PG8_BAR; PG8_SCHED;
            PG8_STAGE(PG8_SB(0, 0), b2, voffB); PG8_STAGE(PG8_SB(0, 1), b2 + hstep, voffB); PG8_STAGE_A(PG8_SA(0, 0), a2, 0, last, gk2); PG8_SCHED; PG8_LDA(At, 0, 1);
            PG8_WAIT_V(8); PG8_WAIT_L(0); PG8_BAR; PG8_MMA(1, 0, At, B0); PG8_MMA(1, 1, At, B1); PG8_BAR; PG8_SCHED;
            PG8_STAGE_A(PG8_SA(0, 1), a2 + hstep, 1, last, gk2); PG8_SCHED; PG8_LDB(B0, 1, 0); PG8_LDB(B1, 1, 1); PG8_SCHED; PG8_LDA(At, 1, 0);
            PG8_WAIT_V(8); PG8_WAIT_L(0); PG8_BAR; PG8_MMA(0, 0, At, B0); PG8_MMA(0, 1, At, B1); PG8_BAR; PG8_SCHED;
            PG8_STAGE(PG8_SB(1, 0), b3, voffB); PG8_STAGE(PG8_SB(1, 1), b3 + hstep, voffB); PG8_STAGE_A(PG8_SA(1, 0), a3, 0, last, gk2 + kstep); PG8_SCHED; PG8_LDA(At, 1, 1);
            PG8_WAIT_V(8); PG8_WAIT_L(0); PG8_BAR; PG8_MMA(1, 0, At, B0); PG8_MMA(1, 1, At, B1); PG8_BAR; PG8_SCHED;
            } else {
            PG8_LDB(B0, 0, 0); PG8_SCHED; PG8_LDA(At, 0, 0); PG8_STAGE(PG8_SA(1, 1), a1 + hstep, voffA);
            PG8_WAIT_L(8); PG8_BAR; PG8_WAIT_L(0); PG8_MMA(0, 0, At, B0); PG8_BAR; PG8_SCHED;
            PG8_LDB(B1, 0, 1); PG8_STAGE(PG8_SB(0, 0), b2, voffB);
            PG8_BAR; PG8_WAIT_L(0); PG8_MMA(0, 1, At, B1); PG8_BAR;
            PG8_LDA(At, 0, 1); PG8_STAGE(PG8_SA(0, 0), a2, voffA);
            PG8_BAR; PG8_WAIT_L(0); PG8_MMA(1, 0, At, B0); PG8_BAR; PG8_SCHED;
            PG8_STAGE(PG8_SB(0, 1), b2 + hstep, voffB);
            PG8_WAIT_V(6); PG8_BAR; PG8_MMA(1, 1, At, B1); PG8_BAR;
            PG8_LDB(B0, 1, 0); PG8_SCHED; PG8_LDA(At, 1, 0); PG8_STAGE(PG8_SA(0, 1), a2 + hstep, voffA);
            PG8_WAIT_L(8); PG8_BAR; PG8_WAIT_L(0); PG8_MMA(0, 0, At, B0); PG8_BAR; PG8_SCHED;
            PG8_LDB(B1, 1, 1); PG8_STAGE(PG8_SB(1, 0), b3, voffB);
            PG8_BAR; PG8_WAIT_L(0); PG8_MMA(0, 1, At, B1); PG8_BAR;
            PG8_LDA(At, 1, 1); PG8_STAGE(PG8_SA(1, 0), a3, voffA);
            PG8_BAR; PG8_WAIT_L(0); PG8_MMA(1, 0, At, B0); PG8_BAR; PG8_SCHED;
            PG8_STAGE(PG8_SB(1, 1), b3 + hstep, voffB);
            PG8_WAIT_V(6); PG8_BAR; PG8_MMA(1, 1, At, B1); PG8_BAR;
            }
        }
        if constexpr (ALIGN_EPI) { if (wr == 0) PG8_BAR; }
        if constexpr (!Epi::AFTER_DRAIN) { int ln_ = (int)__builtin_amdgcn_mbcnt_hi(~0u, __builtin_amdgcn_mbcnt_lo(~0u, 0u)); asm volatile("" : "+v"(ln_));
            E(acc, cur, wr, wc, ln_ & 15, ln_ >> 4); S.done(cur); }
        if (!has_next) break;
#pragma unroll
        for (int a = 0; a < 2; ++a)
#pragma unroll
            for (int b = 0; b < 2; ++b)
#pragma unroll
                for (int m = 0; m < 4; ++m)
#pragma unroll
                    for (int n = 0; n < 2; ++n) acc[a][b][m][n] = (f32x4){0.f, 0.f, 0.f, 0.f};
        cur = nxt; cA = nA; cB = nB; ++ui;
        if constexpr (GATHER) { _Pragma("unroll") for (int _h = 0; _h < 2; ++_h) _Pragma("unroll") for (int _i = 0; _i < 2; ++_i) gc[_h][_i] = gn[_h][_i]; }
        if constexpr (ALIGN_EPI) { if (wr == 1) PG8_BAR; }
    }
    PG8_WAIT_V(0);
    if constexpr (!ALIGN_EPI) { if (wr == 0) PG8_BAR; }
    PG8_BAR;
    if constexpr (Epi::AFTER_DRAIN) { E.fused(acc, cur, wr, wc, fr, fq, lds, wid, lane); S.done(cur); }
#undef PG8_SA
#undef PG8_SB
#undef PG8_STAGE
#undef PG8_STAGE_G
#undef PG8_STAGE_A
#undef PG8_LOADOFF
#undef PG8_LDA
#undef PG8_LDB
#undef PG8_MMA
#undef PG8_CAT8
#undef PG8_WAIT_V
#undef PG8_WAIT_L
#undef PG8_BAR
#undef PG8_SCHED
}
}
#define GAS __attribute__((address_space(1)))
typedef unsigned v4u __attribute__((ext_vector_type(4)));
#define LDS_WAIT() asm volatile("s_waitcnt lgkmcnt(0)" ::: "memory")
#define VM_WAIT() asm volatile("s_waitcnt vmcnt(0)" ::: "memory")
__device__ __forceinline__ unsigned pk2(float lo, float hi) { return cvt_pk_bf16(lo, hi); }
#define XB_TMO      128
#define XB_XCNT(j)  (256  + 64 * (j))
#define XB_XSUB(j)  (1280 + 64 * (j))
#define XB_XGEN(j)  (2304 + 64 * (j))
#define XB_TOP      3328
#define XB_TOPGEN   3392
#define XCD_BAR_WORDS 3456
#define XB_SPIN_CAP (1u << 18)
__device__ __forceinline__ unsigned xb_ld(unsigned* p)              { return __hip_atomic_load(p, __ATOMIC_RELAXED, __HIP_MEMORY_SCOPE_AGENT); }
__device__ __forceinline__ unsigned xb_add(unsigned* p, unsigned v) { return __hip_atomic_fetch_add(p, v, __ATOMIC_RELAXED, __HIP_MEMORY_SCOPE_AGENT); }
__device__ __forceinline__ unsigned xb_xcc_id() { return (unsigned)__builtin_amdgcn_s_getreg((3 << 11) | 20) & 0xFu; }
#define XB_SPIN(cond, bar) do { unsigned _sp = 0; while (cond) { __builtin_amdgcn_s_sleep(1); \
    if ((++_sp & 255u) == 0u) { if (xb_ld(&(bar)[XB_TMO])) break; if (_sp > XB_SPIN_CAP) { atomicAdd(&(bar)[XB_TMO], 1u); break; } } } } while (0)

struct XcdBarrier {
    unsigned* bar; unsigned x;
    volatile LAS unsigned* st;
};

__device__ __forceinline__ XcdBarrier xcd_barrier_post(unsigned* bar, volatile LAS unsigned* st) {
    XcdBarrier b; b.bar = bar; b.x = xb_xcc_id(); b.st = st;
    if (threadIdx.x == 0) (void)xb_add(&bar[XB_XCNT(b.x)], 1u);
    return b;
}
__device__ __forceinline__ void xcd_barrier_complete(unsigned* bar, unsigned x, unsigned& nloc, unsigned& nx) {
    const unsigned G = gridDim.x * gridDim.y * gridDim.z;
    unsigned sum, cnt, mine, sp = 0u;
    for (;;) {
        sum = 0u; cnt = 0u; mine = 0u;
#pragma unroll
        for (unsigned j = 0; j < 16; ++j) { const unsigned c = xb_ld(&bar[XB_XCNT(j)]); sum += c; cnt += (c > 0u) ? 1u : 0u; mine = (j == x) ? c : mine; }
        if (sum == G) break;
        __builtin_amdgcn_s_sleep(1);
        if ((++sp & 255u) == 0u) { if (xb_ld(&bar[XB_TMO])) break; if (sp > XB_SPIN_CAP) { atomicAdd(&bar[XB_TMO], 1u); break; } }
    }
    nloc = mine > 0u ? mine : 1u; nx = cnt > 0u ? cnt : 1u;
}

__device__ __forceinline__ void xcd_barrier(const XcdBarrier& b) {
    asm volatile("s_waitcnt vmcnt(0)" ::: "memory");
    __syncthreads();
    if (threadIdx.x == 0) {
        unsigned* bar = b.bar;
        __builtin_amdgcn_s_waitcnt(0);
        unsigned nloc = b.st[0], nx = b.st[1];
        if (nloc == 0u) { xcd_barrier_complete(bar, b.x, nloc, nx); b.st[0] = nloc; b.st[1] = nx; }
        const unsigned old = xb_add(&bar[XB_XSUB(b.x)], 1u);
        const unsigned gen = old / nloc;
        if (old + 1u == (gen + 1u) * nloc) {
            __builtin_amdgcn_fence(__ATOMIC_RELEASE, "agent");
            asm volatile("s_waitcnt vmcnt(0)" ::: "memory");
            const unsigned og = xb_add(&bar[XB_TOP], 1u);
            const unsigned tg = og / nx;
            if (og + 1u == (tg + 1u) * nx) xb_add(&bar[XB_TOPGEN], 1u);
            else XB_SPIN(xb_ld(&bar[XB_TOPGEN]) == tg, bar);
            __builtin_amdgcn_fence(__ATOMIC_ACQUIRE, "agent");
            xb_add(&bar[XB_XGEN(b.x)], 1u);
            asm volatile("s_waitcnt vmcnt(0)" ::: "memory");
        } else {
            XB_SPIN(xb_ld(&bar[XB_XGEN(b.x)]) == gen, bar);
            __builtin_amdgcn_fence(__ATOMIC_ACQUIRE, "agent");
            asm volatile("s_waitcnt vmcnt(0)" ::: "memory");
        }
    }
    __syncthreads();
}


constexpr int NWAVES = 8, NT = NWAVES * 64;
constexpr int RING_OFF = 0, RING_BYTES = 147456;
constexpr int LDSCTL_OFF = RING_BYTES, MISC_OFF = LDSCTL_OFF + 320;
constexpr int BIAS_OFF = 148480, LDS_BYTES = 163840;
static_assert(MISC_OFF + 128 <= LDS_BYTES && NWV * WAVE_LDS <= RING_BYTES, "LDS map");

struct Args { const float* in[20]; float* out; unsigned char* ws; int ph_lo, ph_hi; };
struct Env { LAS unsigned char* lds; XcdBarrier bar; int lo, hi; };
typedef const __attribute__((address_space(4))) Args* KArgs;
__device__ __forceinline__ void load_p(P& p) {
    KArgs ka = (KArgs)__builtin_amdgcn_kernarg_segment_ptr(); asm volatile("" : "+s"(ka));
    p.x = ka->in[0]; p.c = ka->in[1]; p.ctx = ka->in[2]; p.c_ctx = ka->in[3]; p.w_mod = ka->in[4]; p.b_mod = ka->in[5]; p.w_in = ka->in[6]; p.pool_w = ka->in[7]; p.pool_scale = ka->in[8]; p.attn_sink = ka->in[9];
    p.ret_decay = ka->in[10]; p.w_out = ka->in[11]; p.ln_g = ka->in[12]; p.ln_b = ka->in[13]; p.router_w = ka->in[14]; p.router_b = ka->in[15]; p.exp_w1 = ka->in[16]; p.exp_b1 = ka->in[17]; p.exp_w2 = ka->in[18]; p.exp_b2 = ka->in[19];
    p.out = ka->out; p.ws = ka->ws; fill_views(p);
}
#define PH_LOAD() P p; load_p(p)
#define SIMPLE(n, CALL) do { const long _n = (long)(n); int _t = threadIdx.x; asm volatile("" : "+v"(_t)); for (long gid = (long)blockIdx.x * NT + _t; gid < _n; gid += (long)gridDim.x * NT) { CALL; } } while (0)
#define SEAM(k) do { if (env.lo <= (k) && (k) + 1 < env.hi) xcd_barrier(env.bar); } while (0)
#define LDSP (env.lds + RING_OFF)
#define BLOCKPHASE(CALL) do { CALL; } while (0)

__device__ __forceinline__ void p0_transpose_item(const float* W, int K, int N, bf16* WT, LAS float* scr, int item, int lane) {
    const int nblk = N / 32, kb = item / nblk, nb = item % nblk, k0 = 64 * kb, n0 = 32 * nb;
    float wv[32];
#pragma unroll
    for (int i = 0; i < 32; ++i) wv[i] = __builtin_nontemporal_load(W + (size_t)(k0 + 2 * i + (lane >> 5)) * N + n0 + (lane & 31));
#pragma unroll
    for (int i = 0; i < 32; ++i) scr[(2 * i + (lane >> 5)) * 33 + (lane & 31)] = wv[i];
    LDS_WAIT(); asm volatile("" ::: "memory");
    const int c = lane & 7;
#pragma unroll
    for (int j = 0; j < 4; ++j) { const int n = (lane >> 3) + 8 * j; const LAS float* s = scr + (8 * c) * 33 + n;
        v4u o; o.x = pk2(s[0 * 33], s[1 * 33]); o.y = pk2(s[2 * 33], s[3 * 33]); o.z = pk2(s[4 * 33], s[5 * 33]); o.w = pk2(s[6 * 33], s[7 * 33]);
        *(GAS v4u*)(WT + (size_t)(n0 + n) * K + k0 + 8 * c) = o; }
    LDS_WAIT(); asm volatile("" ::: "memory");
}
#define TRANSPOSE(Wp, nmat, K_, N_, WTp) do { int _t = threadIdx.x; asm volatile("" : "+v"(_t)); const int _wave = __builtin_amdgcn_readfirstlane(_t >> 6), _lane = _t & 63; LAS float* scr = (LAS float*)(env.lds + RING_OFF + _wave * 18432); const int per = ((K_) / 64) * ((N_) / 32); \
    for (long it = (long)blockIdx.x * NWAVES + _wave; it < (long)(nmat) * per; it += (long)gridDim.x * NWAVES) { const int mi = (int)(it / per), r = (int)(it % per); \
        p0_transpose_item((Wp) + (size_t)mi * (K_) * (N_), (K_), (N_), (WTp) + (size_t)mi * (K_) * (N_), scr, r, _lane); } } while (0)
#define GEMM_PLAIN(Ap, Btp, M_, N_, K_, Op, ldc_, biasp, splitc, splits) do { pg8::Gemm g{(Ap), (Btp), (M_), (N_), (K_)}; pg8::StaticOrder S; S.init((M_), (N_), (int)gridDim.x, (int)blockIdx.x); \
    pg8::EpiOut<false> E{(Op), (ldc_), nullptr, (splitc), (size_t)(splits), 1.0f, env.lds + RING_OFF + 131072}; pg8::gemm_phase<pg8::EpiOut<false>, pg8::StaticOrder, true, true>(env.lds + RING_OFF, g, S, E); } while (0)
#define GEMM_PLAIN8(Ap, Btp, M_, N_, K_, Op, ldc_) do { pg8::Gemm g{(const pg8::bf16_t*)(Ap), (const pg8::bf16_t*)(Btp), (M_), (N_), (K_) / 2}; pg8::StaticOrder S; S.init((M_), (N_), (int)gridDim.x, (int)blockIdx.x); \
    pg8::EpiOut<false> E{(Op), (ldc_), nullptr, 0, (size_t)0, 1.0f / W8_SCALE, env.lds + RING_OFF + 131072}; pg8::gemm_phase<pg8::EpiOut<false>, pg8::StaticOrder, true, true, false, true>(env.lds + RING_OFF, g, S, E); } while (0)
#define GEMM_MOE_SW(Ap, Btp, nN_, K_, Op, ldc_, biasp, ncols_) do { pg8::Gemm g{(const pg8::bf16_t*)(Ap), (const pg8::bf16_t*)(Btp), 0, 0, (K_) / 2}; pg8::MoeOrder S; S.init(p.blke, p.blke[NBLKMAX], (nN_), (int)gridDim.x, (int)blockIdx.x); \
    static_assert((NBLKMAX / 8 + 1) * 8 / 32 + 2 <= (LDS_BYTES - BIAS_OFF) / 512, "bf16 bias rows of a workgroup's GEMM1 units fit the LDS bias area"); \
    { int t_ = threadIdx.x; asm volatile("" : "+v"(t_)); LAS pg8::bf16_t* lb_ = (LAS pg8::bf16_t*)(env.lds + BIAS_OFF); pg8::Unit u_; \
      for (int i_ = __builtin_amdgcn_readfirstlane(t_ >> 8); S.next(i_, u_); i_ += 2) lb_[i_ * 256 + (t_ & 255)] = (pg8::bf16_t)f2bf((biasp)[(size_t)u_.pn * 256 + (t_ & 255)]); __syncthreads(); } \
    pg8::EpiSwiglu8 E{(Op), (ldc_), (const LAS pg8::bf16_t*)(env.lds + BIAS_OFF), (ncols_), 1.0f / W8_SCALE, env.lds + RING_OFF + 131072}; static_assert(131072 + 256 * 64 <= RING_BYTES, "SwiGLU staging fits above the stage ring"); pg8::gemm_phase<pg8::EpiSwiglu8, pg8::MoeOrder, true, true, false, true>(env.lds + RING_OFF, g, S, E); } while (0)
#define GEMM_MOE(Ap, Btp, nN_, K_, Op, ldc_, biasp, splitc) do { pg8::Gemm g{(const pg8::bf16_t*)(Ap), (const pg8::bf16_t*)(Btp), 0, 0, (K_) / 2}; pg8::MoeOrder S; S.init(p.blke, p.blke[NBLKMAX], (nN_), (int)gridDim.x, (int)blockIdx.x); \
    static_assert((NBLKMAX / 8 + 1) * 4 / 32 + 2 <= (LDS_BYTES - BIAS_OFF) / 1024, "f32 bias rows of a workgroup's GEMM2 units fit the LDS bias area"); \
    { int t_ = threadIdx.x; asm volatile("" : "+v"(t_)); LAS float* lb_ = (LAS float*)(env.lds + BIAS_OFF); pg8::Unit u_; \
      for (int i_ = __builtin_amdgcn_readfirstlane(t_ >> 8); S.next(i_, u_); i_ += 2) lb_[i_ * 256 + (t_ & 255)] = (biasp)[(size_t)u_.pn * 256 + (t_ & 255)]; __syncthreads(); } \
    pg8::EpiOut8<true> E{(Op), (ldc_), (const LAS float*)(env.lds + BIAS_OFF), (splitc), 1.0f / W8_SCALE, env.lds + RING_OFF + 131072}; pg8::gemm_phase<pg8::EpiOut8<true>, pg8::MoeOrder, true, true, false, true>(env.lds + RING_OFF, g, S, E); } while (0)
__device__ __forceinline__ void t8_load(float (&wv)[64], const float* W, int N, int item, int lane) {
    const int nblk = N / 32, kb = item / nblk, nb = item % nblk, k0 = 128 * kb, n0 = 32 * nb;
    typedef float f4_t __attribute__((ext_vector_type(4)));
#pragma unroll
    for (int i = 0; i < 16; ++i) { const f4_t v = __builtin_nontemporal_load((const f4_t*)(W + (size_t)(k0 + 8 * i + (lane >> 3)) * N + n0 + 4 * (lane & 7)));
        wv[4 * i] = v[0]; wv[4 * i + 1] = v[1]; wv[4 * i + 2] = v[2]; wv[4 * i + 3] = v[3]; }
}
__device__ __forceinline__ void t8_pack(const float (&wv)[64], int K, int N, unsigned char* WT, LAS float* scr, int item, int lane) {
    const int nblk = N / 32, kb = item / nblk, nb = item % nblk, k0 = 128 * kb, n0 = 32 * nb;
#pragma unroll
    for (int i = 0; i < 16; ++i)
#pragma unroll
        for (int q = 0; q < 4; ++q) scr[(8 * i + (lane >> 3)) * 33 + 4 * (lane & 7) + q] = wv[4 * i + q] * W8_SCALE;
    LDS_WAIT(); asm volatile("" ::: "memory");
    const int n = lane & 31, hf = lane >> 5; const LAS float* sp = scr + (64 * hf) * 33 + n;
    GAS v4u* dst = (GAS v4u*)(WT + (size_t)(n0 + n) * K + k0 + 64 * hf);
#pragma unroll
    for (int c = 0; c < 4; ++c) { v4u o;
#pragma unroll
        for (int q = 0; q < 4; ++q) o[q] = pk4_fp8(sp[(16 * c + 4 * q) * 33], sp[(16 * c + 4 * q + 1) * 33], sp[(16 * c + 4 * q + 2) * 33], sp[(16 * c + 4 * q + 3) * 33]);
        dst[c] = o; }
    LDS_WAIT(); asm volatile("" ::: "memory");
}
__device__ __forceinline__ void transpose8_stream(const float* Wp, int nmat, int K, int N, unsigned char* WTp, LAS unsigned char* lds) {
    int _t = threadIdx.x; asm volatile("" : "+v"(_t)); const int wave = __builtin_amdgcn_readfirstlane(_t >> 6), lane = _t & 63; LAS float* scr = (LAS float*)(lds + wave * 18432);
    static_assert(128 * 33 * 4 <= 18432 && NWAVES * 18432 <= RING_BYTES, "transpose tile fits the per-wave slice");
    const int per = (K / 128) * (N / 32); const long total = (long)nmat * per, stride = (long)gridDim.x * NWAVES;
    long it = (long)blockIdx.x * NWAVES + wave; if (it >= total) return;
    float wa[64], wb[64];
    t8_load(wa, Wp + (size_t)(it / per) * K * N, N, (int)(it % per), lane);
    for (;;) {
        const long n1 = it + stride; const bool h1 = n1 < total;
        if (h1) t8_load(wb, Wp + (size_t)(n1 / per) * K * N, N, (int)(n1 % per), lane);
        t8_pack(wa, K, N, WTp + (size_t)(it / per) * K * N, scr, (int)(it % per), lane);
        if (!h1) break;
        const long n2 = n1 + stride; const bool h2 = n2 < total;
        if (h2) t8_load(wa, Wp + (size_t)(n2 / per) * K * N, N, (int)(n2 % per), lane);
        t8_pack(wb, K, N, WTp + (size_t)(n1 / per) * K * N, scr, (int)(n1 % per), lane);
        if (!h2) break;
        it = n2;
    }
}
#define TRANSPOSE8(Wp, nmat, K_, N_, WTp) transpose8_stream((Wp), (nmat), (K_), (N_), (WTp), env.lds + RING_OFF)
#define DUMP(name, ptr, rows, cols, isbf)
#else
struct Env { int lo, hi; std::string dir; };
static P g_P;
#define PH_LOAD() const P& p = g_P
#define SIMPLE(n, CALL) do { const long _n = (long)(n); for (long gid = 0; gid < _n; ++gid) { CALL; } } while (0)
#define SEAM(k)
#define LDSP (emu::g_lds)
#ifndef EMU_GRID
#define EMU_GRID 3
#endif
#define BLOCKPHASE(CALL) do { for (int _b = 0; _b < EMU_GRID; ++_b) emu::run_block(_b, EMU_GRID, 512, [&]() { CALL; }); } while (0)
#define TRANSPOSE(Wp, nmat, K_, N_, WTp) do { for (int mi = 0; mi < (nmat); ++mi) for (int k = 0; k < (K_); ++k) for (int n = 0; n < (N_); ++n) \
    (WTp)[(size_t)mi * (K_) * (N_) + (size_t)n * (K_) + k] = (bf16)f2bf((Wp)[(size_t)mi * (K_) * (N_) + (size_t)k * (N_) + n]); } while (0)
static void cpu_gemm_rows(const bf16* A, const bf16* Bt, int r0, int r1, int N, int K, int bcol_off, bf16* O, int ldc, const float* bias, int splitc, size_t splits, int swiglu) {
    std::vector<float> Bf((size_t)N * K);
    for (int n = 0; n < N; ++n) for (int k = 0; k < K; ++k) Bf[(size_t)n * K + k] = bf2f(Bt[(size_t)(bcol_off + n) * K + k]);
#pragma omp parallel for schedule(static)
    for (int r = r0; r < r1; ++r) {
        std::vector<float> u(N), a(K);
        for (int k = 0; k < K; ++k) a[k] = bf2f(A[(size_t)r * K + k]);
        for (int n = 0; n < N; ++n) { float acc = 0.f; const float* b = &Bf[(size_t)n * K]; for (int k = 0; k < K; ++k) acc += a[k] * b[k];
            u[n] = acc + (bias ? bias[bcol_off + n] : 0.f); }
        if (swiglu) { for (int n = 0; n < N / 2; ++n) { float g = fminf(u[2 * n], SW_LIMIT), l = fminf(fmaxf(u[2 * n + 1], -SW_LIMIT), SW_LIMIT); O[(size_t)r * ldc + n] = (bf16)f2bf(g * (1.0f / (1.0f + expf(-SW_ALPHA * g))) * (l + 1.0f)); } }
        else for (int n = 0; n < N; ++n) { int col = n; bf16* base = O; if (splitc) { const int t = col / splitc; base += (size_t)t * splits; col -= t * splitc; } base[(size_t)r * ldc + col] = (bf16)f2bf(u[n]); }
    }
}
#define GEMM_PLAIN(Ap, Btp, M_, N_, K_, Op, ldc_, biasp, splitc, splits) cpu_gemm_rows((Ap), (Btp), 0, (M_), (N_), (K_), 0, (Op), (ldc_), (biasp), (splitc), (size_t)(splits), 0)
static void cpu_gemm_rows8(const unsigned char* A, const unsigned char* Bt, int r0, int r1, int N, int K, int bcol_off, void* Ov, int ldc, const float* bias, int swiglu) {
    std::vector<float> Bf((size_t)N * K);
    for (int n = 0; n < N; ++n) for (int k = 0; k < K; ++k) Bf[(size_t)n * K + k] = fp8_to_f32(Bt[(size_t)(bcol_off + n) * K + k]);
#pragma omp parallel for schedule(static)
    for (int r = r0; r < r1; ++r) {
        std::vector<float> u(N), a(K);
        for (int k = 0; k < K; ++k) a[k] = fp8_to_f32(A[(size_t)r * K + k]);
        for (int n = 0; n < N; ++n) { float acc = 0.f; const float* b = &Bf[(size_t)n * K]; for (int k = 0; k < K; ++k) acc += a[k] * b[k]; u[n] = acc * (1.0f / W8_SCALE) + bias[bcol_off + n]; }
        if (swiglu) { unsigned char* O = (unsigned char*)Ov; for (int n = 0; n < N / 2; ++n) { float g = fminf(u[2 * n], SW_LIMIT), l = fminf(fmaxf(u[2 * n + 1], -SW_LIMIT), SW_LIMIT); O[(size_t)r * ldc + n] = (unsigned char)f32_to_fp8_sw(g * (1.0f / (1.0f + expf(-SW_ALPHA * g))) * (l + 1.0f)); } }
        else { unsigned char* O = (unsigned char*)Ov; for (int n = 0; n < N; ++n) O[(size_t)r * ldc + n] = (unsigned char)f32_to_fp8_sw(u[n]); }
    }
}
static void cpu_gemm_plain8(const unsigned char* A, const unsigned char* Bt, int M, int N, int K, bf16* O, int ldc) {
    std::vector<float> Bf((size_t)N * K); for (size_t i = 0; i < (size_t)N * K; ++i) Bf[i] = fp8_to_f32(Bt[i]);
#pragma omp parallel for schedule(static)
    for (int r = 0; r < M; ++r) { std::vector<float> a(K); for (int k = 0; k < K; ++k) a[k] = fp8_to_f32(A[(size_t)r * K + k]);
        for (int n = 0; n < N; ++n) { float acc = 0.f; const float* b = &Bf[(size_t)n * K]; for (int k = 0; k < K; ++k) acc += a[k] * b[k]; O[(size_t)r * ldc + n] = (bf16)f2bf(acc * (1.0f / W8_SCALE)); } }
}
#define GEMM_PLAIN8(Ap, Btp, M_, N_, K_, Op, ldc_) cpu_gemm_plain8((Ap), (Btp), (M_), (N_), (K_), (Op), (ldc_))
#define GEMM_MOE_SW(Ap, Btp, nN_, K_, Op, ldc_, biasp, ncols_) do { const int nblk = p.blke[NBLKMAX]; for (int rb = 0; rb < nblk; ++rb) { const int e = p.blke[rb]; \
    cpu_gemm_rows8((Ap), (Btp), rb * MOEB, (rb + 1) * MOEB, (ncols_), (K_), e * (ncols_), (Op), (ldc_), (biasp), 1); } } while (0)
#define GEMM_MOE(Ap, Btp, nN_, K_, Op, ldc_, biasp, splitc) do { const int nblk = p.blke[NBLKMAX]; for (int rb = 0; rb < nblk; ++rb) { const int e = p.blke[rb]; \
    cpu_gemm_rows8((Ap), (Btp), rb * MOEB, (rb + 1) * MOEB, (splitc), (K_), e * (splitc), (Op), (ldc_), (biasp), 0); } } while (0)
#define TRANSPOSE8(Wp, nmat, K_, N_, WTp) do { for (int mi = 0; mi < (nmat); ++mi) for (int k = 0; k < (K_); ++k) for (int n = 0; n < (N_); ++n) \
    (WTp)[(size_t)mi * (K_) * (N_) + (size_t)n * (K_) + k] = (unsigned char)f32_to_fp8_sw((Wp)[(size_t)mi * (K_) * (N_) + (size_t)k * (N_) + n] * W8_SCALE); } while (0)
static void dump_buf(const std::string& dir, const char* name, int l, const void* ptr, long rows, long cols, int isbf) {
    std::vector<float> v((size_t)rows * cols);
    for (long i = 0; i < rows * cols; ++i) v[i] = isbf == 1 ? bf2f(((const bf16*)ptr)[i]) : isbf == 2 ? (float)((const int*)ptr)[i] : ((const float*)ptr)[i];
    char fn[512]; snprintf(fn, sizeof fn, "%s/c_L%d_%s.bin", dir.c_str(), l, name); FILE* f = fopen(fn, "wb"); fwrite(v.data(), 4, v.size(), f); fclose(f);
}
#define DUMP(name, ptr, rows, cols, isbf) dump_buf(env.dir, name, l, ptr, rows, cols, isbf)
#endif
constexpr int NPL = 14, NPHASE = 1 + NPL * DEPTH;
#define IN(k) (env.lo <= (k) && (k) < env.hi)
#ifndef PROBE_MASK
#define PROBE_MASK 0
#endif
#define REP(bit) for (int _rep = 0; _rep < (((PROBE_MASK) >> (bit)) & 1 ? 2 : 1); ++_rep)
#define QB() const_cast<P&>(p).qbank = _rep
template <int L> HD void layer_phases(Env& env) {
        constexpr int l = L;
        const int pb = 1 + NPL * l;
        const bool last = (l == DEPTH - 1);
        const int tlo = last ? TC : 0;
        if (IN(pb + 0)) { PH_LOAD(); if (l == 0) { REP(10) BLOCKPHASE(ph_rows_ln0(p, LDSP));
            REP(9) {
            TRANSPOSE8(p.w_in, DEPTH, D, INW, (unsigned char*)p.WinT);
            TRANSPOSE(p.w_out, DEPTH, D, D, p.WoutT);
            TRANSPOSE8(p.exp_w1, DEPTH * NE, D, 2 * DE, p.W1T8);
            TRANSPOSE8(p.exp_w2, DEPTH * NE, DE, D, p.W2T8);
            }
            SEAM(pb + 0); }  }
        if (IN(pb + 1)) { PH_LOAD(); REP(0) GEMM_PLAIN8(p.hb8, (const unsigned char*)p.WinT + (size_t)l * INW * D, T, INW, D, p.pj, INW); DUMP("pj", p.pj, T, INW, 1); SEAM(pb + 1); }
        if (IN(pb + 2)) { PH_LOAD(); REP(1) { QB();
            if (!last) SIMPLE((long)TC * QW, ph_fch(p, gid));
            BLOCKPHASE(ph_krope(p, LDSP));
            BLOCKPHASE(ph_vtrans(p, LDSP));
            BLOCKPHASE(ph_fftA(p, l, LDSP));
            BLOCKPHASE(ph_retA(p, l, LDSP)); }
            SEAM(pb + 2);
        }
        if (IN(pb + 3)) { PH_LOAD();
            SIMPLE((long)2 * NB * RH * RDK * RDK / 2, ph_retscan(p, l, gid));
            REP(2) { QB(); BLOCKPHASE(ph_attn_wave(p, l, LDSP, !last)); }
            REP(3) { QB();
            BLOCKPHASE(ph_pool_wave(p, l, LDSP, !last));
            if (!last) SIMPLE((long)TC * QW, ph_fctx(p, gid));
            BLOCKPHASE(ph_fftB(p, l, LDSP)); }
            SEAM(pb + 3);
        }
        if (IN(pb + 4)) { PH_LOAD(); REP(4) { QB(); BLOCKPHASE(ph_retC(p, l, LDSP, !last)); } DUMP("mix", p.mix, T, D, 1); SEAM(pb + 4); }
        if (IN(pb + 5)) { PH_LOAD(); REP(5) { if (last) GEMM_PLAIN(p.mix + (size_t)TC * D, p.WoutT + (size_t)l * D * D, TL, D, D, p.y + (size_t)TC * D, D, (const float*)nullptr, 0, 0);
                                        else GEMM_PLAIN(p.mix, p.WoutT + (size_t)l * D * D, T, D, D, p.y, D, (const float*)nullptr, 0, 0); } DUMP("y", p.y, T, D, 1); SEAM(pb + 5); }
        if (IN(pb + 6)) { PH_LOAD(); BLOCKPHASE(ph_rows_res1(p, l, tlo, LDSP)); DUMP("x1", p.xs, T, D, 1); DUMP("logits", p.logits, T, NE, 0); DUMP("topi", p.topi, T, TOPK, 2); SEAM(pb + 6); }
        if (IN(pb + 9)) { PH_LOAD(); REP(6) BLOCKPHASE(ph_dispatch(p, l, tlo, LDSP)); SEAM(pb + 9); }
        if (IN(pb + 11)) { PH_LOAD(); REP(7) GEMM_MOE_SW(p.as8, p.W1T8 + (size_t)l * NE * 2 * DE * D, 2 * DE / 256, D, p.act8, DE, p.exp_b1 + (size_t)l * NE * 2 * DE, 2 * DE); SEAM(pb + 11); }
        if (IN(pb + 12)) { PH_LOAD(); REP(8) GEMM_MOE(p.act8, p.W2T8 + (size_t)l * NE * D * DE, D / 256, DE, p.ym8, D, p.exp_b2 + (size_t)l * NE * D, D); SEAM(pb + 12); }
        if (IN(pb + 13)) { PH_LOAD(); if (last) { REP(12) BLOCKPHASE(ph_rows_res2(p, l, tlo, LDSP)); } else BLOCKPHASE(ph_rows_res2(p, l, tlo, LDSP)); SEAM(pb + 13); }
}
HD void program(Env& env) {
    if (IN(0)) { PH_LOAD();
        REP(11) BLOCKPHASE(ph_mod_block(p, LDSP));
        SIMPLE((long)2 * 64 * 64 + 2 * FN1 * FN1, ph_ftab(p, gid));
        SIMPLE((long)DEPTH * 4 * PGW * PGW, ph_pwt(p, gid));
        SIMPLE((long)128 * 16, ph_rtab(p, gid));
        SIMPLE((long)LCTX, ph_ctab(p, gid));
        SEAM(0);
    }
    layer_phases<0>(env);
    layer_phases<1>(env);
    static_assert(DEPTH == 2, "two layers");
}
#ifndef CPU_TEST
#ifndef MK_ONE_LAUNCH
#define MK_ONE_LAUNCH 1
#endif
__global__ void __launch_bounds__(NT, 2) hpg_fwd(Args a) {
    extern __shared__ __attribute__((aligned(16))) unsigned char lds[];
    Env env; env.lds = (LAS unsigned char*)lds; env.lo = a.ph_lo; env.hi = a.ph_hi;
    for (int u = threadIdx.x; u < (LDS_BYTES - LDSCTL_OFF) / 4; u += NT) ((LAS unsigned*)(env.lds + LDSCTL_OFF))[u] = 0u;
    __syncthreads();
    volatile LAS unsigned* MISC = (volatile LAS unsigned*)(env.lds + MISC_OFF);
    env.bar = xcd_barrier_post((unsigned*)(a.ws + WS_CTL) + CW_BAR, MISC + 8);
    program(env);
}

extern "C" void kernel_launch(void* const* d_in, const int* in_sizes, int n_in, void* d_out, int out_size, void* d_ws, size_t ws_size, hipStream_t stream) {
    static int grid = 0;
    if (grid == 0) {
        if (n_in != 20 || in_sizes[0] != TL * D || out_size != TL * D || ws_size < WS_TOTAL) {
            fprintf(stderr, "kernel_launch: built for 20 inputs, x/out of %d floats, >= %zu bytes of workspace; got n_in %d, in0 %d, out %d, ws %zu; nothing launched\n", TL * D, (size_t)WS_TOTAL, n_in, n_in > 0 ? in_sizes[0] : -1, out_size, ws_size);
            grid = -1; return; }
        int dev = 0, cus = 0, per_cu = 0;
        if (hipGetDevice(&dev) != hipSuccess || hipDeviceGetAttribute(&cus, hipDeviceAttributeMultiprocessorCount, dev) != hipSuccess) { fprintf(stderr, "kernel_launch: device query failed\n"); grid = -1; return; }
        if (hipFuncSetAttribute((const void*)hpg_fwd, hipFuncAttributeMaxDynamicSharedMemorySize, LDS_BYTES) != hipSuccess) { fprintf(stderr, "kernel_launch: hipFuncSetAttribute failed\n"); grid = -1; return; }
        if (hipOccupancyMaxActiveBlocksPerMultiprocessor(&per_cu, (const void*)hpg_fwd, NT, LDS_BYTES) != hipSuccess || per_cu < 1)
            fprintf(stderr, "kernel_launch: note: occupancy query reports %d workgroups per CU\n", per_cu);
        (void)hipGetLastError();
        grid = cus;
    }
    if (grid < 0) return;
    if (hipMemsetAsync((char*)d_ws + WS_CTL, 0, CTL_ZERO_BYTES, stream) != hipSuccess) { fprintf(stderr, "kernel_launch: memset failed\n"); return; }
    Args a{};
    for (int i = 0; i < 20; ++i) a.in[i] = (const float*)d_in[i];
    a.out = (float*)d_out; a.ws = (unsigned char*)d_ws;
#if MK_ONE_LAUNCH
    a.ph_lo = 0; a.ph_hi = NPHASE;
    hipLaunchKernelGGL(hpg_fwd, dim3(grid), dim3(NT), LDS_BYTES, stream, a);
#else
    for (int k = 0; k < NPHASE; ++k) { a.ph_lo = k; a.ph_hi = k + 1; hipLaunchKernelGGL(hpg_fwd, dim3(grid), dim3(NT), LDS_BYTES, stream, a); }
#endif
    const hipError_t le = hipPeekAtLastError();
    if (le != hipSuccess) fprintf(stderr, "kernel_launch: launch failed: %s\n", hipGetErrorName(le));
}
#else
int main(int argc, char** argv) {
    std::string dir = argc > 1 ? argv[1] : "t";
    const size_t sizes[20] = {(size_t)TL * D, (size_t)NB * D, (size_t)TC * D, (size_t)D, (size_t)DEPTH * D * 6 * D, (size_t)DEPTH * 6 * D, (size_t)DEPTH * D * INW, (size_t)DEPTH * 4 * PGW * PGW, (size_t)DEPTH * QW,
        (size_t)DEPTH * NH, (size_t)DEPTH * 2 * RH, (size_t)DEPTH * D * D, (size_t)DEPTH * 2 * D, (size_t)DEPTH * 2 * D, (size_t)DEPTH * D * NE, (size_t)DEPTH * NE, (size_t)DEPTH * NE * D * 2 * DE, (size_t)DEPTH * NE * 2 * DE,
        (size_t)DEPTH * NE * DE * D, (size_t)DEPTH * NE * D};
    std::vector<std::vector<float>> in(20);
    FILE* f = fopen((dir + "/inputs.bin").c_str(), "rb"); if (!f) { printf("no inputs\n"); return 1; }
    for (int i = 0; i < 20; ++i) { in[i].resize(sizes[i]); if (fread(in[i].data(), 4, sizes[i], f) != sizes[i]) { printf("short read %d\n", i); return 1; } }
    fclose(f);
    std::vector<unsigned char> ws(WS_TOTAL, 0xCD); memset(ws.data(), 0, CTL_ZERO_BYTES);
    std::vector<float> out((size_t)TL * D, 0.f);
    P& p = g_P; const float** pp = (const float**)&p.x; for (int i = 0; i < 20; ++i) pp[i] = in[i].data();
    p.out = out.data(); p.ws = ws.data(); fill_views(p);
    Env env; env.lo = 0; env.hi = NPHASE; env.dir = dir;
    program(env);
    f = fopen((dir + "/c_out.bin").c_str(), "wb"); fwrite(out.data(), 4, out.size(), f); fclose(f);
    printf("cpu test done, T=%d PMAX=%d nblk(last)=%d\n", T, PMAX, p.blke[NBLKMAX]);
    return 0;
}
#endif
```
